# Optimizing an MI355X kernel written in HIP

```python
import math
import jax
import jax.numpy as jnp
from jax import lax
import numpy as np

D_MODEL = 1024
BATCH = 8
SEQ = 4096
DEPTH = 4

GRID_W = 64
CTX_LEN = 256
N_MIXERS = 3
MIX_SHORTCONV = 0
MIX_HYENA = 1
MIX_ATTN = 2
CONV_W = 3
EPS = 1e-6
HY_ORDER = 2
HY_EMB = 33
HY_BANDS = (HY_EMB - 1) // 2
HY_FILTER_HIDDEN = 64
HY_FAST_DECAY = 0.3
HY_SLOW_DECAY = 1.5
HY_TARGET = 1e-2
HEAD_DIM = 128
N_Q_HEADS = D_MODEL // HEAD_DIM
N_KV_HEADS = 2
Q_PER_KV = N_Q_HEADS // N_KV_HEADS
AXIS_DIM = HEAD_DIM // 2
ROPE_THETA = 10000.0
Q_BLOCK = 128
N_EXPERTS = 16
EC_CAPACITY_FACTOR = 2
D_EXPERT = D_MODEL

kernel_name = "hybrid_conv_hyena_gqa_ec_moe_dit"


def _layers_of(kind):
    return list(range(kind, DEPTH, N_MIXERS))


def rms_norm(x, g):
    xf = x.astype(jnp.float32)
    y = xf * lax.rsqrt(jnp.mean(xf * xf, axis=-1, keepdims=True) + EPS)
    return (y * g.astype(jnp.float32)).astype(x.dtype)


def modulate(x, shift, scale):
    return x * (1.0 + scale) + shift


def dwconv_centred(x, w):
    L = x.shape[1]
    p = CONV_W // 2
    xp = jnp.pad(x, ((0, 0), (p, p), (0, 0)))
    y = xp[:, 0:L] * w[0]
    for k in range(1, CONV_W):
        y = y + xp[:, k:k + L] * w[k]
    return y


def short_conv_mixer(h, w_in, conv_w, w_out):
    gate_b, gate_c, v = jnp.split(h @ w_in, 3, axis=-1)
    return (gate_b * dwconv_centred(gate_c * v, conv_w)) @ w_out


def hyena_filter_spectrum(L, w1, b1, w2, b2, w3, sin_freq):
    f32 = jnp.float32
    t = jnp.linspace(0.0, 1.0, L, dtype=f32)[:, None]
    bands = jnp.linspace(1e-4, HY_BANDS - 1, HY_BANDS, dtype=f32)[None, :]
    ang = (2.0 * math.pi / L) * jnp.arange(L, dtype=f32)[:, None] * bands
    z = jnp.concatenate([t, jnp.cos(ang), -jnp.sin(ang)], axis=-1)
    freq = sin_freq.astype(f32)
    a = jnp.sin(freq * (z @ w1.astype(f32) + b1.astype(f32)))
    a = jnp.sin(freq * (a @ w2.astype(f32) + b2.astype(f32)))
    h = (a @ w3.astype(f32)).reshape(L, 2, HY_ORDER, D_MODEL)
    deltas = jnp.abs(jnp.linspace(math.log(HY_TARGET) / HY_SLOW_DECAY,
                                  math.log(HY_TARGET) / HY_FAST_DECAY, D_MODEL, dtype=f32))
    h = h * jnp.exp(-t * deltas[None, :])[:, None, None, :]
    fwd = h[:, 0]
    bwd = h[1:, 1][::-1]
    full = jnp.concatenate([fwd, jnp.zeros((1, HY_ORDER, D_MODEL), f32), bwd], axis=0)
    full = full / jnp.sum(jnp.abs(full), axis=0, keepdims=True)
    return jnp.fft.rfft(full, axis=0)


def long_conv(u, filt_f, skip):
    L = u.shape[1]
    uf = u.astype(jnp.float32)
    y = jnp.fft.irfft(jnp.fft.rfft(uf, n=2 * L, axis=1) * filt_f[None], n=2 * L, axis=1)[:, :L]
    return (y + uf * skip.astype(jnp.float32)).astype(u.dtype)


def hyena_mixer(h, w_in, conv_w, f_w1, f_b1, f_w2, f_b2, f_w3, sin_freq, skip, w_out):
    L = h.shape[1]
    parts = jnp.split(dwconv_centred(h @ w_in, conv_w), HY_ORDER + 1, axis=-1)
    z, gates = parts[0], parts[1:]
    filt = hyena_filter_spectrum(L, f_w1, f_b1, f_w2, f_b2, f_w3, sin_freq)
    for o in range(HY_ORDER):
        z = gates[o] * long_conv(z, filt[:, o], skip[o])
    return z @ w_out


def axial_rope_tables(n_tokens, dtype):
    f32 = jnp.float32
    rows = n_tokens // GRID_W
    row = jnp.repeat(jnp.arange(rows, dtype=f32), GRID_W)
    col = jnp.tile(jnp.arange(GRID_W, dtype=f32), rows)
    inv = ROPE_THETA ** (-jnp.arange(0, AXIS_DIM, 2, dtype=f32) / AXIS_DIM)

    def axis_angles(pos):
        a = pos[:, None] * inv[None, :]
        return jnp.concatenate([a, a], axis=-1)

    ang = jnp.concatenate([axis_angles(row), axis_angles(col)], axis=-1)
    return jnp.cos(ang).astype(dtype), jnp.sin(ang).astype(dtype)


def _rotate_axial(x):
    q = AXIS_DIM // 2
    xr, xc = x[..., :AXIS_DIM], x[..., AXIS_DIM:]
    return jnp.concatenate([-xr[..., q:], xr[..., :q], -xc[..., q:], xc[..., :q]], axis=-1)


def apply_rope(x, cos, sin):
    return x * cos + _rotate_axial(x) * sin


def _attend(q, k, v):
    s = jnp.einsum('bqkgd,bskd->bkgqs', q, k, preferred_element_type=jnp.float32) * (HEAD_DIM ** -0.5)
    p = jax.nn.softmax(s, axis=-1)
    return jnp.einsum('bkgqs,bskd->bqkgd', p.astype(v.dtype), v)


def gqa_mixer(h_lat, h_ctx, w_qkv, q_g, k_g, w_o, ctx_out):
    B, L, _ = h_lat.shape
    Lc = h_ctx.shape[1]
    QD = N_Q_HEADS * HEAD_DIM
    KVD = N_KV_HEADS * HEAD_DIM

    def heads_q(t, n):
        return rms_norm(t.reshape(B, n, N_KV_HEADS, Q_PER_KV, HEAD_DIM), q_g)

    def heads_kv(t, n):
        k = rms_norm(t[..., :KVD].reshape(B, n, N_KV_HEADS, HEAD_DIM), k_g)
        v = t[..., KVD:].reshape(B, n, N_KV_HEADS, HEAD_DIM)
        return k, v

    qkv_l = h_lat @ w_qkv
    q_l = heads_q(qkv_l[..., :QD], L)
    k_l, v_l = heads_kv(qkv_l[..., QD:], L)
    cos, sin = axial_rope_tables(L, q_l.dtype)
    q_l = apply_rope(q_l, cos[None, :, None, None], sin[None, :, None, None])
    k_l = apply_rope(k_l, cos[None, :, None], sin[None, :, None])
    if ctx_out:
        qkv_c = h_ctx @ w_qkv
        q_c = heads_q(qkv_c[..., :QD], Lc)
        kv_c = qkv_c[..., QD:]
    else:
        kv_c = h_ctx @ w_qkv[:, QD:]
    k_c, v_c = heads_kv(kv_c, Lc)

    k_all = jnp.concatenate([k_c, k_l], axis=1)
    v_all = jnp.concatenate([v_c, v_l], axis=1)
    n_blk = L // Q_BLOCK
    qb = jnp.moveaxis(q_l.reshape(B, n_blk, Q_BLOCK, N_KV_HEADS, Q_PER_KV, HEAD_DIM), 1, 0)
    o_l = lax.map(lambda qblk: _attend(qblk, k_all, v_all), qb)
    y_l = jnp.moveaxis(o_l, 0, 1).reshape(B, L, QD) @ w_o
    y_c = _attend(q_c, k_c, v_c).reshape(B, Lc, QD) @ w_o if ctx_out else None
    return y_l, y_c


def expert_choice_ffn(h, w_router, w_gate, w_up, w_down):
    B, N, D = h.shape
    cap = EC_CAPACITY_FACTOR * N // N_EXPERTS
    aff = jax.nn.softmax((h @ w_router).astype(jnp.float32), axis=-1)
    g, idx = lax.top_k(jnp.swapaxes(aff, 1, 2), cap)
    xs = jax.vmap(lambda hb, ib: hb[ib])(h, idx)
    hid = jax.nn.silu(jnp.einsum('becd,edf->becf', xs, w_gate)) * jnp.einsum('becd,edf->becf', xs, w_up)
    ys = jnp.einsum('becf,efd->becd', hid, w_down) * g[..., None].astype(h.dtype)
    return jax.vmap(lambda yb, ib: jnp.zeros((N, D), yb.dtype).at[ib.reshape(-1)].add(yb.reshape(-1, D)))(ys, idx)


def setup_inputs(seed: int = 0) -> dict:
    key = jax.random.key(seed)
    ks = iter(jax.random.split(key, 40))
    D, F = D_MODEL, D_EXPERT
    nA, nB, nC = (len(_layers_of(k)) for k in range(N_MIXERS))
    QKV = (N_Q_HEADS + 2 * N_KV_HEADS) * HEAD_DIM

    def nrm(shape, s):
        return jax.random.normal(next(ks), shape, jnp.float32) * s

    return {
        "x": nrm((BATCH, SEQ, D), 1.0),
        "c": nrm((BATCH, D), 1.0),
        "ctx": nrm((BATCH, CTX_LEN, D), 1.0),
        "c_ctx": nrm((D,), 1.0),
        "ada_w": nrm((DEPTH, D, 6 * D), 0.5 * D ** -0.5),
        "ada_b": nrm((DEPTH, 6 * D), 0.01),
        "norm_g": 1.0 + nrm((DEPTH, 2, D), 0.02),
        "sc_w_in": nrm((nA, D, 3 * D), D ** -0.5),
        "sc_conv": nrm((nA, CONV_W, D), CONV_W ** -0.5),
        "sc_w_out": nrm((nA, D, D), D ** -0.5),
        "hy_w_in": nrm((nB, D, (HY_ORDER + 1) * D), D ** -0.5),
        "hy_conv": nrm((nB, CONV_W, (HY_ORDER + 1) * D), CONV_W ** -0.5),
        "hy_f_w1": nrm((nB, HY_EMB, HY_FILTER_HIDDEN), HY_EMB ** -0.5),
        "hy_f_b1": nrm((nB, HY_FILTER_HIDDEN), 0.02),
        "hy_f_w2": nrm((nB, HY_FILTER_HIDDEN, HY_FILTER_HIDDEN), HY_FILTER_HIDDEN ** -0.5),
        "hy_f_b2": nrm((nB, HY_FILTER_HIDDEN), 0.02),
        "hy_f_w3": nrm((nB, HY_FILTER_HIDDEN, 2 * HY_ORDER * D), HY_FILTER_HIDDEN ** -0.5),
        "hy_sin_freq": 1.0 + nrm((nB, HY_FILTER_HIDDEN), 0.02),
        "hy_skip": nrm((nB, HY_ORDER, D), 1.0),
        "hy_w_out": nrm((nB, D, D), D ** -0.5),
        "at_w_qkv": nrm((nC, D, QKV), D ** -0.5),
        "at_q_g": 1.0 + nrm((nC, HEAD_DIM), 0.02),
        "at_k_g": 1.0 + nrm((nC, HEAD_DIM), 0.02),
        "at_w_o": nrm((nC, N_Q_HEADS * HEAD_DIM, D), (N_Q_HEADS * HEAD_DIM) ** -0.5),
        "moe_router": nrm((DEPTH, D, N_EXPERTS), D ** -0.5),
        "moe_w_gate": nrm((DEPTH, N_EXPERTS, D, F), D ** -0.5),
        "moe_w_up": nrm((DEPTH, N_EXPERTS, D, F), D ** -0.5),
        "moe_w_down": nrm((DEPTH, N_EXPERTS, F, D), F ** -0.5),
    }


def reference(x, c, ctx, c_ctx, ada_w, ada_b, norm_g, sc_w_in, sc_conv, sc_w_out,
              hy_w_in, hy_conv, hy_f_w1, hy_f_b1, hy_f_w2, hy_f_b2, hy_f_w3, hy_sin_freq, hy_skip, hy_w_out,
              at_w_qkv, at_q_g, at_k_g, at_w_o, moe_router, moe_w_gate, moe_w_up, moe_w_down):
    last_attn = max(_layers_of(MIX_ATTN), default=-1)
    lat, cx = x, ctx
    silu_c = jax.nn.silu(c)
    silu_cc = jax.nn.silu(c_ctx)
    for i in range(DEPTH):
        kind = i % N_MIXERS
        j = i // N_MIXERS
        need_ctx = i <= last_attn
        upd_ctx = i < last_attn

        m_l = (silu_c @ ada_w[i] + ada_b[i])[:, None, :]
        sh1, sc1, g1, sh2, sc2, g2 = jnp.split(m_l, 6, axis=-1)
        hl = modulate(rms_norm(lat, norm_g[i, 0]), sh1, sc1)
        if need_ctx:
            m_c = silu_cc @ ada_w[i] + ada_b[i]
            csh1, csc1, cg1, csh2, csc2, cg2 = jnp.split(m_c, 6, axis=-1)
            hc = modulate(rms_norm(cx, norm_g[i, 0]), csh1, csc1)

        yc = None
        if kind == MIX_SHORTCONV:
            yl = short_conv_mixer(hl, sc_w_in[j], sc_conv[j], sc_w_out[j])
            if upd_ctx:
                yc = short_conv_mixer(hc, sc_w_in[j], sc_conv[j], sc_w_out[j])
        elif kind == MIX_HYENA:
            hy_args = (hy_w_in[j], hy_conv[j], hy_f_w1[j], hy_f_b1[j], hy_f_w2[j], hy_f_b2[j],
                       hy_f_w3[j], hy_sin_freq[j], hy_skip[j], hy_w_out[j])
            yl = hyena_mixer(hl, *hy_args)
            if upd_ctx:
                yc = hyena_mixer(hc, *hy_args)
        else:
            yl, yc = gqa_mixer(hl, hc, at_w_qkv[j], at_q_g[j], at_k_g[j], at_w_o[j], upd_ctx)

        lat = lat + g1 * yl
        hl2 = modulate(rms_norm(lat, norm_g[i, 1]), sh2, sc2)
        lat = lat + g2 * expert_choice_ffn(hl2, moe_router[i], moe_w_gate[i], moe_w_up[i], moe_w_down[i])
        if upd_ctx:
            cx = cx + cg1 * yc
            hc2 = modulate(rms_norm(cx, norm_g[i, 1]), csh2, csc2)
            cx = cx + cg2 * expert_choice_ffn(hc2, moe_router[i], moe_w_gate[i], moe_w_up[i], moe_w_down[i])
    return lat
```

```cpp
#include <hip/hip_runtime.h>
#include <cstdio>
#include <cstdint>

#define GAS __attribute__((address_space(1)))
#define LAS __attribute__((address_space(3)))
typedef unsigned short bf16_t;
typedef short bf16x8 __attribute__((ext_vector_type(8)));
typedef float f32x4 __attribute__((ext_vector_type(4)));
typedef float f32x2 __attribute__((ext_vector_type(2)));
typedef unsigned u32x4 __attribute__((ext_vector_type(4)));
typedef unsigned u32x2 __attribute__((ext_vector_type(2)));

constexpr int DM = 1024, NB = 8, SEQ = 4096, CTXL = 256, DEPTH = 4;
constexpr int NLAT = NB * SEQ, NCTX = NB * CTXL, MALL = NLAT + NCTX;
constexpr int NE = 16, CAPL = 512, CAPC = 32, REL = NB * CAPL, REC = NB * CAPC;
constexpr int MODW = 6 * DM;
constexpr float EPS = 1e-6f;

constexpr size_t MiB = 1u << 20;
constexpr size_t WS_CTL = 0, CTL_ZERO_BYTES = 1 * MiB;
constexpr size_t WS_MODV = 1 * MiB;
constexpr size_t WS_A2 = 2 * MiB;
constexpr size_t WS_A2C = WS_A2 + 4096 * 64 * 4;
constexpr size_t WS_TW = WS_A2C + 256 * 64 * 4;
constexpr size_t WS_AFF = 4 * MiB;
constexpr size_t WS_AFFC = WS_AFF + 2 * MiB;
constexpr size_t WS_ROWL = 7 * MiB;
constexpr size_t WS_GL = WS_ROWL + 512 * 1024;
constexpr size_t WS_SLOT = 8 * MiB;
constexpr size_t WS_WMIX = 11 * MiB;
constexpr size_t WS_WMOE = 43 * MiB;
constexpr size_t WS_WMOE_DN = WS_WMOE + 64 * MiB;
constexpr size_t WS_LAT = 139 * MiB;
constexpr size_t WS_HL = 275 * MiB;
constexpr size_t WS_U = 343 * MiB;
constexpr size_t WS_Z = 547 * MiB;
constexpr size_t WS_H = 615 * MiB;
constexpr size_t WS_YS = 751 * MiB;
constexpr size_t WS_END = 887 * MiB;
constexpr size_t WM_SC_IN = 0;
constexpr size_t WM_SC_OUT = WM_SC_IN + 2ull * 3072 * 1024;
constexpr size_t WM_HY_IN = WM_SC_OUT + 2ull * 1024 * 1024;
constexpr size_t WM_HY_OUT = WM_HY_IN + 3072ull * 1024;
constexpr size_t WM_AT_QKV = WM_HY_OUT + 1024ull * 1024;
constexpr size_t WM_AT_O = WM_AT_QKV + 1536ull * 1024;
static_assert((WM_AT_O + 1024ull * 1024) * 2 <= 32 * MiB, "mixer weights");
constexpr int CW_BAR = 4096;
constexpr int CW_WQ = 16384;

constexpr int LDS_MAIN = 155648;
constexpr int LDS_MISC = LDS_MAIN;
constexpr int LDS_BYTES = LDS_MAIN + 4096;

#define LDS_WAIT() asm volatile("s_waitcnt lgkmcnt(0)" ::: "memory")
#define VM_WAIT() asm volatile("s_waitcnt vmcnt(0)" ::: "memory")

__device__ __forceinline__ unsigned f2bf(float f) { unsigned u = __builtin_bit_cast(unsigned, f); return (u + 0x7fffu + ((u >> 16) & 1u)) >> 16; }
__device__ __forceinline__ unsigned pk2(float lo, float hi) { return f2bf(lo) | (f2bf(hi) << 16); }
__device__ __forceinline__ float bf_lo(unsigned w) { return __uint_as_float(w << 16); }
__device__ __forceinline__ float bf_hi(unsigned w) { return __uint_as_float(w & 0xffff0000u); }
__device__ __forceinline__ float bf1(bf16_t b) { return __uint_as_float(((unsigned)b) << 16); }
__device__ __forceinline__ float wave_sum(float v) {
#pragma unroll
    for (int o = 1; o < 64; o <<= 1) v += __shfl_xor(v, o);
    return v;
}
__device__ __forceinline__ int wave_sum_i(int v) {
#pragma unroll
    for (int o = 1; o < 64; o <<= 1) v += __shfl_xor(v, o);
    return v;
}

#define XB_TMO      128
#define XB_XCNT(j)  (256  + 64 * (j))
#define XB_XSUB(j)  (1280 + 64 * (j))
#define XB_XGEN(j)  (2304 + 64 * (j))
#define XB_TOP      3328
#define XB_TOPGEN   3392
#define XCD_BAR_WORDS 3456
#define XB_SPIN_CAP (1u << 22)

__device__ __forceinline__ unsigned xb_ld(unsigned* p)              { return __hip_atomic_load(p, __ATOMIC_RELAXED, __HIP_MEMORY_SCOPE_AGENT); }
__device__ __forceinline__ unsigned xb_add(unsigned* p, unsigned v) { return __hip_atomic_fetch_add(p, v, __ATOMIC_RELAXED, __HIP_MEMORY_SCOPE_AGENT); }
__device__ __forceinline__ unsigned xb_xcc_id() { return (unsigned)__builtin_amdgcn_s_getreg((3 << 11) | 20) & 0xFu; }
#define XB_SPIN(cond, bar) do { unsigned _sp = 0; while (cond) { __builtin_amdgcn_s_sleep(1); \
    if ((++_sp & 255u) == 0u) { if (xb_ld(&(bar)[XB_TMO])) break; if (_sp > XB_SPIN_CAP) { atomicAdd(&(bar)[XB_TMO], 1u); break; } } } } while (0)

struct XcdBarrier { unsigned* bar; unsigned x; volatile LAS unsigned* st; };

__device__ __forceinline__ XcdBarrier xcd_barrier_post(unsigned* bar, volatile LAS unsigned* st) {
    XcdBarrier b; b.bar = bar; b.x = xb_xcc_id(); b.st = st;
    if (threadIdx.x == 0) (void)xb_add(&bar[XB_XCNT(b.x)], 1u);
    return b;
}
__device__ __forceinline__ void xcd_barrier_complete(unsigned* bar, unsigned x, unsigned& nloc, unsigned& nx) {
    const unsigned G = gridDim.x * gridDim.y * gridDim.z;
    unsigned sum, cnt, mine, sp = 0u;
    for (;;) {
        sum = 0u; cnt = 0u; mine = 0u;
#pragma unroll
        for (unsigned j = 0; j < 16; ++j) { const unsigned c = xb_ld(&bar[XB_XCNT(j)]); sum += c; cnt += (c > 0u) ? 1u : 0u; mine = (j == x) ? c : mine; }
        if (sum == G) break;
        __builtin_amdgcn_s_sleep(1);
        if ((++sp & 255u) == 0u) { if (xb_ld(&bar[XB_TMO])) break; if (sp > XB_SPIN_CAP) { atomicAdd(&bar[XB_TMO], 1u); break; } }
    }
    nloc = mine > 0u ? mine : 1u; nx = cnt > 0u ? cnt : 1u;
}
__device__ __forceinline__ void xcd_barrier(const XcdBarrier& b) {
    asm volatile("s_waitcnt vmcnt(0)" ::: "memory");
    __syncthreads();
    if (threadIdx.x == 0) {
        unsigned* bar = b.bar;
        __builtin_amdgcn_s_waitcnt(0);
        unsigned nloc = b.st[0], nx = b.st[1];
        if (nloc == 0u) { xcd_barrier_complete(bar, b.x, nloc, nx); b.st[0] = nloc; b.st[1] = nx; }
        const unsigned old = xb_add(&bar[XB_XSUB(b.x)], 1u);
        const unsigned gen = old / nloc;
        if (old + 1u == (gen + 1u) * nloc) {
            __builtin_amdgcn_fence(__ATOMIC_RELEASE, "agent");
            asm volatile("s_waitcnt vmcnt(0)" ::: "memory");
            const unsigned og = xb_add(&bar[XB_TOP], 1u);
            const unsigned tg = og / nx;
            if (og + 1u == (tg + 1u) * nx) xb_add(&bar[XB_TOPGEN], 1u);
            else XB_SPIN(xb_ld(&bar[XB_TOPGEN]) == tg, bar);
            __builtin_amdgcn_fence(__ATOMIC_ACQUIRE, "agent");
            xb_add(&bar[XB_XGEN(b.x)], 1u);
            asm volatile("s_waitcnt vmcnt(0)" ::: "memory");
        } else {
            XB_SPIN(xb_ld(&bar[XB_XGEN(b.x)]) == gen, bar);
            __builtin_amdgcn_fence(__ATOMIC_ACQUIRE, "agent");
            asm volatile("s_waitcnt vmcnt(0)" ::: "memory");
        }
    }
    __syncthreads();
}

namespace pg8 {
constexpr int BM = 256, BK = 64, HALF = 128, HTB = HALF * BK * 2, STAGE_BYTES = 8 * HTB, NXCD = 8, WGM = 8;
__host__ __device__ __forceinline__ int lds_byte(int r, int c) { const int st = (r >> 4) * 2 + (c >> 5), rr = r & 15, cc = c & 31, ob = rr * 64 + cc * 2; return st * 1024 + (ob ^ (((ob >> 9) & 1) << 5)); }
__host__ __device__ __forceinline__ void stage_rc(int b, int& R, int& C) { const int st = b / 1024, sb = b % 1024, swz = sb ^ (((sb >> 9) & 1) << 5); R = (st >> 1) * 16 + swz / 64; C = (st & 1) * 32 + (swz % 64) / 2; }
__host__ __device__ __forceinline__ int perm32(int rho) { const int n = rho >> 4, i = rho & 15; return 8 * (i >> 2) + 4 * n + (i & 3); }

struct Unit { int pm, pn; };
struct Gemm { const bf16_t* A; const bf16_t* Bt; int M, N, K; int tpg; const int* rowlist; };

struct StaticOrder {
    int nM, nN, nwg, G, c;
    __device__ void init(int M, int N, int G_, int c_) { nM = M / BM; nN = N / BM; nwg = nM * nN; G = G_; c = c_; }
    __device__ bool next(int i, Unit& u) const {
        const long L = (long)i * G + c; if (L >= nwg) return false;
        int wgid = (int)L; { const int q = nwg / NXCD, r = nwg % NXCD, xcd = wgid % NXCD, off = wgid / NXCD; wgid = (xcd < r ? xcd * (q + 1) : r * (q + 1) + (xcd - r) * q) + off; }
        const int nig = WGM * nN, gid = wgid / nig, fm = gid * WGM, gsz = (nM - fm) < WGM ? (nM - fm) : WGM;
        u.pm = fm + ((wgid % nig) % gsz); u.pn = (wgid % nig) / gsz; return true;
    }
};

__device__ __forceinline__ unsigned cvt_pk_bf16(float lo, float hi) { unsigned r; asm volatile("v_cvt_pk_bf16_f32 %0, %1, %2" : "=v"(r) : "v"(lo), "v"(hi)); return r; }

template <class Epi, class Sched, bool GATHER>
__device__ __forceinline__ void gemm_phase(LAS unsigned char* lds, const Gemm g, const Sched& S, const Epi& E) {
    const int tid = threadIdx.x, wid = __builtin_amdgcn_readfirstlane(tid >> 6), lane = tid & 63, wr = wid >> 2, wc = wid & 3, fr = lane & 15, fq = lane >> 4;
    const int K = g.K, nt = K / BK, nN = g.N / BM;
    const size_t kstep = (size_t)(BK * 2);
    const size_t hstep = (size_t)HALF * K * 2;
    const size_t tstep = 2 * hstep;
    unsigned voffB[2], vA0[2], vA1[2], nA0[2], nA1[2]; int RA[2], CA[2];
#pragma unroll
    for (int i = 0; i < 2; ++i) { int R, C; stage_rc(tid * 16 + i * 8192, R, C); const int Rb = Epi::PERM ? ((R & ~31) + perm32(R & 31)) : R;
        RA[i] = R; CA[i] = C;
        vA0[i] = (unsigned)(R * K + C) * 2u; vA1[i] = vA0[i] + (unsigned)hstep; nA0[i] = vA0[i]; nA1[i] = vA1[i];
        voffB[i] = (unsigned)(Rb * K + C) * 2u; }
    const unsigned ldsw = (unsigned)wid * 1024u;
    const int aoff = lds_byte(wr * 64 + fr, fq * 8), boff = lds_byte(wc * 32 + fr, fq * 8);
#define PG8_SA(b, h) (((b) * 2 + (h)) * HTB)
#define PG8_SB(b, h) ((4 + (b) * 2 + (h)) * HTB)
#define PG8_STAGE(bufoff, gbase, voff) do { _Pragma("unroll") for (int _i = 0; _i < 2; ++_i) \
        __builtin_amdgcn_global_load_lds((const unsigned*)((const char*)(gbase) + (voff)[_i]), (LAS unsigned*)(lds + (bufoff) + ldsw + _i * 8192), 16, 0, 0); } while (0)
#define PG8_LDA(dst, b, h) do { _Pragma("unroll") for (int m = 0; m < 4; ++m) _Pragma("unroll") for (int k = 0; k < 2; ++k) dst[m][k] = *(const LAS bf16x8*)(lds + PG8_SA(b, h) + aoff + m * 2048 + k * 1024); } while (0)
#define PG8_LDB(dst, b, h) do { _Pragma("unroll") for (int n = 0; n < 2; ++n) _Pragma("unroll") for (int k = 0; k < 2; ++k) dst[n][k] = *(const LAS bf16x8*)(lds + PG8_SB(b, h) + boff + n * 2048 + k * 1024); } while (0)
#define PG8_MMA(ai, bj, At, Bt) do { __builtin_amdgcn_s_setprio(1); _Pragma("unroll") for (int m = 0; m < 4; ++m) _Pragma("unroll") for (int n = 0; n < 2; ++n) _Pragma("unroll") for (int k = 0; k < 2; ++k) \
        acc[ai][bj][m][n] = __builtin_amdgcn_mfma_f32_16x16x32_bf16(Bt[n][k], At[m][k], acc[ai][bj][m][n], 0, 0, 0); __builtin_amdgcn_s_setprio(0); } while (0)
#define PG8_WAIT_V(n) asm volatile("s_waitcnt vmcnt(" #n ")" ::: "memory")
#define PG8_WAIT_L(n) asm volatile("s_waitcnt lgkmcnt(" #n ")" ::: "memory")
#define PG8_BAR __builtin_amdgcn_s_barrier()
#define PG8_SCHED __builtin_amdgcn_sched_barrier(0)
    Unit cur, nxt; int ui = 0;
    if (!S.next(0, cur)) return;
    f32x4 acc[2][2][4][2];
#pragma unroll
    for (int a = 0; a < 2; ++a)
#pragma unroll
        for (int b = 0; b < 2; ++b)
#pragma unroll
            for (int m = 0; m < 4; ++m)
#pragma unroll
                for (int n = 0; n < 2; ++n) acc[a][b][m][n] = (f32x4){0.f, 0.f, 0.f, 0.f};
    bf16x8 At[4][2], B0[2][2], B1[2][2];
    const char* cA; const char* cB = (const char*)g.Bt + (size_t)((cur.pm / g.tpg) * nN + cur.pn) * tstep;
    if (GATHER) {
        cA = (const char*)g.A;
#pragma unroll
        for (int i = 0; i < 2; ++i) { const int r0 = g.rowlist[cur.pm * BM + RA[i]], r1 = g.rowlist[cur.pm * BM + HALF + RA[i]];
            vA0[i] = (unsigned)(r0 * K + CA[i]) * 2u; vA1[i] = (unsigned)(r1 * K + CA[i]) * 2u; }
    } else cA = (const char*)g.A + (size_t)cur.pm * tstep;
    PG8_STAGE(PG8_SB(0, 0), cB, voffB); PG8_STAGE(PG8_SA(0, 0), cA, vA0); PG8_STAGE(PG8_SB(0, 1), cB + hstep, voffB); PG8_STAGE(PG8_SA(0, 1), cA, vA1);
    if (wr == 1) PG8_BAR;
    PG8_WAIT_V(4); PG8_BAR;
    PG8_STAGE(PG8_SB(1, 0), cB + kstep, voffB); PG8_STAGE(PG8_SA(1, 0), cA + kstep, vA0); PG8_STAGE(PG8_SB(1, 1), cB + hstep + kstep, voffB);
    PG8_WAIT_V(6); PG8_BAR;
    for (;;) {
        const bool has_next = S.next(ui + 1, nxt);
        const char* nA; const char* nB = has_next ? (const char*)g.Bt + (size_t)((nxt.pm / g.tpg) * nN + nxt.pn) * tstep : cB;
        if (GATHER) {
            nA = cA;
            if (has_next) {
#pragma unroll
                for (int i = 0; i < 2; ++i) { const int r0 = g.rowlist[nxt.pm * BM + RA[i]], r1 = g.rowlist[nxt.pm * BM + HALF + RA[i]];
                    nA0[i] = (unsigned)(r0 * K + CA[i]) * 2u; nA1[i] = (unsigned)(r1 * K + CA[i]) * 2u; }
            } else {
#pragma unroll
                for (int i = 0; i < 2; ++i) { nA0[i] = vA0[i]; nA1[i] = vA1[i]; }
            }
        } else nA = has_next ? (const char*)g.A + (size_t)nxt.pm * tstep : cA;
        for (int t = 0; t < nt; t += 2) {
            const bool last = (t == nt - 2);
            const char* a1 = cA + (size_t)(t + 1) * kstep;
            const char* a2 = last ? nA : cA + (size_t)(t + 2) * kstep; const char* b2 = last ? nB : cB + (size_t)(t + 2) * kstep;
            const char* a3 = a2 + kstep; const char* b3 = b2 + kstep;
            unsigned s0[2], s1[2];
#pragma unroll
            for (int i = 0; i < 2; ++i) { s0[i] = (GATHER && last) ? nA0[i] : vA0[i]; s1[i] = (GATHER && last) ? nA1[i] : vA1[i]; }
            PG8_LDB(B0, 0, 0); PG8_SCHED; PG8_LDA(At, 0, 0); PG8_STAGE(PG8_SA(1, 1), a1, vA1);
            PG8_WAIT_L(8); PG8_BAR; PG8_WAIT_L(0); PG8_MMA(0, 0, At, B0); PG8_BAR; PG8_SCHED;
            PG8_LDB(B1, 0, 1); PG8_STAGE(PG8_SB(0, 0), b2, voffB);
            PG8_BAR; PG8_WAIT_L(0); PG8_MMA(0, 1, At, B1); PG8_BAR;
            PG8_LDA(At, 0, 1); PG8_STAGE(PG8_SA(0, 0), a2, s0);
            PG8_BAR; PG8_WAIT_L(0); PG8_MMA(1, 0, At, B0); PG8_BAR; PG8_SCHED;
            PG8_STAGE(PG8_SB(0, 1), b2 + hstep, voffB);
            PG8_WAIT_V(6); PG8_BAR; PG8_MMA(1, 1, At, B1); PG8_BAR;
            PG8_LDB(B0, 1, 0); PG8_SCHED; PG8_LDA(At, 1, 0); PG8_STAGE(PG8_SA(0, 1), a2, s1);
            PG8_WAIT_L(8); PG8_BAR; PG8_WAIT_L(0); PG8_MMA(0, 0, At, B0); PG8_BAR; PG8_SCHED;
            PG8_LDB(B1, 1, 1); PG8_STAGE(PG8_SB(1, 0), b3, voffB);
            PG8_BAR; PG8_WAIT_L(0); PG8_MMA(0, 1, At, B1); PG8_BAR;
            PG8_LDA(At, 1, 1); PG8_STAGE(PG8_SA(1, 0), a3, s0);
            PG8_BAR; PG8_WAIT_L(0); PG8_MMA(1, 0, At, B0); PG8_BAR; PG8_SCHED;
            PG8_STAGE(PG8_SB(1, 1), b3 + hstep, voffB);
            PG8_WAIT_V(6); PG8_BAR; PG8_MMA(1, 1, At, B1); PG8_BAR;
        }
        E(acc, cur, wr, wc, fr, fq);
        if (!has_next) break;
#pragma unroll
        for (int a = 0; a < 2; ++a)
#pragma unroll
            for (int b = 0; b < 2; ++b)
#pragma unroll
                for (int m = 0; m < 4; ++m)
#pragma unroll
                    for (int n = 0; n < 2; ++n) acc[a][b][m][n] = (f32x4){0.f, 0.f, 0.f, 0.f};
        cur = nxt; cA = nA; cB = nB; ++ui;
        if (GATHER) {
#pragma unroll
            for (int i = 0; i < 2; ++i) { vA0[i] = nA0[i]; vA1[i] = nA1[i]; }
        }
    }
    PG8_WAIT_V(0);
    if (wr == 0) PG8_BAR;
    PG8_BAR;
#undef PG8_SA
#undef PG8_SB
#undef PG8_STAGE
#undef PG8_LDA
#undef PG8_LDB
#undef PG8_MMA
#undef PG8_WAIT_V
#undef PG8_WAIT_L
#undef PG8_BAR
#undef PG8_SCHED
}

struct EpiBf16 {
    static constexpr bool PERM = true;
    bf16_t* O; int ldc;
    __device__ __forceinline__ void operator()(const f32x4 (&acc)[2][2][4][2], const Unit& u, int wr, int wc, int fr, int fq) const {
        const int row0 = u.pm * BM + wr * 64 + fr, col0 = u.pn * BM + wc * 32 + 8 * fq;
#pragma unroll
        for (int ai = 0; ai < 2; ++ai)
#pragma unroll
            for (int m = 0; m < 4; ++m) { bf16_t* rowp = O + (size_t)(row0 + ai * HALF + m * 16) * ldc + col0;
#pragma unroll
                for (int bj = 0; bj < 2; ++bj) { const f32x4 v0 = acc[ai][bj][m][0], v1 = acc[ai][bj][m][1];
                    u32x4 w; w.x = cvt_pk_bf16(v0[0], v0[1]); w.y = cvt_pk_bf16(v0[2], v0[3]); w.z = cvt_pk_bf16(v1[0], v1[1]); w.w = cvt_pk_bf16(v1[2], v1[3]);
                    *(u32x4*)(rowp + bj * HALF) = w; } }
    }
};
struct EpiRes {
    static constexpr bool PERM = false;
    const float* baseL; const float* baseC; float* out; const float* gate;
    __device__ __forceinline__ void operator()(const f32x4 (&acc)[2][2][4][2], const Unit& u, int wr, int wc, int fr, int fq) const {
        const int row0 = u.pm * BM + wr * 64 + fr, col0 = u.pn * BM + wc * 32 + 4 * fq;
        const bool isc = u.pm >= NLAT / BM;
        const int midx = isc ? 8 : (u.pm >> 4);
        const float* gp = gate + (size_t)midx * MODW + col0;
        const float* bp = isc ? baseC + (size_t)(row0 - NLAT) * DM + col0 : baseL + (size_t)row0 * DM + col0;
        float* op = out + (size_t)row0 * DM + col0;
        f32x4 gv[2][2];
#pragma unroll
        for (int bj = 0; bj < 2; ++bj)
#pragma unroll
            for (int n = 0; n < 2; ++n) gv[bj][n] = *(const f32x4*)(gp + bj * HALF + n * 16);
#pragma unroll
        for (int ai = 0; ai < 2; ++ai)
#pragma unroll
            for (int m = 0; m < 4; ++m) { const size_t ro = (size_t)(ai * HALF + m * 16) * DM;
#pragma unroll
                for (int bj = 0; bj < 2; ++bj)
#pragma unroll
                    for (int n = 0; n < 2; ++n) { const f32x4 bs = *(const f32x4*)(bp + ro + bj * HALF + n * 16);
                        *(f32x4*)(op + ro + bj * HALF + n * 16) = bs + gv[bj][n] * acc[ai][bj][m][n]; }
                asm volatile("" ::: "memory"); }
    }
};
struct EpiMoeUp {
    static constexpr bool PERM = true;
    bf16_t* H;
    __device__ __forceinline__ void operator()(const f32x4 (&acc)[2][2][4][2], const Unit& u, int wr, int wc, int fr, int fq) const {
        const int row0 = u.pm * BM + wr * 64 + fr, col0 = u.pn * HALF + wc * 32 + 8 * fq;
#pragma unroll
        for (int ai = 0; ai < 2; ++ai)
#pragma unroll
            for (int m = 0; m < 4; ++m) { bf16_t* rowp = H + (size_t)(row0 + ai * HALF + m * 16) * DM + col0;
                float h[8];
#pragma unroll
                for (int n = 0; n < 2; ++n)
#pragma unroll
                    for (int j = 0; j < 4; ++j) { const float gt = acc[ai][0][m][n][j], up = acc[ai][1][m][n][j];
                        h[n * 4 + j] = gt * __builtin_amdgcn_rcpf(1.0f + __expf(-gt)) * up; }
                u32x4 w; w.x = cvt_pk_bf16(h[0], h[1]); w.y = cvt_pk_bf16(h[2], h[3]); w.z = cvt_pk_bf16(h[4], h[5]); w.w = cvt_pk_bf16(h[6], h[7]);
                *(u32x4*)rowp = w; }
    }
};
struct EpiMoeDown {
    static constexpr bool PERM = true;
    bf16_t* Y; const float* gl;
    __device__ __forceinline__ void operator()(const f32x4 (&acc)[2][2][4][2], const Unit& u, int wr, int wc, int fr, int fq) const {
        const int row0 = u.pm * BM + wr * 64 + fr, col0 = u.pn * BM + wc * 32 + 8 * fq;
#pragma unroll
        for (int ai = 0; ai < 2; ++ai)
#pragma unroll
            for (int m = 0; m < 4; ++m) { const int row = row0 + ai * HALF + m * 16; const float gg = gl[row]; bf16_t* rowp = Y + (size_t)row * DM + col0;
#pragma unroll
                for (int bj = 0; bj < 2; ++bj) { const f32x4 v0 = acc[ai][bj][m][0] * gg, v1 = acc[ai][bj][m][1] * gg;
                    u32x4 w; w.x = cvt_pk_bf16(v0[0], v0[1]); w.y = cvt_pk_bf16(v0[2], v0[3]); w.z = cvt_pk_bf16(v1[0], v1[1]); w.w = cvt_pk_bf16(v1[2], v1[3]);
                    *(u32x4*)(rowp + bj * HALF) = w; } }
    }
};
}


namespace att {
constexpr int D = 128, NW = 8, QBLK = 32, KVBLK = 64;
constexpr float SCALE = 0.088388347648318440f;
constexpr float THR = 8.f;
constexpr int SDEPTH = 2;
constexpr int LDQ = 1536, LDK = 256, LDO = 1024;
constexpr size_t SHM_V = KVBLK * D * 2, SHM_K = KVBLK * D * 2, SHM_ATTN = 2 * SHM_V + 2 * SHM_K + NW * 64 * 4;
using s16x4  = __attribute__((ext_vector_type(4))) short;
using f32x16 = __attribute__((ext_vector_type(16))) float;
#define KSWZ(row, colB) ((row) * 256 + ((colB) ^ (((row) & 7) << 4)))
#define SBAR() __builtin_amdgcn_sched_barrier(0)
__device__ __forceinline__ int crow(int r, int hi) { return (r & 3) + 8 * (r >> 2) + 4 * hi; }
__device__ __forceinline__ unsigned cvtpk(float lo, float hi) { unsigned r; asm volatile("v_cvt_pk_bf16_f32 %0, %1, %2" : "=v"(r) : "v"(lo), "v"(hi)); return r; }
__device__ __forceinline__ bf16x8 ld8(const bf16_t* p) { return *reinterpret_cast<const bf16x8*>(p); }

__device__ __forceinline__ void partialSM(f32x16& p0, f32x16& p1, float& m_reg, float& mn, float& alpha) {
  constexpr float C = SCALE * 1.4426950408889634f;
  float pmax = p0[0]; for (int r = 1; r < 16; ++r) pmax = fmaxf(pmax, p0[r]); for (int r = 0; r < 16; ++r) pmax = fmaxf(pmax, p1[r]);
  { auto rr = __builtin_amdgcn_permlane32_swap(__float_as_uint(pmax), __float_as_uint(pmax), false, false);
    pmax = fmaxf(__uint_as_float(rr[0]), __uint_as_float(rr[1])); }
  if (__builtin_expect(__all(pmax - m_reg <= THR / SCALE), 1)) { mn = m_reg; alpha = 1.f; }
  else { mn = fmaxf(m_reg, pmax); alpha = __builtin_amdgcn_exp2f((m_reg - mn) * C); m_reg = mn; }
  float mnC = -mn * C;
  for (int r = 0; r < 16; ++r) p0[r] = fmaf(p0[r], C, mnC); for (int r = 0; r < 16; ++r) p1[r] = fmaf(p1[r], C, mnC);
  for (int r = 0; r < 16; ++r) p0[r] = __builtin_amdgcn_exp2f(p0[r]);
}
__device__ __forceinline__ void finishSM(f32x16& p0, f32x16& p1, float alpha, float& l_reg, bf16x8& pa0, bf16x8& pa1, bf16x8& pa2, bf16x8& pa3) {
  for (int r = 0; r < 16; ++r) p1[r] = __builtin_amdgcn_exp2f(p1[r]);
  float ps = 0; for (int r = 0; r < 16; ++r) ps += p0[r]; for (int r = 0; r < 16; ++r) ps += p1[r];
  { auto rr = __builtin_amdgcn_permlane32_swap(__float_as_uint(ps), __float_as_uint(ps), false, false);
    ps = __uint_as_float(rr[0]) + __uint_as_float(rr[1]); }
  l_reg = l_reg * alpha + ps;
#define PK4(P, BASE, OUT) do { unsigned a0 = cvtpk(P[BASE + 0], P[BASE + 1]), a1 = cvtpk(P[BASE + 2], P[BASE + 3]);   \
    unsigned b0 = cvtpk(P[BASE + 4], P[BASE + 5]), b1 = cvtpk(P[BASE + 6], P[BASE + 7]);                              \
    auto r0 = __builtin_amdgcn_permlane32_swap(a0, b0, false, false); auto r1 = __builtin_amdgcn_permlane32_swap(a1, b1, false, false); \
    u32x4 w = {r0[0], r1[0], r0[1], r1[1]}; OUT = *reinterpret_cast<bf16x8*>(&w); } while (0)
  PK4(p0, 0, pa0); PK4(p0, 8, pa1); PK4(p1, 0, pa2); PK4(p1, 8, pa3);
#undef PK4
}
__device__ __forceinline__ void qkt(f32x16& p0, f32x16& p1, const bf16_t* Ks, const bf16x8* qr, int r32, int hi) {
  p0 = f32x16{}; p1 = f32x16{};
  for (int d0 = 0; d0 < 8; ++d0) { int cb = (d0 * 16 + hi * 8) * 2;
    bf16x8 b0 = *reinterpret_cast<const bf16x8*>((const char*)Ks + KSWZ(r32, cb));
    bf16x8 b1 = *reinterpret_cast<const bf16x8*>((const char*)Ks + KSWZ(32 + r32, cb));
    p0 = __builtin_amdgcn_mfma_f32_32x32x16_bf16(b0, qr[d0], p0, 0, 0, 0);
    p1 = __builtin_amdgcn_mfma_f32_32x32x16_bf16(b1, qr[d0], p1, 0, 0, 0); }
}
__device__ __forceinline__ int v_st(int k, int c) { const int kk = (k & ~0xC) | ((k & 4) << 1) | ((k & 8) >> 1); return ((kk >> 3) * 4 + (c >> 5)) * 512 + ((kk & 7) * 32 + (c & 31)) * 2; }
__device__ __forceinline__ int v_rd_base(int lane) { return ((lane & 3) << 3) | (((lane >> 2) & 3) << 6) | (((lane >> 4) & 1) << 5) | (((lane >> 5) & 1) << 8); }
constexpr int v_rd_off(int d0, int ks, int half) { return d0 * 512 + ks * 4096 + half * 2048; }
template <int OFF> __device__ __forceinline__ s16x4 tr_read(int vb) {
  s16x4 r; asm volatile("ds_read_b64_tr_b16 %0, %1 offset:%2" : "=&v"(r) : "v"(vb), "i"(OFF) : "memory"); return r;
}
template <int D0> __device__ __forceinline__ void pv_one(f32x16& od, int vb, bf16x8 pa0, bf16x8 pa1, bf16x8 pa2, bf16x8 pa3) {
  const s16x4 l0 = tr_read<v_rd_off(D0, 0, 0)>(vb), h0 = tr_read<v_rd_off(D0, 0, 1)>(vb), l1 = tr_read<v_rd_off(D0, 1, 0)>(vb), h1 = tr_read<v_rd_off(D0, 1, 1)>(vb);
  const s16x4 l2 = tr_read<v_rd_off(D0, 2, 0)>(vb), h2 = tr_read<v_rd_off(D0, 2, 1)>(vb), l3 = tr_read<v_rd_off(D0, 3, 0)>(vb), h3 = tr_read<v_rd_off(D0, 3, 1)>(vb);
  asm volatile("s_waitcnt lgkmcnt(0)" ::: "memory"); SBAR();
#define PK(L, H) (bf16x8){L[0], L[1], L[2], L[3], H[0], H[1], H[2], H[3]}
  od = __builtin_amdgcn_mfma_f32_32x32x16_bf16(pa0, PK(l0, h0), od, 0, 0, 0);
  od = __builtin_amdgcn_mfma_f32_32x32x16_bf16(pa1, PK(l1, h1), od, 0, 0, 0);
  od = __builtin_amdgcn_mfma_f32_32x32x16_bf16(pa2, PK(l2, h2), od, 0, 0, 0);
  od = __builtin_amdgcn_mfma_f32_32x32x16_bf16(pa3, PK(l3, h3), od, 0, 0, 0);
#undef PK
}
__device__ __forceinline__ void pv_d0(f32x16* o, int vb, bf16x8 pa0, bf16x8 pa1, bf16x8 pa2, bf16x8 pa3) {
  pv_one<0>(o[0], vb, pa0, pa1, pa2, pa3); pv_one<1>(o[1], vb, pa0, pa1, pa2, pa3); pv_one<2>(o[2], vb, pa0, pa1, pa2, pa3); pv_one<3>(o[3], vb, pa0, pa1, pa2, pa3);
}
__device__ __forceinline__ void attn_dense_body(const bf16_t* __restrict__ Qb, const bf16_t* __restrict__ Kh, const bf16_t* __restrict__ Vh,
                                                bf16_t* __restrict__ Ob, int seq, char* lds) {
  const int tid = threadIdx.x, wid = tid >> 6, lane = tid & 63, r32 = lane & 31, hi = lane >> 5;
  bf16_t* V_lds = (bf16_t*)lds; bf16_t* K_lds = (bf16_t*)(lds + 2 * SHM_V);
  float* ws = (float*)(lds + 2 * SHM_V + 2 * SHM_K) + wid * 64; float* li_l = ws; float* al_l = ws + 32;
  float m_reg = -1e30f, l_reg = 0; f32x16 o[4] = {}; bf16x8 qr[8];
  const bf16_t* Qw = Qb + (long)(wid * QBLK + r32) * LDQ + hi * 8;
#pragma unroll
  for (int d0 = 0; d0 < 8; ++d0) qr[d0] = ld8(Qw + d0 * 16);
  const int sr = tid >> 4, sc = (tid & 15) * 8, vst0 = v_st(sr, sc), vst1 = v_st(32 + sr, sc);
  const int vb0 = (int)(uintptr_t)V_lds + v_rd_base(lane);
  struct { bf16x8 vs0, vs1, ks0, ks1; } sr_[SDEPTH];
#define SLOAD(i, k0) do { sr_[i].vs0 = ld8(&Vh[(long)((k0) + sr) * LDK + sc]); sr_[i].vs1 = ld8(&Vh[(long)((k0) + 32 + sr) * LDK + sc]); \
    sr_[i].ks0 = ld8(&Kh[(long)((k0) + sr) * LDK + sc]); sr_[i].ks1 = ld8(&Kh[(long)((k0) + 32 + sr) * LDK + sc]); } while (0)
#define SWRITE(b, i) do { *(bf16x8*)((char*)V_lds + (b) * SHM_V + vst0) = sr_[i].vs0;          \
    *(bf16x8*)((char*)V_lds + (b) * SHM_V + vst1) = sr_[i].vs1; int kc = sc * 2;               \
    *(bf16x8*)((char*)K_lds + (b) * SHM_K + KSWZ(sr, kc)) = sr_[i].ks0;                       \
    *(bf16x8*)((char*)K_lds + (b) * SHM_K + KSWZ(32 + sr, kc)) = sr_[i].ks1; } while (0)
#define SWAIT() do { if constexpr (SDEPTH == 2) asm volatile("s_waitcnt vmcnt(4)" ::: "memory"); else asm volatile("s_waitcnt vmcnt(0)" ::: "memory"); } while (0)
#define RESC(a) do { if (__any((a) < 1.f)) { if (hi == 0) al_l[r32] = (a); asm volatile("s_waitcnt lgkmcnt(0)" ::: "memory"); \
    for (int d = 0; d < 4; ++d) for (int r = 0; r < 16; ++r) o[d][r] *= al_l[crow(r, hi)]; } } while (0)
  f32x16 pA0, pA1, pB0, pB1; float mnA, mnB, alA, alB; bf16x8 pa0, pa1, pa2, pa3; const int NT = seq / KVBLK;
  constexpr int SE = 0, SO = SDEPTH - 1;
  SLOAD(SE, 0); asm volatile("s_waitcnt vmcnt(0)" ::: "memory"); SWRITE(0, SE); __syncthreads();
  qkt(pA0, pA1, K_lds, qr, r32, hi); partialSM(pA0, pA1, m_reg, mnA, alA);
  SLOAD(SO, KVBLK); if constexpr (SDEPTH == 2) { if (2 < NT) SLOAD(SE, 2 * KVBLK); }
  SWAIT(); SWRITE(1, SO); __syncthreads();
  for (int j = 1; j + 1 < NT; j += 2) {
    SBAR(); qkt(pB0, pB1, (bf16_t*)((char*)K_lds + SHM_K), qr, r32, hi);
    finishSM(pA0, pA1, alA, l_reg, pa0, pa1, pa2, pa3); SBAR();
    SLOAD(SO, (j + SDEPTH) * KVBLK); SBAR();
    pv_d0(o, vb0, pa0, pa1, pa2, pa3); partialSM(pB0, pB1, m_reg, mnB, alB);
    __syncthreads(); SWAIT(); SWRITE(0, SE);
    RESC(alB); __syncthreads();
    SBAR(); qkt(pA0, pA1, K_lds, qr, r32, hi);
    finishSM(pB0, pB1, alB, l_reg, pa0, pa1, pa2, pa3); SBAR();
    if (SDEPTH == 1 || j + 3 < NT) SLOAD(SE, (j + 1 + SDEPTH) * KVBLK); SBAR();
    pv_d0(o, vb0 + (int)SHM_V, pa0, pa1, pa2, pa3); partialSM(pA0, pA1, m_reg, mnA, alA);
    __syncthreads(); SWAIT(); SWRITE(1, SO);
    RESC(alA); __syncthreads();
  }
  SBAR(); qkt(pB0, pB1, (bf16_t*)((char*)K_lds + SHM_K), qr, r32, hi);
  finishSM(pA0, pA1, alA, l_reg, pa0, pa1, pa2, pa3); SBAR();
  pv_d0(o, vb0, pa0, pa1, pa2, pa3); partialSM(pB0, pB1, m_reg, mnB, alB);
  __syncthreads(); RESC(alB);
  finishSM(pB0, pB1, alB, l_reg, pa0, pa1, pa2, pa3); SBAR();
  pv_d0(o, vb0 + (int)SHM_V, pa0, pa1, pa2, pa3);
  if (hi == 0) li_l[r32] = l_reg; asm volatile("s_waitcnt lgkmcnt(0)" ::: "memory");
  float rli[16];
#pragma unroll
  for (int r = 0; r < 16; ++r) rli[r] = __builtin_amdgcn_rcpf(li_l[crow(r, hi)]);
  bf16_t* Ow = Ob + (long)(wid * QBLK) * LDO;
#pragma unroll
  for (int r = 0; r < 16; ++r) { int orow = crow(r, hi);
    for (int d0 = 0; d0 < 4; ++d0) Ow[(long)orow * LDO + d0 * 32 + r32] = (bf16_t)f2bf(o[d0][r] * rli[r]); }
#undef SLOAD
#undef SWRITE
#undef SWAIT
#undef RESC
}
#undef KSWZ
#undef SBAR
}

struct Frame {
    LAS unsigned char* lds;
    int tid, lane, wave, G, gw, NGW;
};
struct Args { const float* in[28]; float* out; unsigned char* ws; int ph_lo, ph_hi; };

enum { I_X = 0, I_C, I_CTX, I_CCTX, I_ADAW, I_ADAB, I_NORMG, I_SCWIN, I_SCCONV, I_SCWOUT, I_HYWIN, I_HYCONV, I_HYFW1, I_HYFB1, I_HYFW2, I_HYFB2, I_HYFW3, I_HYFREQ, I_HYSKIP, I_HYWOUT,
       I_ATQKV, I_ATQG, I_ATKG, I_ATWO, I_ROUTER, I_WGATE, I_WUP, I_WDOWN };

__device__ __forceinline__ void p0_mod(const Frame& F, const Args& a) {
    LAS float* s = (LAS float*)F.lds;
    LAS float* red = (LAS float*)(F.lds + 9 * 1024 * 4);
    const float* c = a.in[I_C]; const float* cc = a.in[I_CCTX];
    for (int idx = F.tid; idx < 9 * 1024; idx += 512) { const int m = idx >> 10, k = idx & 1023; const float v = m < 8 ? c[m * 1024 + k] : cc[k]; s[idx] = v / (1.0f + __expf(-v)); }
    __syncthreads();
    float* modv = (float*)(a.ws + WS_MODV);
    for (int u = blockIdx.x; u < DEPTH * 96; u += F.G) {
        const int layer = u / 96, col0 = (u % 96) * 64, col = F.tid & 63, kp = F.tid >> 6;
        const float* w = a.in[I_ADAW] + (size_t)layer * DM * MODW + col0 + col;
        float acc[9];
#pragma unroll
        for (int m = 0; m < 9; ++m) acc[m] = 0.f;
#pragma unroll 8
        for (int k = kp * 128; k < kp * 128 + 128; ++k) { const float wv = w[(size_t)k * MODW];
#pragma unroll
            for (int m = 0; m < 9; ++m) acc[m] += s[m * 1024 + k] * wv; }
#pragma unroll
        for (int m = 0; m < 9; ++m) red[(kp * 9 + m) * 64 + col] = acc[m];
        __syncthreads();
        for (int o = F.tid; o < 9 * 64; o += 512) { const int m = o >> 6, cq = o & 63; float t = 0.f;
#pragma unroll
            for (int q = 0; q < 8; ++q) t += red[(q * 9 + m) * 64 + cq];
            modv[((size_t)layer * 9 + m) * MODW + col0 + cq] = t + a.in[I_ADAB][layer * MODW + col0 + cq]; }
        __syncthreads();
    }
}

__device__ __forceinline__ void transpose_item(const float* W, int K, int N, bf16_t* WT, int k0, int n0, int drow0, LAS float* scr, int lane) {
#pragma unroll 8
    for (int i = 0; i < 32; ++i) { const int kk = 2 * i + (lane >> 5); scr[kk * 33 + (lane & 31)] = W[(size_t)(k0 + kk) * N + n0 + (lane & 31)]; }
    LDS_WAIT(); asm volatile("" ::: "memory");
    const int c = lane & 7;
#pragma unroll
    for (int j = 0; j < 4; ++j) { const int n = (lane >> 3) + 8 * j; const LAS float* sp = scr + (8 * c) * 33 + n;
        u32x4 o; o.x = pk2(sp[0 * 33], sp[1 * 33]); o.y = pk2(sp[2 * 33], sp[3 * 33]); o.z = pk2(sp[4 * 33], sp[5 * 33]); o.w = pk2(sp[6 * 33], sp[7 * 33]);
        *(u32x4*)(WT + (size_t)(drow0 + n) * K + k0 + 8 * c) = o; }
    LDS_WAIT(); asm volatile("" ::: "memory");
}
__device__ __forceinline__ void transpose_plain(const float* W, int K, int N, bf16_t* WT, int item, LAS float* scr, int lane) {
    const int nblk = N / 32, kb = item / nblk, nb = item % nblk;
    transpose_item(W, K, N, WT, 64 * kb, 32 * nb, 32 * nb, scr, lane);
}

__device__ __forceinline__ void p0_convert_mixers(const Frame& F, const Args& a) {
    LAS float* scr = (LAS float*)(F.lds + 65536 + F.wave * 8704);
    bf16_t* wm = (bf16_t*)(a.ws + WS_WMIX);
    constexpr int I_IN = 16 * 96, I_SQ = 16 * 32, I_QKV = 16 * 48;
    constexpr int NIT = 2 * I_IN + 2 * I_SQ + I_IN + I_SQ + I_QKV + I_SQ;
    for (int it = F.gw; it < NIT; it += F.NGW) {
        int r = it;
        if (r < I_IN) { transpose_plain(a.in[I_SCWIN], DM, 3072, wm + WM_SC_IN, r, scr, F.lane); continue; } r -= I_IN;
        if (r < I_IN) { transpose_plain(a.in[I_SCWIN] + (size_t)DM * 3072, DM, 3072, wm + WM_SC_IN + 3072ull * 1024, r, scr, F.lane); continue; } r -= I_IN;
        if (r < I_SQ) { transpose_plain(a.in[I_SCWOUT], DM, DM, wm + WM_SC_OUT, r, scr, F.lane); continue; } r -= I_SQ;
        if (r < I_SQ) { transpose_plain(a.in[I_SCWOUT] + (size_t)DM * DM, DM, DM, wm + WM_SC_OUT + 1024ull * 1024, r, scr, F.lane); continue; } r -= I_SQ;
        if (r < I_IN) { transpose_plain(a.in[I_HYWIN], DM, 3072, wm + WM_HY_IN, r, scr, F.lane); continue; } r -= I_IN;
        if (r < I_SQ) { transpose_plain(a.in[I_HYWOUT], DM, DM, wm + WM_HY_OUT, r, scr, F.lane); continue; } r -= I_SQ;
        if (r < I_QKV) { transpose_plain(a.in[I_ATQKV], DM, 1536, wm + WM_AT_QKV, r, scr, F.lane); continue; } r -= I_QKV;
        transpose_plain(a.in[I_ATWO], DM, DM, wm + WM_AT_O, r, scr, F.lane);
    }
}

__device__ __forceinline__ void norm_row(const float* xrow, const float* gvec, const float* shv, const float* scv, bf16_t* orow, int lane, f32x4 (&y)[4]) {
    const f32x4* xr = (const f32x4*)xrow + lane;
    f32x4 v[4]; float ss = 0.f;
#pragma unroll
    for (int j = 0; j < 4; ++j) { v[j] = xr[64 * j]; ss += (v[j].x * v[j].x + v[j].y * v[j].y) + (v[j].z * v[j].z + v[j].w * v[j].w); }
    const float rstd = 1.0f / sqrtf(wave_sum(ss) * (1.0f / DM) + EPS);
    unsigned long long* o8 = (unsigned long long*)orow + lane;
#pragma unroll
    for (int j = 0; j < 4; ++j) { const f32x4 gg = ((const f32x4*)gvec)[lane + 64 * j], sh = ((const f32x4*)shv)[lane + 64 * j], sc = ((const f32x4*)scv)[lane + 64 * j];
        y[j] = (v[j] * rstd * gg) * (sc + 1.0f) + sh;
        o8[64 * j] = (unsigned long long)pk2(y[j].x, y[j].y) | ((unsigned long long)pk2(y[j].z, y[j].w) << 32); }
}
__device__ __forceinline__ void norm1_phase(const Frame& F, const float* srcL, const float* srcC, int nrows, const float* gvec, const float* modl, bf16_t* hl) {
    for (int row = F.gw; row < nrows; row += F.NGW) {
        const int midx = row < NLAT ? (row >> 12) : 8;
        const float* xr = row < NLAT ? srcL + (size_t)row * DM : srcC + (size_t)(row - NLAT) * DM;
        f32x4 y[4];
        norm_row(xr, gvec, modl + (size_t)midx * MODW, modl + (size_t)midx * MODW + DM, hl + (size_t)row * DM, F.lane, y);
    }
}

__device__ __forceinline__ void sc_conv_phase(const Frame& F, const bf16_t* U, const float* convw  , bf16_t* Z, int nrows) {
    const int nitems = (nrows / 16) * 2;
    for (int it = F.gw; it < nitems; it += F.NGW) {
        const int run = it >> 1, chunk = it & 1, r0 = run * 16, col = chunk * 512 + F.lane * 8;
        int pos0, slen; if (r0 < NLAT) { pos0 = r0 & (SEQ - 1); slen = SEQ; } else { pos0 = (r0 - NLAT) & (CTXL - 1); slen = CTXL; }
        float w0[8], w1[8], w2[8];
#pragma unroll
        for (int j = 0; j < 8; ++j) { w0[j] = convw[col + j]; w1[j] = convw[DM + col + j]; w2[j] = convw[2 * DM + col + j]; }
        float pm[8], pc[8], pn[8];
        auto loadp = [&](int row, float (&p)[8]) {
            const u32x4 gc = *(const u32x4*)(U + (size_t)row * 3072 + DM + col), vv = *(const u32x4*)(U + (size_t)row * 3072 + 2 * DM + col);
            p[0] = bf_lo(gc.x) * bf_lo(vv.x); p[1] = bf_hi(gc.x) * bf_hi(vv.x); p[2] = bf_lo(gc.y) * bf_lo(vv.y); p[3] = bf_hi(gc.y) * bf_hi(vv.y);
            p[4] = bf_lo(gc.z) * bf_lo(vv.z); p[5] = bf_hi(gc.z) * bf_hi(vv.z); p[6] = bf_lo(gc.w) * bf_lo(vv.w); p[7] = bf_hi(gc.w) * bf_hi(vv.w); };
        if (pos0 > 0) loadp(r0 - 1, pm); else {
#pragma unroll
            for (int j = 0; j < 8; ++j) pm[j] = 0.f; }
        loadp(r0, pc);
        for (int i = 0; i < 16; ++i) {
            const int row = r0 + i;
            if (pos0 + i + 1 < slen) loadp(row + 1, pn); else {
#pragma unroll
                for (int j = 0; j < 8; ++j) pn[j] = 0.f; }
            const u32x4 gb = *(const u32x4*)(U + (size_t)row * 3072 + col);
            float g[8] = {bf_lo(gb.x), bf_hi(gb.x), bf_lo(gb.y), bf_hi(gb.y), bf_lo(gb.z), bf_hi(gb.z), bf_lo(gb.w), bf_hi(gb.w)};
            float o[8];
#pragma unroll
            for (int j = 0; j < 8; ++j) o[j] = g[j] * (w0[j] * pm[j] + w1[j] * pc[j] + w2[j] * pn[j]);
            u32x4 w; w.x = pk2(o[0], o[1]); w.y = pk2(o[2], o[3]); w.z = pk2(o[4], o[5]); w.w = pk2(o[6], o[7]);
            *(u32x4*)(Z + (size_t)row * DM + col) = w;
#pragma unroll
            for (int j = 0; j < 8; ++j) { pm[j] = pc[j]; pc[j] = pn[j]; }
        }
    }
}


__device__ __forceinline__ void norm2_router_phase(const Frame& F, const float* lat, int nrows, const float* gvec, const float* modl, bf16_t* hl,
                                                   const float* wrouter, float* affL, float* affC) {
    LAS float* wT = (LAS float*)F.lds;
    for (int idx = F.tid; idx < 16 * DM; idx += 512) { const int k = idx >> 4, e = idx & 15; wT[e * DM + k] = wrouter[idx]; }
    __syncthreads();
    const int lane = F.lane;
    const bool b5 = lane & 32, b4 = lane & 16, b3 = lane & 8, b2 = lane & 4;
    for (int row = F.gw; row < nrows; row += F.NGW) {
        const int midx = row < NLAT ? (row >> 12) : 8;
        f32x4 y[4];
        norm_row(lat + (size_t)row * DM, gvec, modl + (size_t)midx * MODW + 3 * DM, modl + (size_t)midx * MODW + 4 * DM, hl + (size_t)row * DM, lane, y);
        float acc[16];
#pragma unroll
        for (int e = 0; e < 16; ++e) { float s = 0.f;
#pragma unroll
            for (int j = 0; j < 4; ++j) { const f32x4 w = *(const LAS f32x4*)(wT + e * DM + 4 * lane + 256 * j); s += (y[j].x * w.x + y[j].y * w.y) + (y[j].z * w.z + y[j].w * w.w); }
            acc[e] = s; if (e & 1) asm volatile("" ::: "memory"); }
        float a8[8], a4[4], a2[2], a1;
#pragma unroll
        for (int e = 0; e < 8; ++e) { const float send = b5 ? acc[e] : acc[e + 8], keep = b5 ? acc[e + 8] : acc[e]; a8[e] = keep + __shfl_xor(send, 32); }
#pragma unroll
        for (int e = 0; e < 4; ++e) { const float send = b4 ? a8[e] : a8[e + 4], keep = b4 ? a8[e + 4] : a8[e]; a4[e] = keep + __shfl_xor(send, 16); }
#pragma unroll
        for (int e = 0; e < 2; ++e) { const float send = b3 ? a4[e] : a4[e + 2], keep = b3 ? a4[e + 2] : a4[e]; a2[e] = keep + __shfl_xor(send, 8); }
        { const float send = b2 ? a2[0] : a2[1], keep = b2 ? a2[1] : a2[0]; a1 = keep + __shfl_xor(send, 4); }
        a1 += __shfl_xor(a1, 1); a1 += __shfl_xor(a1, 2);
        float mx = a1;
#pragma unroll
        for (int o = 4; o < 64; o <<= 1) mx = fmaxf(mx, __shfl_xor(mx, o));
        const float ex = __expf(a1 - mx); float sm = ex;
#pragma unroll
        for (int o = 4; o < 64; o <<= 1) sm += __shfl_xor(sm, o);
        const float af = ex / sm;
        if ((lane & 3) == 0) { const int e = lane >> 2;
            if (row < NLAT) affL[((size_t)((row >> 12) * NE + e) << 12) + (row & (SEQ - 1))] = af;
            else { const int rc = row - NLAT; affC[((size_t)((rc >> 8) * NE + e) << 8) + (rc & (CTXL - 1))] = af; } }
    }
}

__device__ __forceinline__ int block_excl_scan(int v, LAS int* tmp, int lane, int wave, int& total) {
    int incl = v;
#pragma unroll
    for (int o = 1; o < 64; o <<= 1) { const int t = __shfl_up(incl, o); if (lane >= o) incl += t; }
    if (lane == 63) tmp[wave] = incl;
    __syncthreads();
    int woff = 0, tot = 0;
#pragma unroll
    for (int w = 0; w < 8; ++w) { const int t = tmp[w]; tot += t; if (w < wave) woff += t; }
    __syncthreads();
    total = tot;
    return woff + incl - v;
}
__device__ __forceinline__ void topk_unit(const Frame& F, const float* aff, int N, int K, int e, int rbase, int tokbase, int* rowlist, float* gl, int* slotmap) {
    LAS int* sm = (LAS int*)F.lds;
    const int t = F.tid, lane = F.lane, wave = F.wave;
    unsigned vb[8];
    if (t * 8 < N) { const u32x4 q0 = *(const u32x4*)(aff + t * 8), q1 = *(const u32x4*)(aff + t * 8 + 4);
        vb[0] = q0.x; vb[1] = q0.y; vb[2] = q0.z; vb[3] = q0.w; vb[4] = q1.x; vb[5] = q1.y; vb[6] = q1.z; vb[7] = q1.w; }
    else {
#pragma unroll
        for (int j = 0; j < 8; ++j) vb[j] = 0u; }
    unsigned T = 0u;
    for (int bit = 30; bit >= 0; --bit) {
        const unsigned cand = T | (1u << bit); int c = 0;
#pragma unroll
        for (int j = 0; j < 8; ++j) c += (vb[j] >= cand) ? 1 : 0;
        c = wave_sum_i(c);
        const int buf = bit & 1;
        if (lane == 0) sm[buf * 8 + wave] = c;
        __syncthreads();
        int tot = 0;
#pragma unroll
        for (int w = 0; w < 8; ++w) tot += sm[buf * 8 + w];
        if (tot >= K) T = cand;
    }
    __syncthreads();
    int ngt = 0, neq = 0;
#pragma unroll
    for (int j = 0; j < 8; ++j) { ngt += (vb[j] > T) ? 1 : 0; neq += (vb[j] == T) ? 1 : 0; }
    int tot_gt, tot_eq;
    (void)block_excl_scan(ngt, sm + 16, lane, wave, tot_gt);
    const int eq_pre = block_excl_scan(neq, sm + 16, lane, wave, tot_eq);
    const int need_eq = K - tot_gt;
    int sel[8], nsel = 0, eqr = eq_pre;
#pragma unroll
    for (int j = 0; j < 8; ++j) { int s = 0; if (vb[j] > T) s = 1; else if (vb[j] == T) { s = (eqr < need_eq) ? 1 : 0; ++eqr; } sel[j] = s; nsel += s; }
    int tot_sel;
    int slot = block_excl_scan(nsel, sm + 16, lane, wave, tot_sel);
    if (t * 8 < N) {
#pragma unroll
        for (int j = 0; j < 8; ++j) { const int row = tokbase + t * 8 + j;
            if (sel[j]) { const int pos = rbase + slot; rowlist[pos] = row; gl[pos] = __uint_as_float(vb[j]); slotmap[row * NE + e] = pos; ++slot; }
            else slotmap[row * NE + e] = -1; }
    }
}
__device__ __forceinline__ void topk_convert_phase(const Frame& F, const Args& a, int layer, bool with_ctx, const float* affL, const float* affC, int* rowlist, float* gl, int* slotmap) {
    const int RE = with_ctx ? (REL + REC) : REL;
    const int nunits = with_ctx ? 256 : 128;
    for (int u = blockIdx.x; u < nunits; u += F.G) {
        if (u < 128) { const int b = u >> 4, e = u & 15; topk_unit(F, affL + ((size_t)(b * NE + e) << 12), SEQ, CAPL, e, e * RE + b * CAPL, b * SEQ, rowlist, gl, slotmap); }
        else { const int v = u - 128, b = v >> 4, e = v & 15; topk_unit(F, affC + ((size_t)(b * NE + e) << 8), CTXL, CAPC, e, e * RE + REL + b * CAPC, NLAT + b * CTXL, rowlist, gl, slotmap); }
        __syncthreads();
    }
    __syncthreads();
    LAS float* scr = (LAS float*)(F.lds + 65536 + F.wave * 8704);
    unsigned* ctr = (unsigned*)(a.ws + WS_CTL) + CW_WQ + 64 * layer;
    bf16_t* wup = (bf16_t*)(a.ws + WS_WMOE); bf16_t* wdn = (bf16_t*)(a.ws + WS_WMOE_DN);
    for (;;) {
        unsigned it = 0; if (F.lane == 0) it = __hip_atomic_fetch_add(ctr, 1u, __ATOMIC_RELAXED, __HIP_MEMORY_SCOPE_AGENT);
        it = (unsigned)__builtin_amdgcn_readfirstlane((int)it);
        if (it >= 24576u) break;
        if (it < 16384u) { const int e = it >> 10, r = it & 1023, half = r >> 9, q = r & 511, kb = q >> 5, nb = q & 31, n0 = nb * 32;
            const float* W = (half ? a.in[I_WUP] : a.in[I_WGATE]) + ((size_t)(layer * NE + e) << 20);
            transpose_item(W, DM, DM, wup + ((size_t)e << 21), kb * 64, n0, (n0 >> 7) * 256 + half * 128 + (n0 & 127), scr, F.lane); }
        else { const int r = it - 16384, e = r >> 9, q = r & 511, kb = q >> 5, nb = q & 31;
            const float* W = a.in[I_WDOWN] + ((size_t)(layer * NE + e) << 20);
            transpose_item(W, DM, DM, wdn + ((size_t)e << 20), kb * 64, nb * 32, nb * 32, scr, F.lane); }
    }
}

__device__ __forceinline__ void combine_phase(const Frame& F, float* lat, int nrows, const bf16_t* YS, const int* slotmap, const float* modl,
                                              bool final_layer, float* out, const float* gnext, const float* modnext, bf16_t* hl) {
    const int lane = F.lane;
    for (int row = F.gw; row < nrows; row += F.NGW) {
        const int midx = row < NLAT ? (row >> 12) : 8;
        const int mypos = lane < NE ? slotmap[row * NE + lane] : -1;
        unsigned long long mask = __ballot(mypos >= 0);
        f32x4 acc[4];
#pragma unroll
        for (int j = 0; j < 4; ++j) acc[j] = (f32x4){0.f, 0.f, 0.f, 0.f};
        while (mask) { const int e = __builtin_ctzll(mask); mask &= mask - 1; const int pos = __shfl(mypos, e);
            const u32x2* yr = (const u32x2*)(YS + (size_t)pos * DM) + lane;
#pragma unroll
            for (int j = 0; j < 4; ++j) { const u32x2 w = yr[64 * j]; acc[j] += (f32x4){bf_lo(w.x), bf_hi(w.x), bf_lo(w.y), bf_hi(w.y)}; } }
        f32x4* xr = (f32x4*)(lat + (size_t)row * DM) + lane;
        const f32x4* g2 = (const f32x4*)(modl + (size_t)midx * MODW + 5 * DM) + lane;
        f32x4 v[4]; float ss = 0.f;
#pragma unroll
        for (int j = 0; j < 4; ++j) { v[j] = xr[64 * j] + g2[64 * j] * acc[j]; ss += (v[j].x * v[j].x + v[j].y * v[j].y) + (v[j].z * v[j].z + v[j].w * v[j].w); }
        if (final_layer) { f32x4* o = (f32x4*)(out + (size_t)row * DM) + lane;
#pragma unroll
            for (int j = 0; j < 4; ++j) o[64 * j] = v[j];
        } else {
#pragma unroll
            for (int j = 0; j < 4; ++j) xr[64 * j] = v[j];
            const float rstd = 1.0f / sqrtf(wave_sum(ss) * (1.0f / DM) + EPS);
            const float* shv = modnext + (size_t)midx * MODW; const float* scv = shv + DM;
            unsigned long long* o8 = (unsigned long long*)(hl + (size_t)row * DM) + lane;
#pragma unroll
            for (int j = 0; j < 4; ++j) { const f32x4 gg = ((const f32x4*)gnext)[lane + 64 * j], sh = ((const f32x4*)shv)[lane + 64 * j], sc = ((const f32x4*)scv)[lane + 64 * j];
                const f32x4 y = (v[j] * rstd * gg) * (sc + 1.0f) + sh;
                o8[64 * j] = (unsigned long long)pk2(y.x, y.y) | ((unsigned long long)pk2(y.z, y.w) << 32); }
        }
    }
}

__device__ __forceinline__ void attn_prep_phase(const Frame& F, bf16_t* U, const float* qg, const float* kg, bf16_t* Kb, bf16_t* Vb) {
    const int lane = F.lane;
    const float g_q0 = qg[2 * lane], g_q1 = qg[2 * lane + 1], g_k0 = kg[2 * lane], g_k1 = kg[2 * lane + 1];
    const int i0 = 2 * lane, w0 = i0 & 63;
    const bool axis1 = i0 >= 64, upper = w0 >= 32;
    const float inv0 = exp2f(-(float)(w0 & 31) * (13.287712379549449f / 32.0f)), inv1 = exp2f(-(float)((w0 + 1) & 31) * (13.287712379549449f / 32.0f));
    for (int row = F.gw; row < MALL; row += F.NGW) {
        bf16_t* ur = U + (size_t)row * 1536;
        const bool lat = row < NLAT;
        int b, t; if (lat) { b = row >> 12; t = row & (SEQ - 1); } else { b = (row - NLAT) >> 8; t = (row - NLAT) & (CTXL - 1); }
        float c0 = 1.f, s0 = 0.f, c1 = 1.f, s1 = 0.f;
        if (lat) { const float pos = axis1 ? (float)(t & 63) : (float)(t >> 6); sincosf(pos * inv0, &s0, &c0); sincosf(pos * inv1, &s1, &c1); }
        const size_t krow = (size_t)(b * (CTXL + SEQ) + (lat ? CTXL + t : t)) * 256;
#pragma unroll
        for (int h = 0; h < 10; ++h) {
            if (!lat && h < 8) continue;
            const unsigned w = *(const unsigned*)(ur + h * 128 + i0);
            float x0 = bf_lo(w), x1 = bf_hi(w);
            const float ss = wave_sum(x0 * x0 + x1 * x1);
            const float rstd = 1.0f / sqrtf(ss * (1.0f / 128.0f) + EPS);
            x0 = x0 * rstd * (h < 8 ? g_q0 : g_k0); x1 = x1 * rstd * (h < 8 ? g_q1 : g_k1);
            if (lat) { const float p0 = __shfl_xor(x0, 16), p1 = __shfl_xor(x1, 16);
                const float r0 = upper ? p0 : -p0, r1 = upper ? p1 : -p1;
                x0 = x0 * c0 + r0 * s0; x1 = x1 * c1 + r1 * s1; }
            const unsigned o = pk2(x0, x1);
            if (h < 8) *(unsigned*)(ur + h * 128 + i0) = o;
            else *(unsigned*)(Kb + krow + (h - 8) * 128 + i0) = o;
        }
#pragma unroll
        for (int h = 0; h < 2; ++h) *(unsigned*)(Vb + krow + h * 128 + i0) = *(const unsigned*)(ur + 1280 + h * 128 + i0);
    }
}
__device__ __forceinline__ void attn_phase(const Frame& F, const bf16_t* U, const bf16_t* Kb, const bf16_t* Vb, bf16_t* Z) {
    for (int i = 0; i < 1024; ++i) {
        int u;
        if (F.G == 256) { if (i >= 4) break; u = (blockIdx.x & 7) * 128 + i * 32 + (blockIdx.x >> 3); }
        else { u = blockIdx.x + i * F.G; if (u >= 1024) break; }
        const int pair = u >> 6, within = u & 63, g = within >> 4, qb = within & 15, b = pair >> 1, kvh = pair & 1, h = kvh * 4 + g;
        att::attn_dense_body(U + (size_t)(b * SEQ + qb * 256) * 1536 + h * 128, Kb + (size_t)b * (CTXL + SEQ) * 256 + kvh * 128, Vb + (size_t)b * (CTXL + SEQ) * 256 + kvh * 128,
                             Z + (size_t)(b * SEQ + qb * 256) * DM + h * 128, CTXL + SEQ, (char*)((unsigned char*)F.lds));
        __syncthreads();
    }
}


__device__ __forceinline__ void p0_hyena_tables(const Frame& F, const Args& a) {
    float* a2L = (float*)(a.ws + WS_A2); float* a2C = (float*)(a.ws + WS_A2C); f32x2* tw = (f32x2*)(a.ws + WS_TW);
    const float* w1 = a.in[I_HYFW1]; const float* b1 = a.in[I_HYFB1]; const float* w2 = a.in[I_HYFW2]; const float* b2 = a.in[I_HYFB2]; const float* fr = a.in[I_HYFREQ];
    const int j = F.lane; const float fj = fr[j];
    for (int item = F.gw; item < SEQ + CTXL; item += F.NGW) {
        const int L = item < SEQ ? SEQ : CTXL, lag = item < SEQ ? item : item - SEQ;
        const float t = (float)lag / (float)(L - 1);
        float acc = b1[j] + t * w1[j];
        const float base = (6.283185307179586f / (float)L) * (float)lag;
#pragma unroll 4
        for (int k = 0; k < 16; ++k) { const float band = 1e-4f + (float)k * ((15.0f - 1e-4f) / 15.0f); float s, c; sincosf(base * band, &s, &c);
            acc += c * w1[(1 + k) * 64 + j] - s * w1[(17 + k) * 64 + j]; }
        const float a1 = sinf(fj * acc);
        float acc2 = b2[j];
#pragma unroll 8
        for (int i = 0; i < 64; ++i) acc2 += __shfl(a1, i) * w2[i * 64 + j];
        const float a2 = sinf(fj * acc2);
        (item < SEQ ? a2L : a2C)[(size_t)lag * 64 + j] = a2;
    }
    for (int k = blockIdx.x * 512 + F.tid; k < 2048; k += F.G * 512) { float s, c; sincospif((float)k * (1.0f / 4096.0f), &s, &c); tw[k] = (f32x2){c, -s}; }
}

__device__ __forceinline__ void hy_dwconv_phase(const Frame& F, const bf16_t* U, const float* convw, bf16_t* XTL, bf16_t* XTC) {
    LAS unsigned* tile = (LAS unsigned*)(F.lds + F.wave * 8832);
    const int lane = F.lane, rr = lane >> 3, cq = lane & 7;
    for (int it = F.gw; it < (MALL / 64) * 48; it += F.NGW) {
        const int rb = it / 48, cb = it - rb * 48, r0 = rb * 64, ch0 = cb * 64;
        int b, pos0, slen; if (r0 < NLAT) { b = r0 >> 12; pos0 = r0 & (SEQ - 1); slen = SEQ; } else { const int rc = r0 - NLAT; b = rc >> 8; pos0 = rc & (CTXL - 1); slen = CTXL; }
#pragma unroll
        for (int grp = 0; grp < 9; ++grp) { const int ri = grp * 8 + rr;
            if (ri < 66) { const int p = pos0 - 1 + ri; u32x4 v = (u32x4){0u, 0u, 0u, 0u};
                if (p >= 0 && p < slen) v = *(const u32x4*)(U + (size_t)(r0 - 1 + ri) * 3072 + ch0 + cq * 8);
                LAS unsigned* tp = tile + ri * 33 + cq * 4; tp[0] = v.x; tp[1] = v.y; tp[2] = v.z; tp[3] = v.w; } }
        LDS_WAIT(); asm volatile("" ::: "memory");
        const int part = ch0 >> 10, c0 = ch0 & 1023;
        bf16_t* ob = (r0 < NLAT) ? XTL + ((size_t)((part * NB + b) * DM + c0) << 12) + pos0 + lane : XTC + ((size_t)((part * NB + b) * DM + c0) << 8) + pos0 + lane;
        const float* wp = convw + ch0;
#pragma unroll 4
        for (int cp = 0; cp < 32; ++cp) {
            const unsigned x0 = tile[lane * 33 + cp], x1 = tile[(lane + 1) * 33 + cp], x2 = tile[(lane + 2) * 33 + cp];
            const float oa = wp[2 * cp] * bf_lo(x0) + wp[3072 + 2 * cp] * bf_lo(x1) + wp[6144 + 2 * cp] * bf_lo(x2);
            const float ob2 = wp[2 * cp + 1] * bf_hi(x0) + wp[3072 + 2 * cp + 1] * bf_hi(x1) + wp[6144 + 2 * cp + 1] * bf_hi(x2);
            ob[(size_t)(2 * cp) * slen] = (bf16_t)f2bf(oa); ob[(size_t)(2 * cp + 1) * slen] = (bf16_t)f2bf(ob2); }
        LDS_WAIT(); asm volatile("" ::: "memory");
    }
}

__device__ __forceinline__ void hy_untranspose_phase(const Frame& F, const bf16_t* zTL, const bf16_t* zTC, bf16_t* Z) {
    LAS unsigned* tile = (LAS unsigned*)(F.lds + F.wave * 8448);
    const int lane = F.lane, hi8 = lane >> 3, lo8 = lane & 7;
    constexpr int NITL = NB * 16 * 64, NITC = NB * 16 * 4;
    for (int it = F.gw; it < NITL + NITC; it += F.NGW) {
        int b, cb, tb, slen; const bf16_t* src; int rowbase;
        if (it < NITL) { b = it >> 10; cb = (it >> 6) & 15; tb = it & 63; slen = SEQ; src = zTL; rowbase = b * SEQ; }
        else { const int i2 = it - NITL; b = i2 >> 6; cb = (i2 >> 2) & 15; tb = i2 & 3; slen = CTXL; src = zTC; rowbase = NLAT + b * CTXL; }
        const int c0 = cb * 64, t0 = tb * 64;
#pragma unroll
        for (int g = 0; g < 8; ++g) { const int c = g * 8 + hi8;
            const u32x4 v = *(const u32x4*)(src + (size_t)(b * DM + c0 + c) * slen + t0 + lo8 * 8);
            LAS unsigned* tp = tile + c * 33 + lo8 * 4; tp[0] = v.x; tp[1] = v.y; tp[2] = v.z; tp[3] = v.w; }
        LDS_WAIT(); asm volatile("" ::: "memory");
#pragma unroll
        for (int g = 0; g < 8; ++g) { const int t = g * 8 + hi8; unsigned e[8];
#pragma unroll
            for (int i = 0; i < 8; ++i) { const unsigned w = tile[(lo8 * 8 + i) * 33 + (t >> 1)]; e[i] = (t & 1) ? (w >> 16) : (w & 0xffffu); }
            u32x4 o; o.x = e[0] | (e[1] << 16); o.y = e[2] | (e[3] << 16); o.z = e[4] | (e[5] << 16); o.w = e[6] | (e[7] << 16);
            *(u32x4*)(Z + (size_t)(rowbase + t0 + t) * DM + c0 + lo8 * 8) = o; }
        LDS_WAIT(); asm volatile("" ::: "memory");
    }
}

constexpr int FFT_N = 8192;
__device__ __forceinline__ int PX(int i) { return i + (i >> 5); }
__device__ __forceinline__ f32x2 twv(const LAS f32x2* TW, int k) { const f32x2 t = TW[k & 2047]; return (k & 2048) ? (f32x2){t.y, -t.x} : t; }
__device__ __forceinline__ f32x2 cmul(f32x2 a, f32x2 b) { return (f32x2){a.x * b.x - a.y * b.y, a.x * b.y + a.y * b.x}; }
__device__ __forceinline__ f32x2 cmulc(f32x2 a, f32x2 w) { return (f32x2){a.x * w.x + a.y * w.y, a.y * w.x - a.x * w.y}; }
template <int K, bool INV>
__device__ __forceinline__ void fft_pass(LAS f32x2* X, const LAS f32x2* TW, int ls, int tid) {
    constexpr int R = 1 << K;
    const int lst = ls - (K - 1), st = 1 << lst;
    for (int gi = tid; gi < FFT_N / R; gi += 512) {
        const int pos = gi & (st - 1), g = gi >> lst, ibase = (g << (ls + 1)) + pos;
        f32x2 v[R];
#pragma unroll
        for (int e = 0; e < R; ++e) v[e] = X[PX(ibase + (e << lst))];
        if (!INV) {
#pragma unroll
            for (int m = 0; m < K; ++m) { const int h = 1 << (K - 1 - m), lsm = ls - m;
#pragma unroll
                for (int e = 0; e < R; ++e) if (!(e & h)) { const int pm = ((e & (h - 1)) << lst) + pos; const f32x2 w = twv(TW, pm << (12 - lsm));
                    const f32x2 x = v[e], y = v[e + h]; v[e] = x + y; v[e + h] = cmul(x - y, w); } }
        } else {
#pragma unroll
            for (int m = K - 1; m >= 0; --m) { const int h = 1 << (K - 1 - m), lsm = ls - m;
#pragma unroll
                for (int e = 0; e < R; ++e) if (!(e & h)) { const int pm = ((e & (h - 1)) << lst) + pos; const f32x2 w = twv(TW, pm << (12 - lsm));
                    const f32x2 x = v[e], y = cmulc(v[e + h], w); v[e] = x + y; v[e + h] = x - y; } }
        }
#pragma unroll
        for (int e = 0; e < R; ++e) X[PX(ibase + (e << lst))] = v[e];
    }
    __syncthreads();
}
__device__ __forceinline__ void fft_fwd(LAS f32x2* X, const LAS f32x2* TW, int tid) {
    fft_pass<4, false>(X, TW, 12, tid); fft_pass<4, false>(X, TW, 8, tid); fft_pass<4, false>(X, TW, 4, tid); fft_pass<1, false>(X, TW, 0, tid);
}
__device__ __forceinline__ void fft_inv(LAS f32x2* X, const LAS f32x2* TW, int tid) {
    fft_pass<1, true>(X, TW, 0, tid); fft_pass<4, true>(X, TW, 4, tid); fft_pass<4, true>(X, TW, 8, tid); fft_pass<4, true>(X, TW, 12, tid);
}
__device__ __forceinline__ float block_sum(float v, LAS float* scr, int lane, int wave) {
    v = wave_sum(v); __syncthreads(); if (lane == 0) scr[wave] = v; __syncthreads();
    float t = 0.f;
#pragma unroll
    for (int w = 0; w < 8; ++w) t += scr[w];
    return t;
}
constexpr float HY_DLO = -3.0701134573253944f, HY_DHI = -15.350567286626972f;
__device__ __forceinline__ void hy_longconv_phase(const Frame& F, const Args& a, const bf16_t* XTL, bf16_t* z1T, bf16_t* z2T, const bf16_t* XTC, bf16_t* z2Tc) {
    LAS f32x2* W = (LAS f32x2*)F.lds;
    LAS f32x2* HF = (LAS f32x2*)(F.lds + 67584);
    LAS f32x2* TW = (LAS f32x2*)(F.lds + 135168);
    LAS float* wfb = (LAS float*)(F.lds + 151552);
    LAS float* scr = wfb + 128;
    const int tid = F.tid, lane = F.lane, wave = F.wave;
    const f32x2* twg = (const f32x2*)(a.ws + WS_TW);
    for (int k = tid; k < 2048; k += 512) TW[k] = twg[k];
    const float* a2L = (const float*)(a.ws + WS_A2); const float* a2C = (const float*)(a.ws + WS_A2C);
    const float* w3 = a.in[I_HYFW3]; const float* skip = a.in[I_HYSKIP];
    __syncthreads();
    for (int c = blockIdx.x; c < DM; c += F.G) {
        const float delta = fabsf(HY_DLO + (float)c * ((HY_DHI - HY_DLO) / 1023.0f));
        for (int o = 0; o < 2; ++o) {
            __syncthreads();
            if (tid < 128) { const int i = tid & 63, dir = tid >> 6; wfb[tid] = w3[(size_t)i * 4096 + (dir * 2 + o) * DM + c]; }
            __syncthreads();
            float lsum = 0.f;
#pragma unroll 1
            for (int i8 = 0; i8 < 8; ++i8) { const int q = tid + 512 * i8; const f32x4* ar = (const f32x4*)(a2L + (size_t)q * 64); float hf = 0.f, hb = 0.f;
#pragma unroll
                for (int i4 = 0; i4 < 16; ++i4) { const f32x4 av = ar[i4];
                    hf += (av.x * wfb[4 * i4] + av.y * wfb[4 * i4 + 1]) + (av.z * wfb[4 * i4 + 2] + av.w * wfb[4 * i4 + 3]);
                    hb += (av.x * wfb[64 + 4 * i4] + av.y * wfb[64 + 4 * i4 + 1]) + (av.z * wfb[64 + 4 * i4 + 2] + av.w * wfb[64 + 4 * i4 + 3]); }
                const float dec = __expf(-((float)q * (1.0f / 4095.0f)) * delta); hf *= dec; hb *= dec;
                W[PX(q)] = (f32x2){hf, 0.f}; lsum += fabsf(hf);
                if (q > 0) { W[PX(FFT_N - q)] = (f32x2){hb, 0.f}; lsum += fabsf(hb); } }
            if (tid == 0) W[PX(4096)] = (f32x2){0.f, 0.f};
            const float ssum = block_sum(lsum, scr, lane, wave);
            fft_fwd(W, TW, tid);
            const float scale = 1.0f / (ssum * (float)FFT_N);
#pragma unroll 2
            for (int i = 0; i < 16; ++i) { const int p = PX(tid + 512 * i); HF[p] = W[p] * scale; }
            __syncthreads();
            const bf16_t* usrc = o == 0 ? XTL : z1T; const bf16_t* gsrc = XTL + ((size_t)(1 + o) * NB * DM << 12); bf16_t* dst = o == 0 ? z1T : z2T;
            const float sk = skip[o * DM + c];
            for (int bp = 0; bp < 4; ++bp) {
                const size_t o0 = (size_t)((2 * bp) * DM + c) << 12, o1 = (size_t)((2 * bp + 1) * DM + c) << 12;
                float ur[8], ui[8];
#pragma unroll
                for (int i8 = 0; i8 < 8; ++i8) { const int t = tid + 512 * i8; ur[i8] = bf1(usrc[o0 + t]); ui[i8] = bf1(usrc[o1 + t]);
                    W[PX(t)] = (f32x2){ur[i8], ui[i8]}; W[PX(t + 4096)] = (f32x2){0.f, 0.f}; }
                __syncthreads();
                fft_fwd(W, TW, tid);
#pragma unroll 2
                for (int i = 0; i < 16; ++i) { const int p = PX(tid + 512 * i); W[p] = cmul(W[p], HF[p]); }
                __syncthreads();
                fft_inv(W, TW, tid);
#pragma unroll
                for (int i8 = 0; i8 < 8; ++i8) { const int t = tid + 512 * i8; const f32x2 y = W[PX(t)];
                    const float r0 = bf1(gsrc[o0 + t]) * (y.x + ur[i8] * sk), r1 = bf1(gsrc[o1 + t]) * (y.y + ui[i8] * sk);
                    dst[o0 + t] = (bf16_t)f2bf(r0); dst[o1 + t] = (bf16_t)f2bf(r1); }
                __syncthreads();
            }
        }
    }
    LAS float* uc = (LAS float*)F.lds;
    LAS float* hfull = uc + 2048;
    LAS float* un = hfull + 512;
    for (int c = blockIdx.x; c < DM; c += F.G) {
        const float delta = fabsf(HY_DLO + (float)c * ((HY_DHI - HY_DLO) / 1023.0f));
        __syncthreads();
        for (int idx = tid; idx < 2048; idx += 512) uc[idx] = bf1(XTC[(size_t)((idx >> 8) * DM + c) * CTXL + (idx & 255)]);
        for (int o = 0; o < 2; ++o) {
            __syncthreads();
            if (tid < 128) { const int i = tid & 63, dir = tid >> 6; wfb[tid] = w3[(size_t)i * 4096 + (dir * 2 + o) * DM + c]; }
            __syncthreads();
            float lsum = 0.f;
            if (tid < 256) { const int q = tid; const float* ar = a2C + (size_t)q * 64; float hf = 0.f, hb = 0.f;
                for (int i = 0; i < 64; ++i) { const float av = ar[i]; hf += av * wfb[i]; hb += av * wfb[64 + i]; }
                const float dec = __expf(-((float)q * (1.0f / 255.0f)) * delta); hf *= dec; hb *= dec;
                hfull[255 + q] = hf; lsum += fabsf(hf);
                if (q > 0) { hfull[255 - q] = hb; lsum += fabsf(hb); } }
            const float ssum = block_sum(lsum, scr, lane, wave);
            const float rs = 1.0f / ssum, sk = skip[o * DM + c];
            const int t = tid & 255;
            for (int bb = 0; bb < 4; ++bb) { const int b = (tid >> 8) + 2 * bb; float y = 0.f;
                for (int s = 0; s < 256; ++s) y += hfull[255 + t - s] * uc[b * 256 + s];
                const float gt = bf1(XTC[(size_t)(((1 + o) * NB + b) * DM + c) * CTXL + t]);
                const float r = gt * (y * rs + uc[b * 256 + t] * sk);
                if (o == 0) un[b * 256 + t] = bf1((bf16_t)f2bf(r)); else z2Tc[(size_t)(b * DM + c) * CTXL + t] = (bf16_t)f2bf(r); }
            __syncthreads();
            if (o == 0) { for (int idx = tid; idx < 2048; idx += 512) uc[idx] = un[idx]; }
        }
    }
}

__device__ __forceinline__ void copy_rows(const Frame& F, const float* src, float* dst, size_t n4) {
    for (size_t i = (size_t)blockIdx.x * 512 + F.tid; i < n4; i += (size_t)F.G * 512) ((f32x4*)dst)[i] = ((const f32x4*)src)[i];
}

constexpr int PH_P0 = 0, PH_N0 = 1, PH_L0 = 2, PH_PER = 12, PH_END = PH_L0 + DEPTH * PH_PER;
#ifndef DBG_LAST
#define DBG_LAST 100
#endif

template <int layer>
__device__ __forceinline__ void run_layer(const Frame& F, const Args& a, const XcdBarrier& bar, const int lo, const int hi) {
    float* modv = (float*)(a.ws + WS_MODV);
    float* LAT = (float*)(a.ws + WS_LAT);
    bf16_t* HL = (bf16_t*)(a.ws + WS_HL);
    bf16_t* U = (bf16_t*)(a.ws + WS_U);
    bf16_t* Z = (bf16_t*)(a.ws + WS_Z);
    bf16_t* wm = (bf16_t*)(a.ws + WS_WMIX);
    bf16_t* HB = (bf16_t*)(a.ws + WS_H);
    bf16_t* YS = (bf16_t*)(a.ws + WS_YS);
    bf16_t* XTL = (bf16_t*)(a.ws + WS_H); bf16_t* XTC = (bf16_t*)(a.ws + WS_H + 192 * MiB);
    bf16_t* Z1T = (bf16_t*)(a.ws + WS_U); bf16_t* Z2T = (bf16_t*)(a.ws + WS_U + 68 * MiB); bf16_t* Z2TC = (bf16_t*)(a.ws + WS_U + 136 * MiB);
    bf16_t* KB = (bf16_t*)(a.ws + WS_H); bf16_t* VB = (bf16_t*)(a.ws + WS_H + 17 * MiB);
    float* affL = (float*)(a.ws + WS_AFF); float* affC = (float*)(a.ws + WS_AFFC);
    int* rowlist = (int*)(a.ws + WS_ROWL); float* gl = (float*)(a.ws + WS_GL); int* slotmap = (int*)(a.ws + WS_SLOT);
#define IN(k) (lo <= (k) && (k) < hi)
#define SEAM(k) do { if ((k) + 1 < hi) xcd_barrier(bar); } while (0)
        constexpr int pb = PH_L0 + layer * PH_PER;
        if (pb >= hi) return;
        constexpr int kind = layer % 3, jj = layer / 3;
        constexpr bool need_ctx = layer <= 2, upd_ctx = layer < 2;
        constexpr int m_in = need_ctx ? MALL : NLAT, m_out = upd_ctx ? MALL : NLAT;
        const float* modl = modv + (size_t)layer * 9 * MODW;
        const float* baseL = layer == 0 ? a.in[I_X] : LAT;
        const float* baseC = layer == 0 ? a.in[I_CTX] : LAT + (size_t)NLAT * DM;
        const bf16_t* w_in = kind == 0 ? wm + WM_SC_IN + (size_t)jj * 3072 * 1024 : (kind == 1 ? wm + WM_HY_IN : wm + WM_AT_QKV);
        const bf16_t* w_out = kind == 0 ? wm + WM_SC_OUT + (size_t)jj * 1024 * 1024 : (kind == 1 ? wm + WM_HY_OUT : wm + WM_AT_O);
        constexpr int n_in = kind == 2 ? 1536 : 3072;
        if (IN(pb + 0)) {
            pg8::Gemm g{HL, w_in, m_in, n_in, DM, 1 << 20, nullptr}; pg8::StaticOrder S; S.init(m_in, n_in, F.G, (int)blockIdx.x);
            pg8::EpiBf16 E{U, n_in};
            pg8::gemm_phase<pg8::EpiBf16, pg8::StaticOrder, false>(F.lds, g, S, E);
            SEAM(pb + 0);
        }
        if (IN(pb + 1)) {
            if constexpr (kind == 0) sc_conv_phase(F, U, a.in[I_SCCONV] + (size_t)jj * 3 * DM, Z, m_out);
            if constexpr (kind == 2) attn_prep_phase(F, U, a.in[I_ATQG], a.in[I_ATKG], KB, VB);
            if constexpr (kind == 1) hy_dwconv_phase(F, U, a.in[I_HYCONV], XTL, XTC);
            SEAM(pb + 1);
        }
        if constexpr (kind != 0) if (IN(pb + 2)) {
            if constexpr (kind == 2) attn_phase(F, U, KB, VB, Z);
            if constexpr (kind == 1) hy_longconv_phase(F, a, XTL, Z1T, Z2T, XTC, Z2TC);
            SEAM(pb + 2);
        }
        if constexpr (kind == 1) if (IN(pb + 3)) { hy_untranspose_phase(F, Z2T, Z2TC, Z); SEAM(pb + 3); }
        if (IN(pb + 4)) {
            pg8::Gemm g{Z, w_out, m_out, DM, DM, 1 << 20, nullptr}; pg8::StaticOrder S; S.init(m_out, DM, F.G, (int)blockIdx.x);
            pg8::EpiRes E{baseL, baseC, LAT, modl + 2 * DM};
            pg8::gemm_phase<pg8::EpiRes, pg8::StaticOrder, false>(F.lds, g, S, E);
            SEAM(pb + 4);
        }
        if (IN(pb + 5)) {
            norm2_router_phase(F, LAT, m_out, a.in[I_NORMG] + (size_t)(layer * 2 + 1) * DM, modl, HL, a.in[I_ROUTER] + (size_t)layer * DM * NE, affL, affC);
            SEAM(pb + 5);
        }
        if (IN(pb + 6)) { topk_convert_phase(F, a, layer, upd_ctx, affL, affC, rowlist, gl, slotmap); SEAM(pb + 6); }
        constexpr int RE = upd_ctx ? (REL + REC) : REL;
        if (IN(pb + 7)) {
            pg8::Gemm g{HL, (const bf16_t*)(a.ws + WS_WMOE), NE * RE, 2048, DM, RE / 256, rowlist}; pg8::StaticOrder S; S.init(NE * RE, 2048, F.G, (int)blockIdx.x);
            pg8::EpiMoeUp E{HB};
            pg8::gemm_phase<pg8::EpiMoeUp, pg8::StaticOrder, true>(F.lds, g, S, E);
            SEAM(pb + 7);
        }
        if (IN(pb + 8)) {
            pg8::Gemm g{HB, (const bf16_t*)(a.ws + WS_WMOE_DN), NE * RE, DM, DM, RE / 256, nullptr}; pg8::StaticOrder S; S.init(NE * RE, DM, F.G, (int)blockIdx.x);
            pg8::EpiMoeDown E{YS, gl};
            pg8::gemm_phase<pg8::EpiMoeDown, pg8::StaticOrder, false>(F.lds, g, S, E);
            SEAM(pb + 8);
        }
        if (IN(pb + 9)) {
            const bool fin = layer == DEPTH - 1;
            combine_phase(F, LAT, m_out, YS, slotmap, modl, fin, a.out, a.in[I_NORMG] + (size_t)((layer + 1) * 2) * DM, modv + (size_t)(layer + 1) * 9 * MODW, HL);
            SEAM(pb + 9);
        }
    #undef IN
#undef SEAM
}

__global__ void __launch_bounds__(512, 2) fwd_kernel(Args a) {
    extern __shared__ __attribute__((aligned(16))) unsigned char lds_raw[];
    Frame F;
    F.lds = (LAS unsigned char*)lds_raw;
    F.tid = threadIdx.x; F.lane = F.tid & 63; F.wave = __builtin_amdgcn_readfirstlane(F.tid >> 6);
    F.G = gridDim.x; F.gw = blockIdx.x * 8 + F.wave; F.NGW = F.G * 8;
    volatile LAS unsigned* MISC = (volatile LAS unsigned*)(F.lds + LDS_MISC);
    for (int u = F.tid; u < (LDS_BYTES - LDS_MISC) / 4; u += 512) MISC[u] = 0u;
    __syncthreads();
    unsigned* ctl = (unsigned*)(a.ws + WS_CTL);
    const int lo = a.ph_lo, hi = a.ph_hi;
    const bool multi = (hi - lo) > 1;
    XcdBarrier bar; bar.bar = ctl + CW_BAR; bar.x = 0; bar.st = nullptr;
    if (multi) bar = xcd_barrier_post(ctl + CW_BAR, MISC + 8);
#define IN(k) (lo <= (k) && (k) < hi)
#define SEAM(k) do { if ((k) + 1 < hi) xcd_barrier(bar); } while (0)

    float* modv = (float*)(a.ws + WS_MODV);
    float* LAT = (float*)(a.ws + WS_LAT);
    bf16_t* HL = (bf16_t*)(a.ws + WS_HL);
    bf16_t* U = (bf16_t*)(a.ws + WS_U);
    bf16_t* Z = (bf16_t*)(a.ws + WS_Z);
    bf16_t* wm = (bf16_t*)(a.ws + WS_WMIX);
    bf16_t* HB = (bf16_t*)(a.ws + WS_H);
    bf16_t* YS = (bf16_t*)(a.ws + WS_YS);
    bf16_t* XTL = (bf16_t*)(a.ws + WS_H); bf16_t* XTC = (bf16_t*)(a.ws + WS_H + 192 * MiB);
    bf16_t* Z1T = (bf16_t*)(a.ws + WS_U); bf16_t* Z2T = (bf16_t*)(a.ws + WS_U + 68 * MiB); bf16_t* Z2TC = (bf16_t*)(a.ws + WS_U + 136 * MiB);
    bf16_t* KB = (bf16_t*)(a.ws + WS_H); bf16_t* VB = (bf16_t*)(a.ws + WS_H + 17 * MiB);
    float* affL = (float*)(a.ws + WS_AFF); float* affC = (float*)(a.ws + WS_AFFC);
    int* rowlist = (int*)(a.ws + WS_ROWL); float* gl = (float*)(a.ws + WS_GL); int* slotmap = (int*)(a.ws + WS_SLOT);

    if (IN(PH_P0)) { p0_mod(F, a); __syncthreads(); p0_convert_mixers(F, a); p0_hyena_tables(F, a); SEAM(PH_P0); }
    if (IN(PH_N0)) { norm1_phase(F, a.in[I_X], a.in[I_CTX], MALL, a.in[I_NORMG], modv, HL); SEAM(PH_N0); }

    if (DBG_LAST >= PH_L0 + 0 * PH_PER) run_layer<0>(F, a, bar, lo, hi);
    if (DBG_LAST >= PH_L0 + 1 * PH_PER) run_layer<1>(F, a, bar, lo, hi);
    if (DBG_LAST >= PH_L0 + 2 * PH_PER) run_layer<2>(F, a, bar, lo, hi);
    if (DBG_LAST >= PH_L0 + 3 * PH_PER) run_layer<3>(F, a, bar, lo, hi);
    if (IN(PH_END) && DBG_LAST < PH_END - 1) { copy_rows(F, LAT, a.out, (size_t)NLAT * DM / 4); }
#undef IN
#undef SEAM
}

#ifndef ONE_LAUNCH
#define ONE_LAUNCH 0
#endif
extern "C" void kernel_launch(void* const* d_in, const int* in_sizes, int n_in, void* d_out, int out_size, void* d_ws, size_t ws_size, hipStream_t stream) {
    static int grid = 0;
    if (grid == 0) {
        if (n_in != 28 || out_size != NLAT * DM || ws_size < WS_END) { fprintf(stderr, "kernel_launch: unexpected shapes n_in %d out %d ws %zu (need %zu)\n", n_in, out_size, ws_size, (size_t)WS_END); grid = -1; return; }
        int dev = 0, cus = 0, per_cu = 0;
        if (hipGetDevice(&dev) != hipSuccess || hipDeviceGetAttribute(&cus, hipDeviceAttributeMultiprocessorCount, dev) != hipSuccess) { grid = -1; return; }
        if (hipFuncSetAttribute((const void*)fwd_kernel, hipFuncAttributeMaxDynamicSharedMemorySize, LDS_BYTES) != hipSuccess) { fprintf(stderr, "kernel_launch: hipFuncSetAttribute failed\n"); grid = -1; return; }
        if (hipOccupancyMaxActiveBlocksPerMultiprocessor(&per_cu, (const void*)fwd_kernel, 512, LDS_BYTES) != hipSuccess || per_cu < 1) fprintf(stderr, "kernel_launch: occupancy query says %d\n", per_cu);
        (void)hipGetLastError();
        grid = cus;
    }
    if (grid < 0) return;
    hipMemsetAsync((char*)d_ws + WS_CTL, 0, CTL_ZERO_BYTES, stream);
    Args a{};
    for (int i = 0; i < 28; ++i) a.in[i] = (const float*)d_in[i];
    a.out = (float*)d_out; a.ws = (unsigned char*)d_ws;
    if (ONE_LAUNCH) { a.ph_lo = 0; a.ph_hi = PH_END + 1; hipLaunchKernelGGL(fwd_kernel, dim3(grid), dim3(512), LDS_BYTES, stream, a); }
    else {
        for (int ph = 0; ph <= PH_END; ++ph) {
            bool exists = (ph == PH_P0 || ph == PH_N0 || ph == PH_END);
            if (ph >= PH_L0 && ph < PH_END) { const int layer = (ph - PH_L0) / PH_PER, k = (ph - PH_L0) % PH_PER, kind = layer % 3;
                exists = (k == 0 || k == 1 || k == 4 || (k >= 5 && k <= 9) || (k == 2 && kind != 0) || (k == 3 && kind == 1));
                if (ph > DBG_LAST) exists = false; }
            if (!exists) continue;
            a.ph_lo = ph; a.ph_hi = ph + 1;
            hipLaunchKernelGGL(fwd_kernel, dim3(grid), dim3(512), LDS_BYTES, stream, a);
        }
    }
}
```

```cpp
#include <hip/hip_runtime.h>
#include <cstdio>
#include <cstdint>

#define GAS __attribute__((address_space(1)))
#define LAS __attribute__((address_space(3)))
typedef unsigned short bf16_t;
typedef short bf16x8 __attribute__((ext_vector_type(8)));
typedef float f32x4 __attribute__((ext_vector_type(4)));
typedef float f32x2 __attribute__((ext_vector_type(2)));
typedef unsigned u32x4 __attribute__((ext_vector_type(4)));
typedef unsigned u32x2 __attribute__((ext_vector_type(2)));

constexpr int DM = 1024, NB = 8, SEQ = 4096, CTXL = 256, DEPTH = 4;
constexpr int NLAT = NB * SEQ, NCTX = NB * CTXL, MALL = NLAT + NCTX;
constexpr int NE = 16, CAPL = 512, CAPC = 32, REL = NB * CAPL, REC = NB * CAPC;
constexpr int MODW = 6 * DM;
constexpr float EPS = 1e-6f;

constexpr size_t MiB = 1u << 20;
constexpr size_t WS_CTL = 0, CTL_ZERO_BYTES = 1 * MiB;
constexpr size_t WS_MODV = 1 * MiB;
constexpr size_t WS_A2 = 2 * MiB;
constexpr size_t WS_A2C = WS_A2 + 4096 * 64 * 4;
constexpr size_t WS_TW = WS_A2C + 256 * 64 * 4;
constexpr size_t WS_AFF = 4 * MiB;
constexpr size_t WS_AFFC = WS_AFF + 2 * MiB;
constexpr size_t WS_ROWL = 7 * MiB;
constexpr size_t WS_GL = WS_ROWL + 512 * 1024;
constexpr size_t WS_SLOT = 8 * MiB;
constexpr size_t WS_WMIX = 11 * MiB;
constexpr size_t WS_WMOE = 43 * MiB;
constexpr size_t WS_WMOE_DN = WS_WMOE + 64 * MiB;
constexpr size_t WS_LAT = 139 * MiB;
constexpr size_t WS_HL = 275 * MiB;
constexpr size_t WS_U = 343 * MiB;
constexpr size_t WS_Z = 547 * MiB;
constexpr size_t WS_H = 615 * MiB;
constexpr size_t WS_YS = 751 * MiB;
constexpr size_t WS_END = 887 * MiB;
constexpr size_t WM_SC_IN = 0;
constexpr size_t WM_SC_OUT = WM_SC_IN + 2ull * 3072 * 1024;
constexpr size_t WM_HY_IN = WM_SC_OUT + 2ull * 1024 * 1024;
constexpr size_t WM_HY_OUT = WM_HY_IN + 3072ull * 1024;
constexpr size_t WM_AT_QKV = WM_HY_OUT + 1024ull * 1024;
constexpr size_t WM_AT_O = WM_AT_QKV + 1536ull * 1024;
static_assert((WM_AT_O + 1024ull * 1024) * 2 <= 32 * MiB, "mixer weights");
constexpr int CW_BAR = 4096;
constexpr int CW_WQ = 16384;

constexpr int LDS_MAIN = 155648;
constexpr int LDS_MISC = LDS_MAIN;
constexpr int LDS_BYTES = LDS_MAIN + 4096;

#define LDS_WAIT() asm volatile("s_waitcnt lgkmcnt(0)" ::: "memory")
#define VM_WAIT() asm volatile("s_waitcnt vmcnt(0)" ::: "memory")

__device__ __forceinline__ unsigned f2bf(float f) { unsigned u = __builtin_bit_cast(unsigned, f); return (u + 0x7fffu + ((u >> 16) & 1u)) >> 16; }
__device__ __forceinline__ unsigned pk2(float lo, float hi) { return f2bf(lo) | (f2bf(hi) << 16); }
__device__ __forceinline__ float bf_lo(unsigned w) { return __uint_as_float(w << 16); }
__device__ __forceinline__ float bf_hi(unsigned w) { return __uint_as_float(w & 0xffff0000u); }
__device__ __forceinline__ float bf1(bf16_t b) { return __uint_as_float(((unsigned)b) << 16); }
__device__ __forceinline__ float wave_sum(float v) {
#pragma unroll
    for (int o = 1; o < 64; o <<= 1) v += __shfl_xor(v, o);
    return v;
}
__device__ __forceinline__ int wave_sum_i(int v) {
#pragma unroll
    for (int o = 1; o < 64; o <<= 1) v += __shfl_xor(v, o);
    return v;
}

#define XB_TMO      128
#define XB_XCNT(j)  (256  + 64 * (j))
#define XB_XSUB(j)  (1280 + 64 * (j))
#define XB_XGEN(j)  (2304 + 64 * (j))
#define XB_TOP      3328
#define XB_TOPGEN   3392
#define XCD_BAR_WORDS 3456
#define XB_SPIN_CAP (1u << 22)

__device__ __forceinline__ unsigned xb_ld(unsigned* p)              { return __hip_atomic_load(p, __ATOMIC_RELAXED, __HIP_MEMORY_SCOPE_AGENT); }
__device__ __forceinline__ unsigned xb_add(unsigned* p, unsigned v) { return __hip_atomic_fetch_add(p, v, __ATOMIC_RELAXED, __HIP_MEMORY_SCOPE_AGENT); }
__device__ __forceinline__ unsigned xb_xcc_id() { return (unsigned)__builtin_amdgcn_s_getreg((3 << 11) | 20) & 0xFu; }
#define XB_SPIN(cond, bar) do { unsigned _sp = 0; while (cond) { __builtin_amdgcn_s_sleep(1); \
    if ((++_sp & 255u) == 0u) { if (xb_ld(&(bar)[XB_TMO])) break; if (_sp > XB_SPIN_CAP) { atomicAdd(&(bar)[XB_TMO], 1u); break; } } } } while (0)

struct XcdBarrier { unsigned* bar; unsigned x; volatile LAS unsigned* st; };

__device__ __forceinline__ XcdBarrier xcd_barrier_post(unsigned* bar, volatile LAS unsigned* st) {
    XcdBarrier b; b.bar = bar; b.x = xb_xcc_id(); b.st = st;
    if (threadIdx.x == 0) (void)xb_add(&bar[XB_XCNT(b.x)], 1u);
    return b;
}
__device__ __forceinline__ void xcd_barrier_complete(unsigned* bar, unsigned x, unsigned& nloc, unsigned& nx) {
    const unsigned G = gridDim.x * gridDim.y * gridDim.z;
    unsigned sum, cnt, mine, sp = 0u;
    for (;;) {
        sum = 0u; cnt = 0u; mine = 0u;
#pragma unroll
        for (unsigned j = 0; j < 16; ++j) { const unsigned c = xb_ld(&bar[XB_XCNT(j)]); sum += c; cnt += (c > 0u) ? 1u : 0u; mine = (j == x) ? c : mine; }
        if (sum == G) break;
        __builtin_amdgcn_s_sleep(1);
        if ((++sp & 255u) == 0u) { if (xb_ld(&bar[XB_TMO])) break; if (sp > XB_SPIN_CAP) { atomicAdd(&bar[XB_TMO], 1u); break; } }
    }
    nloc = mine > 0u ? mine : 1u; nx = cnt > 0u ? cnt : 1u;
}
__device__ __forceinline__ void xcd_barrier(const XcdBarrier& b) {
    asm volatile("s_waitcnt vmcnt(0)" ::: "memory");
    __syncthreads();
    if (threadIdx.x == 0) {
        unsigned* bar = b.bar;
        __builtin_amdgcn_s_waitcnt(0);
        unsigned nloc = b.st[0], nx = b.st[1];
        if (nloc == 0u) { xcd_barrier_complete(bar, b.x, nloc, nx); b.st[0] = nloc; b.st[1] = nx; }
        const unsigned old = xb_add(&bar[XB_XSUB(b.x)], 1u);
        const unsigned gen = old / nloc;
        if (old + 1u == (gen + 1u) * nloc) {
            __builtin_amdgcn_fence(__ATOMIC_RELEASE, "agent");
            asm volatile("s_waitcnt vmcnt(0)" ::: "memory");
            const unsigned og = xb_add(&bar[XB_TOP], 1u);
            const unsigned tg = og / nx;
            if (og + 1u == (tg + 1u) * nx) xb_add(&bar[XB_TOPGEN], 1u);
            else XB_SPIN(xb_ld(&bar[XB_TOPGEN]) == tg, bar);
            __builtin_amdgcn_fence(__ATOMIC_ACQUIRE, "agent");
            xb_add(&bar[XB_XGEN(b.x)], 1u);
            asm volatile("s_waitcnt vmcnt(0)" ::: "memory");
        } else {
            XB_SPIN(xb_ld(&bar[XB_XGEN(b.x)]) == gen, bar);
            __builtin_amdgcn_fence(__ATOMIC_ACQUIRE, "agent");
            asm volatile("s_waitcnt vmcnt(0)" ::: "memory");
        }
    }
    __syncthreads();
}

namespace pg8 {
constexpr int BM = 256, BK = 64, HALF = 128, HTB = HALF * BK * 2, STAGE_BYTES = 8 * HTB, NXCD = 8, WGM = 8;
__host__ __device__ __forceinline__ int lds_byte(int r, int c) { const int st = (r >> 4) * 2 + (c >> 5), rr = r & 15, cc = c & 31, ob = rr * 64 + cc * 2; return st * 1024 + (ob ^ (((ob >> 9) & 1) << 5)); }
__host__ __device__ __forceinline__ void stage_rc(int b, int& R, int& C) { const int st = b / 1024, sb = b % 1024, swz = sb ^ (((sb >> 9) & 1) << 5); R = (st >> 1) * 16 + swz / 64; C = (st & 1) * 32 + (swz % 64) / 2; }
__host__ __device__ __forceinline__ int perm32(int rho) { const int n = rho >> 4, i = rho & 15; return 8 * (i >> 2) + 4 * n + (i & 3); }

struct Unit { int pm, pn; };
struct Gemm { const bf16_t* A; const bf16_t* Bt; int M, N, K; int tpg; const int* rowlist; };

struct StaticOrder {
    int nM, nN, nwg, G, c;
    __device__ void init(int M, int N, int G_, int c_) { nM = M / BM; nN = N / BM; nwg = nM * nN; G = G_; c = c_; }
    __device__ bool next(int i, Unit& u) const {
        const long L = (long)i * G + c; if (L >= nwg) return false;
        int wgid = (int)L; { const int q = nwg / NXCD, r = nwg % NXCD, xcd = wgid % NXCD, off = wgid / NXCD; wgid = (xcd < r ? xcd * (q + 1) : r * (q + 1) + (xcd - r) * q) + off; }
        const int nig = WGM * nN, gid = wgid / nig, fm = gid * WGM, gsz = (nM - fm) < WGM ? (nM - fm) : WGM;
        u.pm = fm + ((wgid % nig) % gsz); u.pn = (wgid % nig) / gsz; return true;
    }
};

__device__ __forceinline__ unsigned cvt_pk_bf16(float lo, float hi) { unsigned r; asm volatile("v_cvt_pk_bf16_f32 %0, %1, %2" : "=v"(r) : "v"(lo), "v"(hi)); return r; }

template <class Epi, class Sched, bool GATHER>
__device__ __forceinline__ void gemm_phase(LAS unsigned char* lds, const Gemm g, const Sched& S, const Epi& E) {
    const int tid = threadIdx.x, wid = __builtin_amdgcn_readfirstlane(tid >> 6), lane = tid & 63, wr = wid >> 2, wc = wid & 3, fr = lane & 15, fq = lane >> 4;
    const int K = g.K, nt = K / BK, nN = g.N / BM;
    const size_t kstep = (size_t)(BK * 2);
    const size_t hstep = (size_t)HALF * K * 2;
    const size_t tstep = 2 * hstep;
    unsigned voffB[2], vA0[2], vA1[2], nA0[2], nA1[2]; int RA[2], CA[2];
#pragma unroll
    for (int i = 0; i < 2; ++i) { int R, C; stage_rc(tid * 16 + i * 8192, R, C); const int Rb = Epi::PERM ? ((R & ~31) + perm32(R & 31)) : R;
        RA[i] = R; CA[i] = C;
        vA0[i] = (unsigned)(R * K + C) * 2u; vA1[i] = vA0[i] + (unsigned)hstep; nA0[i] = vA0[i]; nA1[i] = vA1[i];
        voffB[i] = (unsigned)(Rb * K + C) * 2u; }
    const unsigned ldsw = (unsigned)wid * 1024u;
    const int aoff = lds_byte(wr * 64 + fr, fq * 8), boff = lds_byte(wc * 32 + fr, fq * 8);
#define PG8_SA(b, h) (((b) * 2 + (h)) * HTB)
#define PG8_SB(b, h) ((4 + (b) * 2 + (h)) * HTB)
#define PG8_STAGE(bufoff, gbase, voff) do { _Pragma("unroll") for (int _i = 0; _i < 2; ++_i) \
        __builtin_amdgcn_global_load_lds((const unsigned*)((const char*)(gbase) + (voff)[_i]), (LAS unsigned*)(lds + (bufoff) + ldsw + _i * 8192), 16, 0, 0); } while (0)
#define PG8_LDA(dst, b, h) do { _Pragma("unroll") for (int m = 0; m < 4; ++m) _Pragma("unroll") for (int k = 0; k < 2; ++k) dst[m][k] = *(const LAS bf16x8*)(lds + PG8_SA(b, h) + aoff + m * 2048 + k * 1024); } while (0)
#define PG8_LDB(dst, b, h) do { _Pragma("unroll") for (int n = 0; n < 2; ++n) _Pragma("unroll") for (int k = 0; k < 2; ++k) dst[n][k] = *(const LAS bf16x8*)(lds + PG8_SB(b, h) + boff + n * 2048 + k * 1024); } while (0)
#define PG8_MMA(ai, bj, At, Bt) do { __builtin_amdgcn_s_setprio(1); _Pragma("unroll") for (int m = 0; m < 4; ++m) _Pragma("unroll") for (int n = 0; n < 2; ++n) _Pragma("unroll") for (int k = 0; k < 2; ++k) \
        acc[ai][bj][m][n] = __builtin_amdgcn_mfma_f32_16x16x32_bf16(Bt[n][k], At[m][k], acc[ai][bj][m][n], 0, 0, 0); __builtin_amdgcn_s_setprio(0); } while (0)
#define PG8_WAIT_V(n) asm volatile("s_waitcnt vmcnt(" #n ")" ::: "memory")
#define PG8_WAIT_L(n) asm volatile("s_waitcnt lgkmcnt(" #n ")" ::: "memory")
#define PG8_BAR __builtin_amdgcn_s_barrier()
#define PG8_SCHED __builtin_amdgcn_sched_barrier(0)
    Unit cur, nxt; int ui = 0;
    if (!S.next(0, cur)) return;
    f32x4 acc[2][2][4][2];
#pragma unroll
    for (int a = 0; a < 2; ++a)
#pragma unroll
        for (int b = 0; b < 2; ++b)
#pragma unroll
            for (int m = 0; m < 4; ++m)
#pragma unroll
                for (int n = 0; n < 2; ++n) acc[a][b][m][n] = (f32x4){0.f, 0.f, 0.f, 0.f};
    bf16x8 At[4][2], B0[2][2], B1[2][2];
    const char* cA; const char* cB = (const char*)g.Bt + (size_t)((cur.pm / g.tpg) * nN + cur.pn) * tstep;
    if (GATHER) {
        cA = (const char*)g.A;
#pragma unroll
        for (int i = 0; i < 2; ++i) { const int r0 = g.rowlist[cur.pm * BM + RA[i]], r1 = g.rowlist[cur.pm * BM + HALF + RA[i]];
            vA0[i] = (unsigned)(r0 * K + CA[i]) * 2u; vA1[i] = (unsigned)(r1 * K + CA[i]) * 2u; }
    } else cA = (const char*)g.A + (size_t)cur.pm * tstep;
    PG8_STAGE(PG8_SB(0, 0), cB, voffB); PG8_STAGE(PG8_SA(0, 0), cA, vA0); PG8_STAGE(PG8_SB(0, 1), cB + hstep, voffB); PG8_STAGE(PG8_SA(0, 1), cA, vA1);
    if (wr == 1) PG8_BAR;
    PG8_WAIT_V(4); PG8_BAR;
    PG8_STAGE(PG8_SB(1, 0), cB + kstep, voffB); PG8_STAGE(PG8_SA(1, 0), cA + kstep, vA0); PG8_STAGE(PG8_SB(1, 1), cB + hstep + kstep, voffB);
    PG8_WAIT_V(6); PG8_BAR;
    for (;;) {
        const bool has_next = S.next(ui + 1, nxt);
        const char* nA; const char* nB = has_next ? (const char*)g.Bt + (size_t)((nxt.pm / g.tpg) * nN + nxt.pn) * tstep : cB;
        if (GATHER) {
            nA = cA;
            if (has_next) {
#pragma unroll
                for (int i = 0; i < 2; ++i) { const int r0 = g.rowlist[nxt.pm * BM + RA[i]], r1 = g.rowlist[nxt.pm * BM + HALF + RA[i]];
                    nA0[i] = (unsigned)(r0 * K + CA[i]) * 2u; nA1[i] = (unsigned)(r1 * K + CA[i]) * 2u; }
            } else {
#pragma unroll
                for (int i = 0; i < 2; ++i) { nA0[i] = vA0[i]; nA1[i] = vA1[i]; }
            }
        } else nA = has_next ? (const char*)g.A + (size_t)nxt.pm * tstep : cA;
        for (int t = 0; t < nt; t += 2) {
            const bool last = (t == nt - 2);
            const char* a1 = cA + (size_t)(t + 1) * kstep;
            const char* a2 = last ? nA : cA + (size_t)(t + 2) * kstep; const char* b2 = last ? nB : cB + (size_t)(t + 2) * kstep;
            const char* a3 = a2 + kstep; const char* b3 = b2 + kstep;
            unsigned s0[2], s1[2];
#pragma unroll
            for (int i = 0; i < 2; ++i) { s0[i] = (GATHER && last) ? nA0[i] : vA0[i]; s1[i] = (GATHER && last) ? nA1[i] : vA1[i]; }
            PG8_LDB(B0, 0, 0); PG8_SCHED; PG8_LDA(At, 0, 0); PG8_STAGE(PG8_SA(1, 1), a1, vA1);
            PG8_WAIT_L(8); PG8_BAR; PG8_WAIT_L(0); PG8_MMA(0, 0, At, B0); PG8_BAR; PG8_SCHED;
            PG8_LDB(B1, 0, 1); PG8_STAGE(PG8_SB(0, 0), b2, voffB);
            PG8_BAR; PG8_WAIT_L(0); PG8_MMA(0, 1, At, B1); PG8_BAR;
            PG8_LDA(At, 0, 1); PG8_STAGE(PG8_SA(0, 0), a2, s0);
            PG8_BAR; PG8_WAIT_L(0); PG8_MMA(1, 0, At, B0); PG8_BAR; PG8_SCHED;
            PG8_STAGE(PG8_SB(0, 1), b2 + hstep, voffB);
            PG8_WAIT_V(6); PG8_BAR; PG8_MMA(1, 1, At, B1); PG8_BAR;
            PG8_LDB(B0, 1, 0); PG8_SCHED; PG8_LDA(At, 1, 0); PG8_STAGE(PG8_SA(0, 1), a2, s1);
            PG8_WAIT_L(8); PG8_BAR; PG8_WAIT_L(0); PG8_MMA(0, 0, At, B0); PG8_BAR; PG8_SCHED;
            PG8_LDB(B1, 1, 1); PG8_STAGE(PG8_SB(1, 0), b3, voffB);
            PG8_BAR; PG8_WAIT_L(0); PG8_MMA(0, 1, At, B1); PG8_BAR;
            PG8_LDA(At, 1, 1); PG8_STAGE(PG8_SA(1, 0), a3, s0);
            PG8_BAR; PG8_WAIT_L(0); PG8_MMA(1, 0, At, B0); PG8_BAR; PG8_SCHED;
            PG8_STAGE(PG8_SB(1, 1), b3 + hstep, voffB);
            PG8_WAIT_V(6); PG8_BAR; PG8_MMA(1, 1, At, B1); PG8_BAR;
        }
        E(acc, cur, wr, wc, fr, fq);
        if (!has_next) break;
#pragma unroll
        for (int a = 0; a < 2; ++a)
#pragma unroll
            for (int b = 0; b < 2; ++b)
#pragma unroll
                for (int m = 0; m < 4; ++m)
#pragma unroll
                    for (int n = 0; n < 2; ++n) acc[a][b][m][n] = (f32x4){0.f, 0.f, 0.f, 0.f};
        cur = nxt; cA = nA; cB = nB; ++ui;
        if (GATHER) {
#pragma unroll
            for (int i = 0; i < 2; ++i) { vA0[i] = nA0[i]; vA1[i] = nA1[i]; }
        }
    }
    PG8_WAIT_V(0);
    if (wr == 0) PG8_BAR;
    PG8_BAR;
#undef PG8_SA
#undef PG8_SB
#undef PG8_STAGE
#undef PG8_LDA
#undef PG8_LDB
#undef PG8_MMA
#undef PG8_WAIT_V
#undef PG8_WAIT_L
#undef PG8_BAR
#undef PG8_SCHED
}

struct EpiBf16 {
    static constexpr bool PERM = true;
    bf16_t* O; int ldc;
    __device__ __forceinline__ void operator()(const f32x4 (&acc)[2][2][4][2], const Unit& u, int wr, int wc, int fr, int fq) const {
        const int row0 = u.pm * BM + wr * 64 + fr, col0 = u.pn * BM + wc * 32 + 8 * fq;
#pragma unroll
        for (int ai = 0; ai < 2; ++ai)
#pragma unroll
            for (int m = 0; m < 4; ++m) { bf16_t* rowp = O + (size_t)(row0 + ai * HALF + m * 16) * ldc + col0;
#pragma unroll
                for (int bj = 0; bj < 2; ++bj) { const f32x4 v0 = acc[ai][bj][m][0], v1 = acc[ai][bj][m][1];
                    u32x4 w; w.x = cvt_pk_bf16(v0[0], v0[1]); w.y = cvt_pk_bf16(v0[2], v0[3]); w.z = cvt_pk_bf16(v1[0], v1[1]); w.w = cvt_pk_bf16(v1[2], v1[3]);
                    *(u32x4*)(rowp + bj * HALF) = w; } }
    }
};
struct EpiRes {
    static constexpr bool PERM = false;
    const float* baseL; const float* baseC; float* out; const float* gate;
    __device__ __forceinline__ void operator()(const f32x4 (&acc)[2][2][4][2], const Unit& u, int wr, int wc, int fr, int fq) const {
        const int row0 = u.pm * BM + wr * 64 + fr, col0 = u.pn * BM + wc * 32 + 4 * fq;
        const bool isc = u.pm >= NLAT / BM;
        const int midx = isc ? 8 : (u.pm >> 4);
        const float* gp = gate + (size_t)midx * MODW + col0;
        const float* bp = isc ? baseC + (size_t)(row0 - NLAT) * DM + col0 : baseL + (size_t)row0 * DM + col0;
        float* op = out + (size_t)row0 * DM + col0;
        f32x4 gv[2][2];
#pragma unroll
        for (int bj = 0; bj < 2; ++bj)
#pragma unroll
            for (int n = 0; n < 2; ++n) gv[bj][n] = *(const f32x4*)(gp + bj * HALF + n * 16);
#pragma unroll
        for (int ai = 0; ai < 2; ++ai)
#pragma unroll
            for (int m = 0; m < 4; ++m) { const size_t ro = (size_t)(ai * HALF + m * 16) * DM;
#pragma unroll
                for (int bj = 0; bj < 2; ++bj)
#pragma unroll
                    for (int n = 0; n < 2; ++n) { const f32x4 bs = *(const f32x4*)(bp + ro + bj * HALF + n * 16);
                        *(f32x4*)(op + ro + bj * HALF + n * 16) = bs + gv[bj][n] * acc[ai][bj][m][n]; }
                asm volatile("" ::: "memory"); }
    }
};
struct EpiMoeUp {
    static constexpr bool PERM = true;
    bf16_t* H;
    __device__ __forceinline__ void operator()(const f32x4 (&acc)[2][2][4][2], const Unit& u, int wr, int wc, int fr, int fq) const {
        const int row0 = u.pm * BM + wr * 64 + fr, col0 = u.pn * HALF + wc * 32 + 8 * fq;
#pragma unroll
        for (int ai = 0; ai < 2; ++ai)
#pragma unroll
            for (int m = 0; m < 4; ++m) { bf16_t* rowp = H + (size_t)(row0 + ai * HALF + m * 16) * DM + col0;
                float h[8];
#pragma unroll
                for (int n = 0; n < 2; ++n)
#pragma unroll
                    for (int j = 0; j < 4; ++j) { const float gt = acc[ai][0][m][n][j], up = acc[ai][1][m][n][j];
                        h[n * 4 + j] = gt * __builtin_amdgcn_rcpf(1.0f + __expf(-gt)) * up; }
                u32x4 w; w.x = cvt_pk_bf16(h[0], h[1]); w.y = cvt_pk_bf16(h[2], h[3]); w.z = cvt_pk_bf16(h[4], h[5]); w.w = cvt_pk_bf16(h[6], h[7]);
                *(u32x4*)rowp = w; }
    }
};
struct EpiMoeDown {
    static constexpr bool PERM = true;
    bf16_t* Y; const float* gl;
    __device__ __forceinline__ void operator()(const f32x4 (&acc)[2][2][4][2], const Unit& u, int wr, int wc, int fr, int fq) const {
        const int row0 = u.pm * BM + wr * 64 + fr, col0 = u.pn * BM + wc * 32 + 8 * fq;
#pragma unroll
        for (int ai = 0; ai < 2; ++ai)
#pragma unroll
            for (int m = 0; m < 4; ++m) { const int row = row0 + ai * HALF + m * 16; const float gg = gl[row]; bf16_t* rowp = Y + (size_t)row * DM + col0;
#pragma unroll
                for (int bj = 0; bj < 2; ++bj) { const f32x4 v0 = acc[ai][bj][m][0] * gg, v1 = acc[ai][bj][m][1] * gg;
                    u32x4 w; w.x = cvt_pk_bf16(v0[0], v0[1]); w.y = cvt_pk_bf16(v0[2], v0[3]); w.z = cvt_pk_bf16(v1[0], v1[1]); w.w = cvt_pk_bf16(v1[2], v1[3]);
                    *(u32x4*)(rowp + bj * HALF) = w; } }
    }
};
}


namespace att {
constexpr int D = 128, NW = 8, QBLK = 32, KVBLK = 64;
constexpr float SCALE = 0.088388347648318440f;
constexpr float THR = 8.f;
constexpr int SDEPTH = 2;
constexpr int LDQ = 1536, LDK = 256, LDO = 1024;
constexpr size_t SHM_V = KVBLK * D * 2, SHM_K = KVBLK * D * 2, SHM_ATTN = 2 * SHM_V + 2 * SHM_K + NW * 64 * 4;
using s16x4  = __attribute__((ext_vector_type(4))) short;
using f32x16 = __attribute__((ext_vector_type(16))) float;
#define KSWZ(row, colB) ((row) * 256 + ((colB) ^ (((row) & 7) << 4)))
#define SBAR() __builtin_amdgcn_sched_barrier(0)
__device__ __forceinline__ int crow(int r, int hi) { return (r & 3) + 8 * (r >> 2) + 4 * hi; }
__device__ __forceinline__ unsigned cvtpk(float lo, float hi) { unsigned r; asm volatile("v_cvt_pk_bf16_f32 %0, %1, %2" : "=v"(r) : "v"(lo), "v"(hi)); return r; }
__device__ __forceinline__ bf16x8 ld8(const bf16_t* p) { return *reinterpret_cast<const bf16x8*>(p); }

__device__ __forceinline__ void partialSM(f32x16& p0, f32x16& p1, float& m_reg, float& mn, float& alpha) {
  constexpr float C = SCALE * 1.4426950408889634f;
  float pmax = p0[0]; for (int r = 1; r < 16; ++r) pmax = fmaxf(pmax, p0[r]); for (int r = 0; r < 16; ++r) pmax = fmaxf(pmax, p1[r]);
  { auto rr = __builtin_amdgcn_permlane32_swap(__float_as_uint(pmax), __float_as_uint(pmax), false, false);
    pmax = fmaxf(__uint_as_float(rr[0]), __uint_as_float(rr[1])); }
  if (__builtin_expect(__all(pmax - m_reg <= THR / SCALE), 1)) { mn = m_reg; alpha = 1.f; }
  else { mn = fmaxf(m_reg, pmax); alpha = __builtin_amdgcn_exp2f((m_reg - mn) * C); m_reg = mn; }
  float mnC = -mn * C;
  for (int r = 0; r < 16; ++r) p0[r] = fmaf(p0[r], C, mnC); for (int r = 0; r < 16; ++r) p1[r] = fmaf(p1[r], C, mnC);
  for (int r = 0; r < 16; ++r) p0[r] = __builtin_amdgcn_exp2f(p0[r]);
}
__device__ __forceinline__ void finishSM(f32x16& p0, f32x16& p1, float alpha, float& l_reg, bf16x8& pa0, bf16x8& pa1, bf16x8& pa2, bf16x8& pa3) {
  for (int r = 0; r < 16; ++r) p1[r] = __builtin_amdgcn_exp2f(p1[r]);
  float ps = 0; for (int r = 0; r < 16; ++r) ps += p0[r]; for (int r = 0; r < 16; ++r) ps += p1[r];
  { auto rr = __builtin_amdgcn_permlane32_swap(__float_as_uint(ps), __float_as_uint(ps), false, false);
    ps = __uint_as_float(rr[0]) + __uint_as_float(rr[1]); }
  l_reg = l_reg * alpha + ps;
#define PK4(P, BASE, OUT) do { unsigned a0 = cvtpk(P[BASE + 0], P[BASE + 1]), a1 = cvtpk(P[BASE + 2], P[BASE + 3]);   \
    unsigned b0 = cvtpk(P[BASE + 4], P[BASE + 5]), b1 = cvtpk(P[BASE + 6], P[BASE + 7]);                              \
    auto r0 = __builtin_amdgcn_permlane32_swap(a0, b0, false, false); auto r1 = __builtin_amdgcn_permlane32_swap(a1, b1, false, false); \
    u32x4 w = {r0[0], r1[0], r0[1], r1[1]}; OUT = *reinterpret_cast<bf16x8*>(&w); } while (0)
  PK4(p0, 0, pa0); PK4(p0, 8, pa1); PK4(p1, 0, pa2); PK4(p1, 8, pa3);
#undef PK4
}
__device__ __forceinline__ void qkt(f32x16& p0, f32x16& p1, const bf16_t* Ks, const bf16x8* qr, int r32, int hi) {
  p0 = f32x16{}; p1 = f32x16{};
  for (int d0 = 0; d0 < 8; ++d0) { int cb = (d0 * 16 + hi * 8) * 2;
    bf16x8 b0 = *reinterpret_cast<const bf16x8*>((const char*)Ks + KSWZ(r32, cb));
    bf16x8 b1 = *reinterpret_cast<const bf16x8*>((const char*)Ks + KSWZ(32 + r32, cb));
    p0 = __builtin_amdgcn_mfma_f32_32x32x16_bf16(b0, qr[d0], p0, 0, 0, 0);
    p1 = __builtin_amdgcn_mfma_f32_32x32x16_bf16(b1, qr[d0], p1, 0, 0, 0); }
}
__device__ __forceinline__ int v_st(int k, int c) { const int kk = (k & ~0xC) | ((k & 4) << 1) | ((k & 8) >> 1); return ((kk >> 3) * 4 + (c >> 5)) * 512 + ((kk & 7) * 32 + (c & 31)) * 2; }
__device__ __forceinline__ int v_rd_base(int lane) { return ((lane & 3) << 3) | (((lane >> 2) & 3) << 6) | (((lane >> 4) & 1) << 5) | (((lane >> 5) & 1) << 8); }
constexpr int v_rd_off(int d0, int ks, int half) { return d0 * 512 + ks * 4096 + half * 2048; }
template <int OFF> __device__ __forceinline__ s16x4 tr_read(int vb) {
  s16x4 r; asm volatile("ds_read_b64_tr_b16 %0, %1 offset:%2" : "=&v"(r) : "v"(vb), "i"(OFF) : "memory"); return r;
}
template <int D0> __device__ __forceinline__ void pv_one(f32x16& od, int vb, bf16x8 pa0, bf16x8 pa1, bf16x8 pa2, bf16x8 pa3) {
  const s16x4 l0 = tr_read<v_rd_off(D0, 0, 0)>(vb), h0 = tr_read<v_rd_off(D0, 0, 1)>(vb), l1 = tr_read<v_rd_off(D0, 1, 0)>(vb), h1 = tr_read<v_rd_off(D0, 1, 1)>(vb);
  const s16x4 l2 = tr_read<v_rd_off(D0, 2, 0)>(vb), h2 = tr_read<v_rd_off(D0, 2, 1)>(vb), l3 = tr_read<v_rd_off(D0, 3, 0)>(vb), h3 = tr_read<v_rd_off(D0, 3, 1)>(vb);
  asm volatile("s_waitcnt lgkmcnt(0)" ::: "memory"); SBAR();
#define PK(L, H) (bf16x8){L[0], L[1], L[2], L[3], H[0], H[1], H[2], H[3]}
  od = __builtin_amdgcn_mfma_f32_32x32x16_bf16(pa0, PK(l0, h0), od, 0, 0, 0);
  od = __builtin_amdgcn_mfma_f32_32x32x16_bf16(pa1, PK(l1, h1), od, 0, 0, 0);
  od = __builtin_amdgcn_mfma_f32_32x32x16_bf16(pa2, PK(l2, h2), od, 0, 0, 0);
  od = __builtin_amdgcn_mfma_f32_32x32x16_bf16(pa3, PK(l3, h3), od, 0, 0, 0);
#undef PK
}
__device__ __forceinline__ void pv_d0(f32x16* o, int vb, bf16x8 pa0, bf16x8 pa1, bf16x8 pa2, bf16x8 pa3) {
  pv_one<0>(o[0], vb, pa0, pa1, pa2, pa3); pv_one<1>(o[1], vb, pa0, pa1, pa2, pa3); pv_one<2>(o[2], vb, pa0, pa1, pa2, pa3); pv_one<3>(o[3], vb, pa0, pa1, pa2, pa3);
}
__device__ __forceinline__ void attn_dense_body(const bf16_t* __restrict__ Qb, const bf16_t* __restrict__ Kh, const bf16_t* __restrict__ Vh,
                                                bf16_t* __restrict__ Ob, int seq, char* lds) {
  const int tid = threadIdx.x, wid = tid >> 6, lane = tid & 63, r32 = lane & 31, hi = lane >> 5;
  bf16_t* V_lds = (bf16_t*)lds; bf16_t* K_lds = (bf16_t*)(lds + 2 * SHM_V);
  float* ws = (float*)(lds + 2 * SHM_V + 2 * SHM_K) + wid * 64; float* li_l = ws; float* al_l = ws + 32;
  float m_reg = -1e30f, l_reg = 0; f32x16 o[4] = {}; bf16x8 qr[8];
  const bf16_t* Qw = Qb + (long)(wid * QBLK + r32) * LDQ + hi * 8;
#pragma unroll
  for (int d0 = 0; d0 < 8; ++d0) qr[d0] = ld8(Qw + d0 * 16);
  const int sr = tid >> 4, sc = (tid & 15) * 8, vst0 = v_st(sr, sc), vst1 = v_st(32 + sr, sc);
  const int vb0 = (int)(uintptr_t)V_lds + v_rd_base(lane);
  struct { bf16x8 vs0, vs1, ks0, ks1; } sr_[SDEPTH];
#define SLOAD(i, k0) do { sr_[i].vs0 = ld8(&Vh[(long)((k0) + sr) * LDK + sc]); sr_[i].vs1 = ld8(&Vh[(long)((k0) + 32 + sr) * LDK + sc]); \
    sr_[i].ks0 = ld8(&Kh[(long)((k0) + sr) * LDK + sc]); sr_[i].ks1 = ld8(&Kh[(long)((k0) + 32 + sr) * LDK + sc]); } while (0)
#define SWRITE(b, i) do { *(bf16x8*)((char*)V_lds + (b) * SHM_V + vst0) = sr_[i].vs0;          \
    *(bf16x8*)((char*)V_lds + (b) * SHM_V + vst1) = sr_[i].vs1; int kc = sc * 2;               \
    *(bf16x8*)((char*)K_lds + (b) * SHM_K + KSWZ(sr, kc)) = sr_[i].ks0;                       \
    *(bf16x8*)((char*)K_lds + (b) * SHM_K + KSWZ(32 + sr, kc)) = sr_[i].ks1; } while (0)
#define SWAIT() do { if constexpr (SDEPTH == 2) asm volatile("s_waitcnt vmcnt(4)" ::: "memory"); else asm volatile("s_waitcnt vmcnt(0)" ::: "memory"); } while (0)
#define RESC(a) do { if (__any((a) < 1.f)) { if (hi == 0) al_l[r32] = (a); asm volatile("s_waitcnt lgkmcnt(0)" ::: "memory"); \
    for (int d = 0; d < 4; ++d) for (int r = 0; r < 16; ++r) o[d][r] *= al_l[crow(r, hi)]; } } while (0)
  f32x16 pA0, pA1, pB0, pB1; float mnA, mnB, alA, alB; bf16x8 pa0, pa1, pa2, pa3; const int NT = seq / KVBLK;
  constexpr int SE = 0, SO = SDEPTH - 1;
  SLOAD(SE, 0); asm volatile("s_waitcnt vmcnt(0)" ::: "memory"); SWRITE(0, SE); __syncthreads();
  qkt(pA0, pA1, K_lds, qr, r32, hi); partialSM(pA0, pA1, m_reg, mnA, alA);
  SLOAD(SO, KVBLK); if constexpr (SDEPTH == 2) { if (2 < NT) SLOAD(SE, 2 * KVBLK); }
  SWAIT(); SWRITE(1, SO); __syncthreads();
  for (int j = 1; j + 1 < NT; j += 2) {
    SBAR(); qkt(pB0, pB1, (bf16_t*)((char*)K_lds + SHM_K), qr, r32, hi);
    finishSM(pA0, pA1, alA, l_reg, pa0, pa1, pa2, pa3); SBAR();
    SLOAD(SO, (j + SDEPTH) * KVBLK); SBAR();
    pv_d0(o, vb0, pa0, pa1, pa2, pa3); partialSM(pB0, pB1, m_reg, mnB, alB);
    __syncthreads(); SWAIT(); SWRITE(0, SE);
    RESC(alB); __syncthreads();
    SBAR(); qkt(pA0, pA1, K_lds, qr, r32, hi);
    finishSM(pB0, pB1, alB, l_reg, pa0, pa1, pa2, pa3); SBAR();
    if (SDEPTH == 1 || j + 3 < NT) SLOAD(SE, (j + 1 + SDEPTH) * KVBLK); SBAR();
    pv_d0(o, vb0 + (int)SHM_V, pa0, pa1, pa2, pa3); partialSM(pA0, pA1, m_reg, mnA, alA);
    __syncthreads(); SWAIT(); SWRITE(1, SO);
    RESC(alA); __syncthreads();
  }
  SBAR(); qkt(pB0, pB1, (bf16_t*)((char*)K_lds + SHM_K), qr, r32, hi);
  finishSM(pA0, pA1, alA, l_reg, pa0, pa1, pa2, pa3); SBAR();
  pv_d0(o, vb0, pa0, pa1, pa2, pa3); partialSM(pB0, pB1, m_reg, mnB, alB);
  __syncthreads(); RESC(alB);
  finishSM(pB0, pB1, alB, l_reg, pa0, pa1, pa2, pa3); SBAR();
  pv_d0(o, vb0 + (int)SHM_V, pa0, pa1, pa2, pa3);
  if (hi == 0) li_l[r32] = l_reg; asm volatile("s_waitcnt lgkmcnt(0)" ::: "memory");
  float rli[16];
#pragma unroll
  for (int r = 0; r < 16; ++r) rli[r] = __builtin_amdgcn_rcpf(li_l[crow(r, hi)]);
  bf16_t* Ow = Ob + (long)(wid * QBLK) * LDO;
#pragma unroll
  for (int r = 0; r < 16; ++r) { int orow = crow(r, hi);
    for (int d0 = 0; d0 < 4; ++d0) Ow[(long)orow * LDO + d0 * 32 + r32] = (bf16_t)f2bf(o[d0][r] * rli[r]); }
#undef SLOAD
#undef SWRITE
#undef SWAIT
#undef RESC
}
#undef KSWZ
#undef SBAR
}

struct Frame {
    LAS unsigned char* lds;
    int tid, lane, wave, G, gw, NGW;
};
struct Args { const float* in[28]; float* out; unsigned char* ws; int ph_lo, ph_hi; };

enum { I_X = 0, I_C, I_CTX, I_CCTX, I_ADAW, I_ADAB, I_NORMG, I_SCWIN, I_SCCONV, I_SCWOUT, I_HYWIN, I_HYCONV, I_HYFW1, I_HYFB1, I_HYFW2, I_HYFB2, I_HYFW3, I_HYFREQ, I_HYSKIP, I_HYWOUT,
       I_ATQKV, I_ATQG, I_ATKG, I_ATWO, I_ROUTER, I_WGATE, I_WUP, I_WDOWN };

__device__ __forceinline__ void p0_mod(const Frame& F, const Args& a) {
    LAS float* s = (LAS float*)F.lds;
    LAS float* red = (LAS float*)(F.lds + 9 * 1024 * 4);
    const float* c = a.in[I_C]; const float* cc = a.in[I_CCTX];
    for (int idx = F.tid; idx < 9 * 1024; idx += 512) { const int m = idx >> 10, k = idx & 1023; const float v = m < 8 ? c[m * 1024 + k] : cc[k]; s[idx] = v / (1.0f + __expf(-v)); }
    __syncthreads();
    float* modv = (float*)(a.ws + WS_MODV);
    for (int u = blockIdx.x; u < DEPTH * 96; u += F.G) {
        const int layer = u / 96, col0 = (u % 96) * 64, col = F.tid & 63, kp = F.tid >> 6;
        const float* w = a.in[I_ADAW] + (size_t)layer * DM * MODW + col0 + col;
        float acc[9];
#pragma unroll
        for (int m = 0; m < 9; ++m) acc[m] = 0.f;
#pragma unroll 8
        for (int k = kp * 128; k < kp * 128 + 128; ++k) { const float wv = w[(size_t)k * MODW];
#pragma unroll
            for (int m = 0; m < 9; ++m) acc[m] += s[m * 1024 + k] * wv; }
#pragma unroll
        for (int m = 0; m < 9; ++m) red[(kp * 9 + m) * 64 + col] = acc[m];
        __syncthreads();
        for (int o = F.tid; o < 9 * 64; o += 512) { const int m = o >> 6, cq = o & 63; float t = 0.f;
#pragma unroll
            for (int q = 0; q < 8; ++q) t += red[(q * 9 + m) * 64 + cq];
            modv[((size_t)layer * 9 + m) * MODW + col0 + cq] = t + a.in[I_ADAB][layer * MODW + col0 + cq]; }
        __syncthreads();
    }
}

__device__ __forceinline__ void transpose_item(const float* W, int K, int N, bf16_t* WT, int k0, int n0, int drow0, LAS float* scr, int lane) {
#pragma unroll 8
    for (int i = 0; i < 32; ++i) { const int kk = 2 * i + (lane >> 5); scr[kk * 33 + (lane & 31)] = W[(size_t)(k0 + kk) * N + n0 + (lane & 31)]; }
    LDS_WAIT(); asm volatile("" ::: "memory");
    const int c = lane & 7;
#pragma unroll
    for (int j = 0; j < 4; ++j) { const int n = (lane >> 3) + 8 * j; const LAS float* sp = scr + (8 * c) * 33 + n;
        u32x4 o; o.x = pk2(sp[0 * 33], sp[1 * 33]); o.y = pk2(sp[2 * 33], sp[3 * 33]); o.z = pk2(sp[4 * 33], sp[5 * 33]); o.w = pk2(sp[6 * 33], sp[7 * 33]);
        *(u32x4*)(WT + (size_t)(drow0 + n) * K + k0 + 8 * c) = o; }
    LDS_WAIT(); asm volatile("" ::: "memory");
}
__device__ __forceinline__ void transpose_plain(const float* W, int K, int N, bf16_t* WT, int item, LAS float* scr, int lane) {
    const int nblk = N / 32, kb = item / nblk, nb = item % nblk;
    transpose_item(W, K, N, WT, 64 * kb, 32 * nb, 32 * nb, scr, lane);
}

__device__ __forceinline__ void p0_convert_mixers(const Frame& F, const Args& a) {
    LAS float* scr = (LAS float*)(F.lds + 65536 + F.wave * 8704);
    bf16_t* wm = (bf16_t*)(a.ws + WS_WMIX);
    constexpr int I_IN = 16 * 96, I_SQ = 16 * 32, I_QKV = 16 * 48;
    constexpr int NIT = 2 * I_IN + 2 * I_SQ + I_IN + I_SQ + I_QKV + I_SQ;
    for (int it = F.gw; it < NIT; it += F.NGW) {
        int r = it;
        if (r < I_IN) { transpose_plain(a.in[I_SCWIN], DM, 3072, wm + WM_SC_IN, r, scr, F.lane); continue; } r -= I_IN;
        if (r < I_IN) { transpose_plain(a.in[I_SCWIN] + (size_t)DM * 3072, DM, 3072, wm + WM_SC_IN + 3072ull * 1024, r, scr, F.lane); continue; } r -= I_IN;
        if (r < I_SQ) { transpose_plain(a.in[I_SCWOUT], DM, DM, wm + WM_SC_OUT, r, scr, F.lane); continue; } r -= I_SQ;
        if (r < I_SQ) { transpose_plain(a.in[I_SCWOUT] + (size_t)DM * DM, DM, DM, wm + WM_SC_OUT + 1024ull * 1024, r, scr, F.lane); continue; } r -= I_SQ;
        if (r < I_IN) { transpose_plain(a.in[I_HYWIN], DM, 3072, wm + WM_HY_IN, r, scr, F.lane); continue; } r -= I_IN;
        if (r < I_SQ) { transpose_plain(a.in[I_HYWOUT], DM, DM, wm + WM_HY_OUT, r, scr, F.lane); continue; } r -= I_SQ;
        if (r < I_QKV) { transpose_plain(a.in[I_ATQKV], DM, 1536, wm + WM_AT_QKV, r, scr, F.lane); continue; } r -= I_QKV;
        transpose_plain(a.in[I_ATWO], DM, DM, wm + WM_AT_O, r, scr, F.lane);
    }
}

__device__ __forceinline__ void norm_row(const float* xrow, const float* gvec, const float* shv, const float* scv, bf16_t* orow, int lane, f32x4 (&y)[4]) {
    const f32x4* xr = (const f32x4*)xrow + lane;
    f32x4 v[4]; float ss = 0.f;
#pragma unroll
    for (int j = 0; j < 4; ++j) { v[j] = xr[64 * j]; ss += (v[j].x * v[j].x + v[j].y * v[j].y) + (v[j].z * v[j].z + v[j].w * v[j].w); }
    const float rstd = 1.0f / sqrtf(wave_sum(ss) * (1.0f / DM) + EPS);
    unsigned long long* o8 = (unsigned long long*)orow + lane;
#pragma unroll
    for (int j = 0; j < 4; ++j) { const f32x4 gg = ((const f32x4*)gvec)[lane + 64 * j], sh = ((const f32x4*)shv)[lane + 64 * j], sc = ((const f32x4*)scv)[lane + 64 * j];
        y[j] = (v[j] * rstd * gg) * (sc + 1.0f) + sh;
        o8[64 * j] = (unsigned long long)pk2(y[j].x, y[j].y) | ((unsigned long long)pk2(y[j].z, y[j].w) << 32); }
}
__device__ __forceinline__ void norm1_phase(const Frame& F, const float* srcL, const float* srcC, int nrows, const float* gvec, const float* modl, bf16_t* hl) {
    for (int row = F.gw; row < nrows; row += F.NGW) {
        const int midx = row < NLAT ? (row >> 12) : 8;
        const float* xr = row < NLAT ? srcL + (size_t)row * DM : srcC + (size_t)(row - NLAT) * DM;
        f32x4 y[4];
        norm_row(xr, gvec, modl + (size_t)midx * MODW, modl + (size_t)midx * MODW + DM, hl + (size_t)row * DM, F.lane, y);
    }
}

__device__ __forceinline__ void sc_conv_phase(const Frame& F, const bf16_t* U, const float* convw  , bf16_t* Z, int nrows) {
    const int nitems = (nrows / 16) * 2;
    for (int it = F.gw; it < nitems; it += F.NGW) {
        const int run = it >> 1, chunk = it & 1, r0 = run * 16, col = chunk * 512 + F.lane * 8;
        int pos0, slen; if (r0 < NLAT) { pos0 = r0 & (SEQ - 1); slen = SEQ; } else { pos0 = (r0 - NLAT) & (CTXL - 1); slen = CTXL; }
        float w0[8], w1[8], w2[8];
#pragma unroll
        for (int j = 0; j < 8; ++j) { w0[j] = convw[col + j]; w1[j] = convw[DM + col + j]; w2[j] = convw[2 * DM + col + j]; }
        float pm[8], pc[8], pn[8];
        auto loadp = [&](int row, float (&p)[8]) {
            const u32x4 gc = *(const u32x4*)(U + (size_t)row * 3072 + DM + col), vv = *(const u32x4*)(U + (size_t)row * 3072 + 2 * DM + col);
            p[0] = bf_lo(gc.x) * bf_lo(vv.x); p[1] = bf_hi(gc.x) * bf_hi(vv.x); p[2] = bf_lo(gc.y) * bf_lo(vv.y); p[3] = bf_hi(gc.y) * bf_hi(vv.y);
            p[4] = bf_lo(gc.z) * bf_lo(vv.z); p[5] = bf_hi(gc.z) * bf_hi(vv.z); p[6] = bf_lo(gc.w) * bf_lo(vv.w); p[7] = bf_hi(gc.w) * bf_hi(vv.w); };
        if (pos0 > 0) loadp(r0 - 1, pm); else {
#pragma unroll
            for (int j = 0; j < 8; ++j) pm[j] = 0.f; }
        loadp(r0, pc);
        for (int i = 0; i < 16; ++i) {
            const int row = r0 + i;
            if (pos0 + i + 1 < slen) loadp(row + 1, pn); else {
#pragma unroll
                for (int j = 0; j < 8; ++j) pn[j] = 0.f; }
            const u32x4 gb = *(const u32x4*)(U + (size_t)row * 3072 + col);
            float g[8] = {bf_lo(gb.x), bf_hi(gb.x), bf_lo(gb.y), bf_hi(gb.y), bf_lo(gb.z), bf_hi(gb.z), bf_lo(gb.w), bf_hi(gb.w)};
            float o[8];
#pragma unroll
            for (int j = 0; j < 8; ++j) o[j] = g[j] * (w0[j] * pm[j] + w1[j] * pc[j] + w2[j] * pn[j]);
            u32x4 w; w.x = pk2(o[0], o[1]); w.y = pk2(o[2], o[3]); w.z = pk2(o[4], o[5]); w.w = pk2(o[6], o[7]);
            *(u32x4*)(Z + (size_t)row * DM + col) = w;
#pragma unroll
            for (int j = 0; j < 8; ++j) { pm[j] = pc[j]; pc[j] = pn[j]; }
        }
    }
}


__device__ __forceinline__ void norm2_router_phase(const Frame& F, const float* lat, int nrows, const float* gvec, const float* modl, bf16_t* hl,
                                                   const float* wrouter, float* affL, float* affC) {
    LAS float* wT = (LAS float*)F.lds;
    for (int idx = F.tid; idx < 16 * DM; idx += 512) { const int k = idx >> 4, e = idx & 15; wT[e * DM + k] = wrouter[idx]; }
    __syncthreads();
    const int lane = F.lane;
    const bool b5 = lane & 32, b4 = lane & 16, b3 = lane & 8, b2 = lane & 4;
    for (int row = F.gw; row < nrows; row += F.NGW) {
        const int midx = row < NLAT ? (row >> 12) : 8;
        f32x4 y[4];
        norm_row(lat + (size_t)row * DM, gvec, modl + (size_t)midx * MODW + 3 * DM, modl + (size_t)midx * MODW + 4 * DM, hl + (size_t)row * DM, lane, y);
        float acc[16];
#pragma unroll
        for (int e = 0; e < 16; ++e) { float s = 0.f;
#pragma unroll
            for (int j = 0; j < 4; ++j) { const f32x4 w = *(const LAS f32x4*)(wT + e * DM + 4 * lane + 256 * j); s += (y[j].x * w.x + y[j].y * w.y) + (y[j].z * w.z + y[j].w * w.w); }
            acc[e] = s; if (e & 1) asm volatile("" ::: "memory"); }
        float a8[8], a4[4], a2[2], a1;
#pragma unroll
        for (int e = 0; e < 8; ++e) { const float send = b5 ? acc[e] : acc[e + 8], keep = b5 ? acc[e + 8] : acc[e]; a8[e] = keep + __shfl_xor(send, 32); }
#pragma unroll
        for (int e = 0; e < 4; ++e) { const float send = b4 ? a8[e] : a8[e + 4], keep = b4 ? a8[e + 4] : a8[e]; a4[e] = keep + __shfl_xor(send, 16); }
#pragma unroll
        for (int e = 0; e < 2; ++e) { const float send = b3 ? a4[e] : a4[e + 2], keep = b3 ? a4[e + 2] : a4[e]; a2[e] = keep + __shfl_xor(send, 8); }
        { const float send = b2 ? a2[0] : a2[1], keep = b2 ? a2[1] : a2[0]; a1 = keep + __shfl_xor(send, 4); }
        a1 += __shfl_xor(a1, 1); a1 += __shfl_xor(a1, 2);
        float mx = a1;
#pragma unroll
        for (int o = 4; o < 64; o <<= 1) mx = fmaxf(mx, __shfl_xor(mx, o));
        const float ex = __expf(a1 - mx); float sm = ex;
#pragma unroll
        for (int o = 4; o < 64; o <<= 1) sm += __shfl_xor(sm, o);
        const float af = ex / sm;
        if ((lane & 3) == 0) { const int e = lane >> 2;
            if (row < NLAT) affL[((size_t)((row >> 12) * NE + e) << 12) + (row & (SEQ - 1))] = af;
            else { const int rc = row - NLAT; affC[((size_t)((rc >> 8) * NE + e) << 8) + (rc & (CTXL - 1))] = af; } }
    }
}

__device__ __forceinline__ int block_excl_scan(int v, LAS int* tmp, int lane, int wave, int& total) {
    int incl = v;
#pragma unroll
    for (int o = 1; o < 64; o <<= 1) { const int t = __shfl_up(incl, o); if (lane >= o) incl += t; }
    if (lane == 63) tmp[wave] = incl;
    __syncthreads();
    int woff = 0, tot = 0;
#pragma unroll
    for (int w = 0; w < 8; ++w) { const int t = tmp[w]; tot += t; if (w < wave) woff += t; }
    __syncthreads();
    total = tot;
    return woff + incl - v;
}
__device__ __forceinline__ void topk_unit(const Frame& F, const float* aff, int N, int K, int e, int rbase, int tokbase, int* rowlist, float* gl, int* slotmap) {
    LAS int* sm = (LAS int*)F.lds;
    const int t = F.tid, lane = F.lane, wave = F.wave;
    unsigned vb[8];
    if (t * 8 < N) { const u32x4 q0 = *(const u32x4*)(aff + t * 8), q1 = *(const u32x4*)(aff + t * 8 + 4);
        vb[0] = q0.x; vb[1] = q0.y; vb[2] = q0.z; vb[3] = q0.w; vb[4] = q1.x; vb[5] = q1.y; vb[6] = q1.z; vb[7] = q1.w; }
    else {
#pragma unroll
        for (int j = 0; j < 8; ++j) vb[j] = 0u; }
    unsigned T = 0u;
    for (int bit = 30; bit >= 0; --bit) {
        const unsigned cand = T | (1u << bit); int c = 0;
#pragma unroll
        for (int j = 0; j < 8; ++j) c += (vb[j] >= cand) ? 1 : 0;
        c = wave_sum_i(c);
        const int buf = bit & 1;
        if (lane == 0) sm[buf * 8 + wave] = c;
        __syncthreads();
        int tot = 0;
#pragma unroll
        for (int w = 0; w < 8; ++w) tot += sm[buf * 8 + w];
        if (tot >= K) T = cand;
    }
    __syncthreads();
    int ngt = 0, neq = 0;
#pragma unroll
    for (int j = 0; j < 8; ++j) { ngt += (vb[j] > T) ? 1 : 0; neq += (vb[j] == T) ? 1 : 0; }
    int tot_gt, tot_eq;
    (void)block_excl_scan(ngt, sm + 16, lane, wave, tot_gt);
    const int eq_pre = block_excl_scan(neq, sm + 16, lane, wave, tot_eq);
    const int need_eq = K - tot_gt;
    int sel[8], nsel = 0, eqr = eq_pre;
#pragma unroll
    for (int j = 0; j < 8; ++j) { int s = 0; if (vb[j] > T) s = 1; else if (vb[j] == T) { s = (eqr < need_eq) ? 1 : 0; ++eqr; } sel[j] = s; nsel += s; }
    int tot_sel;
    int slot = block_excl_scan(nsel, sm + 16, lane, wave, tot_sel);
    if (t * 8 < N) {
#pragma unroll
        for (int j = 0; j < 8; ++j) { const int row = tokbase + t * 8 + j;
            if (sel[j]) { const int pos = rbase + slot; rowlist[pos] = row; gl[pos] = __uint_as_float(vb[j]); slotmap[row * NE + e] = pos; ++slot; }
            else slotmap[row * NE + e] = -1; }
    }
}
__device__ __forceinline__ void topk_convert_phase(const Frame& F, const Args& a, int layer, bool with_ctx, const float* affL, const float* affC, int* rowlist, float* gl, int* slotmap) {
    const int RE = with_ctx ? (REL + REC) : REL;
    const int nunits = with_ctx ? 256 : 128;
    for (int u = blockIdx.x; u < nunits; u += F.G) {
        if (u < 128) { const int b = u >> 4, e = u & 15; topk_unit(F, affL + ((size_t)(b * NE + e) << 12), SEQ, CAPL, e, e * RE + b * CAPL, b * SEQ, rowlist, gl, slotmap); }
        else { const int v = u - 128, b = v >> 4, e = v & 15; topk_unit(F, affC + ((size_t)(b * NE + e) << 8), CTXL, CAPC, e, e * RE + REL + b * CAPC, NLAT + b * CTXL, rowlist, gl, slotmap); }
        __syncthreads();
    }
    __syncthreads();
    LAS float* scr = (LAS float*)(F.lds + 65536 + F.wave * 8704);
    unsigned* ctr = (unsigned*)(a.ws + WS_CTL) + CW_WQ + 64 * layer;
    bf16_t* wup = (bf16_t*)(a.ws + WS_WMOE); bf16_t* wdn = (bf16_t*)(a.ws + WS_WMOE_DN);
    for (;;) {
        unsigned it = 0; if (F.lane == 0) it = __hip_atomic_fetch_add(ctr, 1u, __ATOMIC_RELAXED, __HIP_MEMORY_SCOPE_AGENT);
        it = (unsigned)__builtin_amdgcn_readfirstlane((int)it);
        if (it >= 24576u) break;
        if (it < 16384u) { const int e = it >> 10, r = it & 1023, half = r >> 9, q = r & 511, kb = q >> 5, nb = q & 31, n0 = nb * 32;
            const float* W = (half ? a.in[I_WUP] : a.in[I_WGATE]) + ((size_t)(layer * NE + e) << 20);
            transpose_item(W, DM, DM, wup + ((size_t)e << 21), kb * 64, n0, (n0 >> 7) * 256 + half * 128 + (n0 & 127), scr, F.lane); }
        else { const int r = it - 16384, e = r >> 9, q = r & 511, kb = q >> 5, nb = q & 31;
            const float* W = a.in[I_WDOWN] + ((size_t)(layer * NE + e) << 20);
            transpose_item(W, DM, DM, wdn + ((size_t)e << 20), kb * 64, nb * 32, nb * 32, scr, F.lane); }
    }
}

__device__ __forceinline__ void combine_phase(const Frame& F, float* lat, int nrows, const bf16_t* YS, const int* slotmap, const float* modl,
                                              bool final_layer, float* out, const float* gnext, const float* modnext, bf16_t* hl) {
    const int lane = F.lane;
    for (int row = F.gw; row < nrows; row += F.NGW) {
        const int midx = row < NLAT ? (row >> 12) : 8;
        const int mypos = lane < NE ? slotmap[row * NE + lane] : -1;
        unsigned long long mask = __ballot(mypos >= 0);
        f32x4 acc[4];
#pragma unroll
        for (int j = 0; j < 4; ++j) acc[j] = (f32x4){0.f, 0.f, 0.f, 0.f};
        while (mask) { const int e = __builtin_ctzll(mask); mask &= mask - 1; const int pos = __shfl(mypos, e);
            const u32x2* yr = (const u32x2*)(YS + (size_t)pos * DM) + lane;
#pragma unroll
            for (int j = 0; j < 4; ++j) { const u32x2 w = yr[64 * j]; acc[j] += (f32x4){bf_lo(w.x), bf_hi(w.x), bf_lo(w.y), bf_hi(w.y)}; } }
        f32x4* xr = (f32x4*)(lat + (size_t)row * DM) + lane;
        const f32x4* g2 = (const f32x4*)(modl + (size_t)midx * MODW + 5 * DM) + lane;
        f32x4 v[4]; float ss = 0.f;
#pragma unroll
        for (int j = 0; j < 4; ++j) { v[j] = xr[64 * j] + g2[64 * j] * acc[j]; ss += (v[j].x * v[j].x + v[j].y * v[j].y) + (v[j].z * v[j].z + v[j].w * v[j].w); }
        if (final_layer) { f32x4* o = (f32x4*)(out + (size_t)row * DM) + lane;
#pragma unroll
            for (int j = 0; j < 4; ++j) o[64 * j] = v[j];
        } else {
#pragma unroll
            for (int j = 0; j < 4; ++j) xr[64 * j] = v[j];
            const float rstd = 1.0f / sqrtf(wave_sum(ss) * (1.0f / DM) + EPS);
            const float* shv = modnext + (size_t)midx * MODW; const float* scv = shv + DM;
            unsigned long long* o8 = (unsigned long long*)(hl + (size_t)row * DM) + lane;
#pragma unroll
            for (int j = 0; j < 4; ++j) { const f32x4 gg = ((const f32x4*)gnext)[lane + 64 * j], sh = ((const f32x4*)shv)[lane + 64 * j], sc = ((const f32x4*)scv)[lane + 64 * j];
                const f32x4 y = (v[j] * rstd * gg) * (sc + 1.0f) + sh;
                o8[64 * j] = (unsigned long long)pk2(y.x, y.y) | ((unsigned long long)pk2(y.z, y.w) << 32); }
        }
    }
}

__device__ __forceinline__ void attn_prep_phase(const Frame& F, bf16_t* U, const float* qg, const float* kg, bf16_t* Kb, bf16_t* Vb) {
    const int lane = F.lane;
    const float g_q0 = qg[2 * lane], g_q1 = qg[2 * lane + 1], g_k0 = kg[2 * lane], g_k1 = kg[2 * lane + 1];
    const int i0 = 2 * lane, w0 = i0 & 63;
    const bool axis1 = i0 >= 64, upper = w0 >= 32;
    const float inv0 = exp2f(-(float)(w0 & 31) * (13.287712379549449f / 32.0f)), inv1 = exp2f(-(float)((w0 + 1) & 31) * (13.287712379549449f / 32.0f));
    for (int row = F.gw; row < MALL; row += F.NGW) {
        bf16_t* ur = U + (size_t)row * 1536;
        const bool lat = row < NLAT;
        int b, t; if (lat) { b = row >> 12; t = row & (SEQ - 1); } else { b = (row - NLAT) >> 8; t = (row - NLAT) & (CTXL - 1); }
        float c0 = 1.f, s0 = 0.f, c1 = 1.f, s1 = 0.f;
        if (lat) { const float pos = axis1 ? (float)(t & 63) : (float)(t >> 6); sincosf(pos * inv0, &s0, &c0); sincosf(pos * inv1, &s1, &c1); }
        const size_t krow = (size_t)(b * (CTXL + SEQ) + (lat ? CTXL + t : t)) * 256;
#pragma unroll
        for (int h = 0; h < 10; ++h) {
            if (!lat && h < 8) continue;
            const unsigned w = *(const unsigned*)(ur + h * 128 + i0);
            float x0 = bf_lo(w), x1 = bf_hi(w);
            const float ss = wave_sum(x0 * x0 + x1 * x1);
            const float rstd = 1.0f / sqrtf(ss * (1.0f / 128.0f) + EPS);
            x0 = x0 * rstd * (h < 8 ? g_q0 : g_k0); x1 = x1 * rstd * (h < 8 ? g_q1 : g_k1);
            if (lat) { const float p0 = __shfl_xor(x0, 16), p1 = __shfl_xor(x1, 16);
                const float r0 = upper ? p0 : -p0, r1 = upper ? p1 : -p1;
                x0 = x0 * c0 + r0 * s0; x1 = x1 * c1 + r1 * s1; }
            const unsigned o = pk2(x0, x1);
            if (h < 8) *(unsigned*)(ur + h * 128 + i0) = o;
            else *(unsigned*)(Kb + krow + (h - 8) * 128 + i0) = o;
        }
#pragma unroll
        for (int h = 0; h < 2; ++h) *(unsigned*)(Vb + krow + h * 128 + i0) = *(const unsigned*)(ur + 1280 + h * 128 + i0);
    }
}
__device__ __forceinline__ void attn_phase(const Frame& F, const bf16_t* U, const bf16_t* Kb, const bf16_t* Vb, bf16_t* Z) {
    for (int i = 0; i < 1024; ++i) {
        int u;
        if (F.G == 256) { if (i >= 4) break; u = (blockIdx.x & 7) * 128 + i * 32 + (blockIdx.x >> 3); }
        else { u = blockIdx.x + i * F.G; if (u >= 1024) break; }
        const int pair = u >> 6, within = u & 63, g = within >> 4, qb = within & 15, b = pair >> 1, kvh = pair & 1, h = kvh * 4 + g;
        att::attn_dense_body(U + (size_t)(b * SEQ + qb * 256) * 1536 + h * 128, Kb + (size_t)b * (CTXL + SEQ) * 256 + kvh * 128, Vb + (size_t)b * (CTXL + SEQ) * 256 + kvh * 128,
                             Z + (size_t)(b * SEQ + qb * 256) * DM + h * 128, CTXL + SEQ, (char*)((unsigned char*)F.lds));
        __syncthreads();
    }
}


__device__ __forceinline__ void p0_hyena_tables(const Frame& F, const Args& a) {
    float* a2L = (float*)(a.ws + WS_A2); float* a2C = (float*)(a.ws + WS_A2C); f32x2* tw = (f32x2*)(a.ws + WS_TW);
    const float* w1 = a.in[I_HYFW1]; const float* b1 = a.in[I_HYFB1]; const float* w2 = a.in[I_HYFW2]; const float* b2 = a.in[I_HYFB2]; const float* fr = a.in[I_HYFREQ];
    const int j = F.lane; const float fj = fr[j];
    for (int item = F.gw; item < SEQ + CTXL; item += F.NGW) {
        const int L = item < SEQ ? SEQ : CTXL, lag = item < SEQ ? item : item - SEQ;
        const float t = (float)lag / (float)(L - 1);
        float acc = b1[j] + t * w1[j];
        const float base = (6.283185307179586f / (float)L) * (float)lag;
#pragma unroll 4
        for (int k = 0; k < 16; ++k) { const float band = 1e-4f + (float)k * ((15.0f - 1e-4f) / 15.0f); float s, c; sincosf(base * band, &s, &c);
            acc += c * w1[(1 + k) * 64 + j] - s * w1[(17 + k) * 64 + j]; }
        const float a1 = sinf(fj * acc);
        float acc2 = b2[j];
#pragma unroll 8
        for (int i = 0; i < 64; ++i) acc2 += __shfl(a1, i) * w2[i * 64 + j];
        const float a2 = sinf(fj * acc2);
        (item < SEQ ? a2L : a2C)[(size_t)lag * 64 + j] = a2;
    }
    for (int k = blockIdx.x * 512 + F.tid; k < 2048; k += F.G * 512) { float s, c; sincospif((float)k * (1.0f / 4096.0f), &s, &c); tw[k] = (f32x2){c, -s}; }
}

__device__ __forceinline__ void hy_dwconv_phase(const Frame& F, const bf16_t* U, const float* convw, bf16_t* XTL, bf16_t* XTC) {
    LAS unsigned* tile = (LAS unsigned*)(F.lds + F.wave * 8832);
    const int lane = F.lane, rr = lane >> 3, cq = lane & 7;
    for (int it = F.gw; it < (MALL / 64) * 48; it += F.NGW) {
        const int rb = it / 48, cb = it - rb * 48, r0 = rb * 64, ch0 = cb * 64;
        int b, pos0, slen; if (r0 < NLAT) { b = r0 >> 12; pos0 = r0 & (SEQ - 1); slen = SEQ; } else { const int rc = r0 - NLAT; b = rc >> 8; pos0 = rc & (CTXL - 1); slen = CTXL; }
#pragma unroll
        for (int grp = 0; grp < 9; ++grp) { const int ri = grp * 8 + rr;
            if (ri < 66) { const int p = pos0 - 1 + ri; u32x4 v = (u32x4){0u, 0u, 0u, 0u};
                if (p >= 0 && p < slen) v = *(const u32x4*)(U + (size_t)(r0 - 1 + ri) * 3072 + ch0 + cq * 8);
                LAS unsigned* tp = tile + ri * 33 + cq * 4; tp[0] = v.x; tp[1] = v.y; tp[2] = v.z; tp[3] = v.w; } }
        LDS_WAIT(); asm volatile("" ::: "memory");
        const int part = ch0 >> 10, c0 = ch0 & 1023;
        bf16_t* ob = (r0 < NLAT) ? XTL + ((size_t)((part * NB + b) * DM + c0) << 12) + pos0 + lane : XTC + ((size_t)((part * NB + b) * DM + c0) << 8) + pos0 + lane;
        const float* wp = convw + ch0;
#pragma unroll 4
        for (int cp = 0; cp < 32; ++cp) {
            const unsigned x0 = tile[lane * 33 + cp], x1 = tile[(lane + 1) * 33 + cp], x2 = tile[(lane + 2) * 33 + cp];
            const float oa = wp[2 * cp] * bf_lo(x0) + wp[3072 + 2 * cp] * bf_lo(x1) + wp[6144 + 2 * cp] * bf_lo(x2);
            const float ob2 = wp[2 * cp + 1] * bf_hi(x0) + wp[3072 + 2 * cp + 1] * bf_hi(x1) + wp[6144 + 2 * cp + 1] * bf_hi(x2);
            ob[(size_t)(2 * cp) * slen] = (bf16_t)f2bf(oa); ob[(size_t)(2 * cp + 1) * slen] = (bf16_t)f2bf(ob2); }
        LDS_WAIT(); asm volatile("" ::: "memory");
    }
}

__device__ __forceinline__ void hy_untranspose_phase(const Frame& F, const bf16_t* zTL, const bf16_t* zTC, bf16_t* Z) {
    LAS unsigned* tile = (LAS unsigned*)(F.lds + F.wave * 8448);
    const int lane = F.lane, hi8 = lane >> 3, lo8 = lane & 7;
    constexpr int NITL = NB * 16 * 64, NITC = NB * 16 * 4;
    for (int it = F.gw; it < NITL + NITC; it += F.NGW) {
        int b, cb, tb, slen; const bf16_t* src; int rowbase;
        if (it < NITL) { b = it >> 10; cb = (it >> 6) & 15; tb = it & 63; slen = SEQ; src = zTL; rowbase = b * SEQ; }
        else { const int i2 = it - NITL; b = i2 >> 6; cb = (i2 >> 2) & 15; tb = i2 & 3; slen = CTXL; src = zTC; rowbase = NLAT + b * CTXL; }
        const int c0 = cb * 64, t0 = tb * 64;
#pragma unroll
        for (int g = 0; g < 8; ++g) { const int c = g * 8 + hi8;
            const u32x4 v = *(const u32x4*)(src + (size_t)(b * DM + c0 + c) * slen + t0 + lo8 * 8);
            LAS unsigned* tp = tile + c * 33 + lo8 * 4; tp[0] = v.x; tp[1] = v.y; tp[2] = v.z; tp[3] = v.w; }
        LDS_WAIT(); asm volatile("" ::: "memory");
#pragma unroll
        for (int g = 0; g < 8; ++g) { const int t = g * 8 + hi8; unsigned e[8];
#pragma unroll
            for (int i = 0; i < 8; ++i) { const unsigned w = tile[(lo8 * 8 + i) * 33 + (t >> 1)]; e[i] = (t & 1) ? (w >> 16) : (w & 0xffffu); }
            u32x4 o; o.x = e[0] | (e[1] << 16); o.y = e[2] | (e[3] << 16); o.z = e[4] | (e[5] << 16); o.w = e[6] | (e[7] << 16);
            *(u32x4*)(Z + (size_t)(rowbase + t0 + t) * DM + c0 + lo8 * 8) = o; }
        LDS_WAIT(); asm volatile("" ::: "memory");
    }
}

constexpr int FFT_N = 8192;
__device__ __forceinline__ int PX(int i) { return i + (i >> 5); }
__device__ __forceinline__ f32x2 twv(const LAS f32x2* TW, int k) { const f32x2 t = TW[k & 2047]; return (k & 2048) ? (f32x2){t.y, -t.x} : t; }
__device__ __forceinline__ f32x2 cmul(f32x2 a, f32x2 b) { return (f32x2){a.x * b.x - a.y * b.y, a.x * b.y + a.y * b.x}; }
__device__ __forceinline__ f32x2 cmulc(f32x2 a, f32x2 w) { return (f32x2){a.x * w.x + a.y * w.y, a.y * w.x - a.x * w.y}; }
template <int K, bool INV>
__device__ __forceinline__ void fft_pass(LAS f32x2* X, const LAS f32x2* TW, int ls, int tid) {
    constexpr int R = 1 << K;
    const int lst = ls - (K - 1), st = 1 << lst;
    for (int gi = tid; gi < FFT_N / R; gi += 512) {
        const int pos = gi & (st - 1), g = gi >> lst, ibase = (g << (ls + 1)) + pos;
        f32x2 v[R];
#pragma unroll
        for (int e = 0; e < R; ++e) v[e] = X[PX(ibase + (e << lst))];
        if (!INV) {
#pragma unroll
            for (int m = 0; m < K; ++m) { const int h = 1 << (K - 1 - m), lsm = ls - m;
#pragma unroll
                for (int e = 0; e < R; ++e) if (!(e & h)) { const int pm = ((e & (h - 1)) << lst) + pos; const f32x2 w = twv(TW, pm << (12 - lsm));
                    const f32x2 x = v[e], y = v[e + h]; v[e] = x + y; v[e + h] = cmul(x - y, w); } }
        } else {
#pragma unroll
            for (int m = K - 1; m >= 0; --m) { const int h = 1 << (K - 1 - m), lsm = ls - m;
#pragma unroll
                for (int e = 0; e < R; ++e) if (!(e & h)) { const int pm = ((e & (h - 1)) << lst) + pos; const f32x2 w = twv(TW, pm << (12 - lsm));
                    const f32x2 x = v[e], y = cmulc(v[e + h], w); v[e] = x + y; v[e + h] = x - y; } }
        }
#pragma unroll
        for (int e = 0; e < R; ++e) X[PX(ibase + (e << lst))] = v[e];
    }
    __syncthreads();
}
__device__ __forceinline__ void fft_fwd(LAS f32x2* X, const LAS f32x2* TW, int tid) {
    fft_pass<4, false>(X, TW, 12, tid); fft_pass<4, false>(X, TW, 8, tid); fft_pass<4, false>(X, TW, 4, tid); fft_pass<1, false>(X, TW, 0, tid);
}
__device__ __forceinline__ void fft_inv(LAS f32x2* X, const LAS f32x2* TW, int tid) {
    fft_pass<1, true>(X, TW, 0, tid); fft_pass<4, true>(X, TW, 4, tid); fft_pass<4, true>(X, TW, 8, tid); fft_pass<4, true>(X, TW, 12, tid);
}
__device__ __forceinline__ float block_sum(float v, LAS float* scr, int lane, int wave) {
    v = wave_sum(v); __syncthreads(); if (lane == 0) scr[wave] = v; __syncthreads();
    float t = 0.f;
#pragma unroll
    for (int w = 0; w < 8; ++w) t += scr[w];
    return t;
}
constexpr float HY_DLO = -3.0701134573253944f, HY_DHI = -15.350567286626972f;
__device__ __forceinline__ void hy_longconv_phase(const Frame& F, const Args& a, const bf16_t* XTL, bf16_t* z1T, bf16_t* z2T, const bf16_t* XTC, bf16_t* z2Tc) {
    LAS f32x2* W = (LAS f32x2*)F.lds;
    LAS f32x2* HF = (LAS f32x2*)(F.lds + 67584);
    LAS f32x2* TW = (LAS f32x2*)(F.lds + 135168);
    LAS float* wfb = (LAS float*)(F.lds + 151552);
    LAS float* scr = wfb + 128;
    const int tid = F.tid, lane = F.lane, wave = F.wave;
    const f32x2* twg = (const f32x2*)(a.ws + WS_TW);
    for (int k = tid; k < 2048; k += 512) TW[k] = twg[k];
    const float* a2L = (const float*)(a.ws + WS_A2); const float* a2C = (const float*)(a.ws + WS_A2C);
    const float* w3 = a.in[I_HYFW3]; const float* skip = a.in[I_HYSKIP];
    __syncthreads();
    for (int c = blockIdx.x; c < DM; c += F.G) {
        const float delta = fabsf(HY_DLO + (float)c * ((HY_DHI - HY_DLO) / 1023.0f));
        for (int o = 0; o < 2; ++o) {
            __syncthreads();
            if (tid < 128) { const int i = tid & 63, dir = tid >> 6; wfb[tid] = w3[(size_t)i * 4096 + (dir * 2 + o) * DM + c]; }
            __syncthreads();
            float lsum = 0.f;
#pragma unroll 1
            for (int i8 = 0; i8 < 8; ++i8) { const int q = tid + 512 * i8; const f32x4* ar = (const f32x4*)(a2L + (size_t)q * 64); float hf = 0.f, hb = 0.f;
#pragma unroll
                for (int i4 = 0; i4 < 16; ++i4) { const f32x4 av = ar[i4];
                    hf += (av.x * wfb[4 * i4] + av.y * wfb[4 * i4 + 1]) + (av.z * wfb[4 * i4 + 2] + av.w * wfb[4 * i4 + 3]);
                    hb += (av.x * wfb[64 + 4 * i4] + av.y * wfb[64 + 4 * i4 + 1]) + (av.z * wfb[64 + 4 * i4 + 2] + av.w * wfb[64 + 4 * i4 + 3]); }
                const float dec = __expf(-((float)q * (1.0f / 4095.0f)) * delta); hf *= dec; hb *= dec;
                W[PX(q)] = (f32x2){hf, 0.f}; lsum += fabsf(hf);
                if (q > 0) { W[PX(FFT_N - q)] = (f32x2){hb, 0.f}; lsum += fabsf(hb); } }
            if (tid == 0) W[PX(4096)] = (f32x2){0.f, 0.f};
            const float ssum = block_sum(lsum, scr, lane, wave);
            fft_fwd(W, TW, tid);
            const float scale = 1.0f / (ssum * (float)FFT_N);
#pragma unroll 2
            for (int i = 0; i < 16; ++i) { const int p = PX(tid + 512 * i); HF[p] = W[p] * scale; }
            __syncthreads();
            const bf16_t* usrc = o == 0 ? XTL : z1T; const bf16_t* gsrc = XTL + ((size_t)(1 + o) * NB * DM << 12); bf16_t* dst = o == 0 ? z1T : z2T;
            const float sk = skip[o * DM + c];
            for (int bp = 0; bp < 4; ++bp) {
                const size_t o0 = (size_t)((2 * bp) * DM + c) << 12, o1 = (size_t)((2 * bp + 1) * DM + c) << 12;
                float ur[8], ui[8];
#pragma unroll
                for (int i8 = 0; i8 < 8; ++i8) { const int t = tid + 512 * i8; ur[i8] = bf1(usrc[o0 + t]); ui[i8] = bf1(usrc[o1 + t]);
                    W[PX(t)] = (f32x2){ur[i8], ui[i8]}; W[PX(t + 4096)] = (f32x2){0.f, 0.f}; }
                __syncthreads();
                fft_fwd(W, TW, tid);
#pragma unroll 2
                for (int i = 0; i < 16; ++i) { const int p = PX(tid + 512 * i); W[p] = cmul(W[p], HF[p]); }
                __syncthreads();
                fft_inv(W, TW, tid);
#pragma unroll
                for (int i8 = 0; i8 < 8; ++i8) { const int t = tid + 512 * i8; const f32x2 y = W[PX(t)];
                    const float r0 = bf1(gsrc[o0 + t]) * (y.x + ur[i8] * sk), r1 = bf1(gsrc[o1 + t]) * (y.y + ui[i8] * sk);
                    dst[o0 + t] = (bf16_t)f2bf(r0); dst[o1 + t] = (bf16_t)f2bf(r1); }
                __syncthreads();
            }
        }
    }
    LAS float* uc = (LAS float*)F.lds;
    LAS float* hfull = uc + 2048;
    LAS float* un = hfull + 512;
    for (int c = blockIdx.x; c < DM; c += F.G) {
        const float delta = fabsf(HY_DLO + (float)c * ((HY_DHI - HY_DLO) / 1023.0f));
        __syncthreads();
        for (int idx = tid; idx < 2048; idx += 512) uc[idx] = bf1(XTC[(size_t)((idx >> 8) * DM + c) * CTXL + (idx & 255)]);
        for (int o = 0; o < 2; ++o) {
            __syncthreads();
            if (tid < 128) { const int i = tid & 63, dir = tid >> 6; wfb[tid] = w3[(size_t)i * 4096 + (dir * 2 + o) * DM + c]; }
            __syncthreads();
            float lsum = 0.f;
            if (tid < 256) { const int q = tid; const float* ar = a2C + (size_t)q * 64; float hf = 0.f, hb = 0.f;
                for (int i = 0; i < 64; ++i) { const float av = ar[i]; hf += av * wfb[i]; hb += av * wfb[64 + i]; }
                const float dec = __expf(-((float)q * (1.0f / 255.0f)) * delta); hf *= dec; hb *= dec;
                hfull[255 + q] = hf; lsum += fabsf(hf);
                if (q > 0) { hfull[255 - q] = hb; lsum += fabsf(hb); } }
            const float ssum = block_sum(lsum, scr, lane, wave);
            const float rs = 1.0f / ssum, sk = skip[o * DM + c];
            const int t = tid & 255;
            for (int bb = 0; bb < 4; ++bb) { const int b = (tid >> 8) + 2 * bb; float y = 0.f;
                for (int s = 0; s < 256; ++s) y += hfull[255 + t - s] * uc[b * 256 + s];
                const float gt = bf1(XTC[(size_t)(((1 + o) * NB + b) * DM + c) * CTXL + t]);
                const float r = gt * (y * rs + uc[b * 256 + t] * sk);
                if (o == 0) un[b * 256 + t] = bf1((bf16_t)f2bf(r)); else z2Tc[(size_t)(b * DM + c) * CTXL + t] = (bf16_t)f2bf(r); }
            __syncthreads();
            if (o == 0) { for (int idx = tid; idx < 2048; idx += 512) uc[idx] = un[idx]; }
        }
    }
}

__device__ __forceinline__ void copy_rows(const Frame& F, const float* src, float* dst, size_t n4) {
    for (size_t i = (size_t)blockIdx.x * 512 + F.tid; i < n4; i += (size_t)F.G * 512) ((f32x4*)dst)[i] = ((const f32x4*)src)[i];
}

constexpr int PH_P0 = 0, PH_N0 = 1, PH_L0 = 2, PH_PER = 12, PH_END = PH_L0 + DEPTH * PH_PER;
#ifndef DBG_LAST
#define DBG_LAST 100
#endif

template <int layer>
__device__ __forceinline__ void run_layer(const Frame& F, const Args& a, const XcdBarrier& bar, const int lo, const int hi) {
    float* modv = (float*)(a.ws + WS_MODV);
    float* LAT = (float*)(a.ws + WS_LAT);
    bf16_t* HL = (bf16_t*)(a.ws + WS_HL);
    bf16_t* U = (bf16_t*)(a.ws + WS_U);
    bf16_t* Z = (bf16_t*)(a.ws + WS_Z);
    bf16_t* wm = (bf16_t*)(a.ws + WS_WMIX);
    bf16_t* HB = (bf16_t*)(a.ws + WS_H);
    bf16_t* YS = (bf16_t*)(a.ws + WS_YS);
    bf16_t* XTL = (bf16_t*)(a.ws + WS_H); bf16_t* XTC = (bf16_t*)(a.ws + WS_H + 192 * MiB);
    bf16_t* Z1T = (bf16_t*)(a.ws + WS_U); bf16_t* Z2T = (bf16_t*)(a.ws + WS_U + 68 * MiB); bf16_t* Z2TC = (bf16_t*)(a.ws + WS_U + 136 * MiB);
    bf16_t* KB = (bf16_t*)(a.ws + WS_H); bf16_t* VB = (bf16_t*)(a.ws + WS_H + 17 * MiB);
    float* affL = (float*)(a.ws + WS_AFF); float* affC = (float*)(a.ws + WS_AFFC);
    int* rowlist = (int*)(a.ws + WS_ROWL); float* gl = (float*)(a.ws + WS_GL); int* slotmap = (int*)(a.ws + WS_SLOT);
#define IN(k) (lo <= (k) && (k) < hi)
#define SEAM(k) do { if ((k) + 1 < hi) xcd_barrier(bar); } while (0)
        constexpr int pb = PH_L0 + layer * PH_PER;
        if (pb >= hi) return;
        constexpr int kind = layer % 3, jj = layer / 3;
        constexpr bool need_ctx = layer <= 2, upd_ctx = layer < 2;
        constexpr int m_in = need_ctx ? MALL : NLAT, m_out = upd_ctx ? MALL : NLAT;
        const float* modl = modv + (size_t)layer * 9 * MODW;
        const float* baseL = layer == 0 ? a.in[I_X] : LAT;
        const float* baseC = layer == 0 ? a.in[I_CTX] : LAT + (size_t)NLAT * DM;
        const bf16_t* w_in = kind == 0 ? wm + WM_SC_IN + (size_t)jj * 3072 * 1024 : (kind == 1 ? wm + WM_HY_IN : wm + WM_AT_QKV);
        const bf16_t* w_out = kind == 0 ? wm + WM_SC_OUT + (size_t)jj * 1024 * 1024 : (kind == 1 ? wm + WM_HY_OUT : wm + WM_AT_O);
        constexpr int n_in = kind == 2 ? 1536 : 3072;
        if (IN(pb + 0)) {
            pg8::Gemm g{HL, w_in, m_in, n_in, DM, 1 << 20, nullptr}; pg8::StaticOrder S; S.init(m_in, n_in, F.G, (int)blockIdx.x);
            pg8::EpiBf16 E{U, n_in};
            pg8::gemm_phase<pg8::EpiBf16, pg8::StaticOrder, false>(F.lds, g, S, E);
            SEAM(pb + 0);
        }
        if (IN(pb + 1)) {
            if constexpr (kind == 0) sc_conv_phase(F, U, a.in[I_SCCONV] + (size_t)jj * 3 * DM, Z, m_out);
            if constexpr (kind == 2) attn_prep_phase(F, U, a.in[I_ATQG], a.in[I_ATKG], KB, VB);
            if constexpr (kind == 1) hy_dwconv_phase(F, U, a.in[I_HYCONV], XTL, XTC);
            SEAM(pb + 1);
        }
        if constexpr (kind != 0) if (IN(pb + 2)) {
            if constexpr (kind == 2) attn_phase(F, U, KB, VB, Z);
            if constexpr (kind == 1) hy_longconv_phase(F, a, XTL, Z1T, Z2T, XTC, Z2TC);
            SEAM(pb + 2);
        }
        if constexpr (kind == 1) if (IN(pb + 3)) { hy_untranspose_phase(F, Z2T, Z2TC, Z); SEAM(pb + 3); }
        if (IN(pb + 4)) {
            pg8::Gemm g{Z, w_out, m_out, DM, DM, 1 << 20, nullptr}; pg8::StaticOrder S; S.init(m_out, DM, F.G, (int)blockIdx.x);
            pg8::EpiRes E{baseL, baseC, LAT, modl + 2 * DM};
            pg8::gemm_phase<pg8::EpiRes, pg8::StaticOrder, false>(F.lds, g, S, E);
            SEAM(pb + 4);
        }
        if (IN(pb + 5)) {
            norm2_router_phase(F, LAT, m_out, a.in[I_NORMG] + (size_t)(layer * 2 + 1) * DM, modl, HL, a.in[I_ROUTER] + (size_t)layer * DM * NE, affL, affC);
            SEAM(pb + 5);
        }
        if (IN(pb + 6)) { topk_convert_phase(F, a, layer, upd_ctx, affL, affC, rowlist, gl, slotmap); SEAM(pb + 6); }
        constexpr int RE = upd_ctx ? (REL + REC) : REL;
        if (IN(pb + 7)) {
            pg8::Gemm g{HL, (const bf16_t*)(a.ws + WS_WMOE), NE * RE, 2048, DM, RE / 256, rowlist}; pg8::StaticOrder S; S.init(NE * RE, 2048, F.G, (int)blockIdx.x);
            pg8::EpiMoeUp E{HB};
            pg8::gemm_phase<pg8::EpiMoeUp, pg8::StaticOrder, true>(F.lds, g, S, E);
            SEAM(pb + 7);
        }
        if (IN(pb + 8)) {
            pg8::Gemm g{HB, (const bf16_t*)(a.ws + WS_WMOE_DN), NE * RE, DM, DM, RE / 256, nullptr}; pg8::StaticOrder S; S.init(NE * RE, DM, F.G, (int)blockIdx.x);
            pg8::EpiMoeDown E{YS, gl};
            pg8::gemm_phase<pg8::EpiMoeDown, pg8::StaticOrder, false>(F.lds, g, S, E);
            SEAM(pb + 8);
        }
        if (IN(pb + 9)) {
            const bool fin = layer == DEPTH - 1;
            combine_phase(F, LAT, m_out, YS, slotmap, modl, fin, a.out, a.in[I_NORMG] + (size_t)((layer + 1) * 2) * DM, modv + (size_t)(layer + 1) * 9 * MODW, HL);
            SEAM(pb + 9);
        }
    #undef IN
#undef SEAM
}

__global__ void __launch_bounds__(512, 2) fwd_kernel(Args a) {
    extern __shared__ __attribute__((aligned(16))) unsigned char lds_raw[];
    Frame F;
    F.lds = (LAS unsigned char*)lds_raw;
    F.tid = threadIdx.x; F.lane = F.tid & 63; F.wave = __builtin_amdgcn_readfirstlane(F.tid >> 6);
    F.G = gridDim.x; F.gw = blockIdx.x * 8 + F.wave; F.NGW = F.G * 8;
    volatile LAS unsigned* MISC = (volatile LAS unsigned*)(F.lds + LDS_MISC);
    for (int u = F.tid; u < (LDS_BYTES - LDS_MISC) / 4; u += 512) MISC[u] = 0u;
    __syncthreads();
    unsigned* ctl = (unsigned*)(a.ws + WS_CTL);
    const int lo = a.ph_lo, hi = a.ph_hi;
    const bool multi = (hi - lo) > 1;
    XcdBarrier bar; bar.bar = ctl + CW_BAR; bar.x = 0; bar.st = nullptr;
    if (multi) bar = xcd_barrier_post(ctl + CW_BAR, MISC + 8);
#define IN(k) (lo <= (k) && (k) < hi)
#define SEAM(k) do { if ((k) + 1 < hi) xcd_barrier(bar); } while (0)

    float* modv = (float*)(a.ws + WS_MODV);
    float* LAT = (float*)(a.ws + WS_LAT);
    bf16_t* HL = (bf16_t*)(a.ws + WS_HL);
    bf16_t* U = (bf16_t*)(a.ws + WS_U);
    bf16_t* Z = (bf16_t*)(a.ws + WS_Z);
    bf16_t* wm = (bf16_t*)(a.ws + WS_WMIX);
    bf16_t* HB = (bf16_t*)(a.ws + WS_H);
    bf16_t* YS = (bf16_t*)(a.ws + WS_YS);
    bf16_t* XTL = (bf16_t*)(a.ws + WS_H); bf16_t* XTC = (bf16_t*)(a.ws + WS_H + 192 * MiB);
    bf16_t* Z1T = (bf16_t*)(a.ws + WS_U); bf16_t* Z2T = (bf16_t*)(a.ws + WS_U + 68 * MiB); bf16_t* Z2TC = (bf16_t*)(a.ws + WS_U + 136 * MiB);
    bf16_t* KB = (bf16_t*)(a.ws + WS_H); bf16_t* VB = (bf16_t*)(a.ws + WS_H + 17 * MiB);
    float* affL = (float*)(a.ws + WS_AFF); float* affC = (float*)(a.ws + WS_AFFC);
    int* rowlist = (int*)(a.ws + WS_ROWL); float* gl = (float*)(a.ws + WS_GL); int* slotmap = (int*)(a.ws + WS_SLOT);

    if (IN(PH_P0)) { p0_mod(F, a); __syncthreads(); p0_convert_mixers(F, a); p0_hyena_tables(F, a); SEAM(PH_P0); }
    if (IN(PH_N0)) { norm1_phase(F, a.in[I_X], a.in[I_CTX], MALL, a.in[I_NORMG], modv, HL); SEAM(PH_N0); }

    if (DBG_LAST >= PH_L0 + 0 * PH_PER) run_layer<0>(F, a, bar, lo, hi);
    if (DBG_LAST >= PH_L0 + 1 * PH_PER) run_layer<1>(F, a, bar, lo, hi);
    if (DBG_LAST >= PH_L0 + 2 * PH_PER) run_layer<2>(F, a, bar, lo, hi);
    if (DBG_LAST >= PH_L0 + 3 * PH_PER) run_layer<3>(F, a, bar, lo, hi);
    if (IN(PH_END) && DBG_LAST < PH_END - 1) { copy_rows(F, LAT, a.out, (size_t)NLAT * DM / 4); }
#undef IN
#undef SEAM
}

#ifndef ONE_LAUNCH
#define ONE_LAUNCH 1
#endif
extern "C" void kernel_launch(void* const* d_in, const int* in_sizes, int n_in, void* d_out, int out_size, void* d_ws, size_t ws_size, hipStream_t stream) {
    static int grid = 0;
    if (grid == 0) {
        if (n_in != 28 || out_size != NLAT * DM || ws_size < WS_END) { fprintf(stderr, "kernel_launch: unexpected shapes n_in %d out %d ws %zu (need %zu)\n", n_in, out_size, ws_size, (size_t)WS_END); grid = -1; return; }
        int dev = 0, cus = 0, per_cu = 0;
        if (hipGetDevice(&dev) != hipSuccess || hipDeviceGetAttribute(&cus, hipDeviceAttributeMultiprocessorCount, dev) != hipSuccess) { grid = -1; return; }
        if (hipFuncSetAttribute((const void*)fwd_kernel, hipFuncAttributeMaxDynamicSharedMemorySize, LDS_BYTES) != hipSuccess) { fprintf(stderr, "kernel_launch: hipFuncSetAttribute failed\n"); grid = -1; return; }
        if (hipOccupancyMaxActiveBlocksPerMultiprocessor(&per_cu, (const void*)fwd_kernel, 512, LDS_BYTES) != hipSuccess || per_cu < 1) fprintf(stderr, "kernel_launch: occupancy query says %d\n", per_cu);
        (void)hipGetLastError();
        grid = cus;
    }
    if (grid < 0) return;
    hipMemsetAsync((char*)d_ws + WS_CTL, 0, CTL_ZERO_BYTES, stream);
    Args a{};
    for (int i = 0; i < 28; ++i) a.in[i] = (const float*)d_in[i];
    a.out = (float*)d_out; a.ws = (unsigned char*)d_ws;
    if (ONE_LAUNCH) { a.ph_lo = 0; a.ph_hi = PH_END + 1; hipLaunchKernelGGL(fwd_kernel, dim3(grid), dim3(512), LDS_BYTES, stream, a); }
    else {
        for (int ph = 0; ph <= PH_END; ++ph) {
            bool exists = (ph == PH_P0 || ph == PH_N0 || ph == PH_END);
            if (ph >= PH_L0 && ph < PH_END) { const int layer = (ph - PH_L0) / PH_PER, k = (ph - PH_L0) % PH_PER, kind = layer % 3;
                exists = (k == 0 || k == 1 || k == 4 || (k >= 5 && k <= 9) || (k == 2 && kind != 0) || (k == 3 && kind == 1));
                if (ph > DBG_LAST) exists = false; }
            if (!exists) continue;
            a.ph_lo = ph; a.ph_hi = ph + 1;
            hipLaunchKernelGGL(fwd_kernel, dim3(grid), dim3(512), LDS_BYTES, stream, a);
        }
    }
}
```

```cpp
#include <hip/hip_runtime.h>
#include <cstdio>
#include <cstdint>

#define GAS __attribute__((address_space(1)))
#define LAS __attribute__((address_space(3)))
typedef unsigned short bf16_t;
typedef short bf16x8 __attribute__((ext_vector_type(8)));
typedef float f32x4 __attribute__((ext_vector_type(4)));
typedef float f32x2 __attribute__((ext_vector_type(2)));
typedef unsigned u32x4 __attribute__((ext_vector_type(4)));
typedef unsigned u32x2 __attribute__((ext_vector_type(2)));

constexpr int DM = 1024, NB = 8, SEQ = 4096, CTXL = 256, DEPTH = 4;
constexpr int NLAT = NB * SEQ, NCTX = NB * CTXL, MALL = NLAT + NCTX;
constexpr int NE = 16, CAPL = 512, CAPC = 32, REL = NB * CAPL, REC = NB * CAPC;
constexpr int MODW = 6 * DM;
constexpr float EPS = 1e-6f;

constexpr size_t MiB = 1u << 20;
constexpr size_t WS_CTL = 0, CTL_ZERO_BYTES = 1 * MiB;
constexpr size_t WS_MODV = 1 * MiB;
constexpr size_t WS_A2 = 2 * MiB;
constexpr size_t WS_A2C = WS_A2 + 4096 * 64 * 4;
constexpr size_t WS_TW = WS_A2C + 256 * 64 * 4;
constexpr size_t WS_AFF = 4 * MiB;
constexpr size_t WS_AFFC = WS_AFF + 2 * MiB;
constexpr size_t WS_ROWL = 7 * MiB;
constexpr size_t WS_GL = WS_ROWL + 512 * 1024;
constexpr size_t WS_SLOT = 8 * MiB;
constexpr size_t WS_WMIX = 11 * MiB;
constexpr size_t WS_WMOE = 43 * MiB;
constexpr size_t WS_WMOE_DN = WS_WMOE + 64 * MiB;
constexpr size_t WS_LAT = 139 * MiB;
constexpr size_t WS_HL = 275 * MiB;
constexpr size_t WS_U = 343 * MiB;
constexpr size_t WS_Z = 547 * MiB;
constexpr size_t WS_H = 615 * MiB;
constexpr size_t WS_YS = 751 * MiB;
constexpr size_t WS_HT = 887 * MiB;
constexpr size_t WS_HTC = 951 * MiB;
constexpr size_t WS_END = 955 * MiB;
constexpr size_t WM_SC_IN = 0;
constexpr size_t WM_SC_OUT = WM_SC_IN + 2ull * 3072 * 1024;
constexpr size_t WM_HY_IN = WM_SC_OUT + 2ull * 1024 * 1024;
constexpr size_t WM_HY_OUT = WM_HY_IN + 3072ull * 1024;
constexpr size_t WM_AT_QKV = WM_HY_OUT + 1024ull * 1024;
constexpr size_t WM_AT_O = WM_AT_QKV + 1536ull * 1024;
static_assert((WM_AT_O + 1024ull * 1024) * 2 <= 32 * MiB, "mixer weights");
constexpr int CW_BAR = 4096;
constexpr int CW_WQ = 16384;

constexpr int LDS_MAIN = 155648;
constexpr int LDS_MISC = LDS_MAIN;
constexpr int LDS_BYTES = LDS_MAIN + 4096;

#ifndef PROBE_MASK
#define PROBE_MASK 0u
#endif
#ifndef PROBE_K
#define PROBE_K 1
#endif
#ifndef PROBE_SEAMMASK
#define PROBE_SEAMMASK 0u
#endif
#define PB(type) const int _ptype = (type); (void)_ptype; unsigned long long _pt0 = 0; if ((PROBE_MASK >> (type)) & 1u) _pt0 = wall_clock64();
#define PE(type) if ((PROBE_MASK >> (type)) & 1u) { if (threadIdx.x == 0) { volatile LAS unsigned long long* _pa = (volatile LAS unsigned long long*)(F.lds + LDS_MISC + 128); *_pa = *_pa + (wall_clock64() - _pt0); } }
enum { PT_SUB_FILT = 16, PT_SUB_CTX = 17, PT_SUB_TOPKU = 18, PT_SUB_GATHER = 19 };
enum { PT_P0 = 0, PT_N1, PT_INGEMM, PT_SCCONV, PT_ATPREP, PT_ATTN, PT_HYDW, PT_HYLC, PT_HYUT, PT_OUTGEMM, PT_NORM2, PT_TOPK, PT_MOEUP, PT_MOEDN, PT_COMB };
#define LDS_WAIT() asm volatile("s_waitcnt lgkmcnt(0)" ::: "memory")
#define VM_WAIT() asm volatile("s_waitcnt vmcnt(0)" ::: "memory")

__device__ __forceinline__ unsigned f2bf(float f) { unsigned u = __builtin_bit_cast(unsigned, f); return (u + 0x7fffu + ((u >> 16) & 1u)) >> 16; }
__device__ __forceinline__ unsigned pk2(float lo, float hi) { return f2bf(lo) | (f2bf(hi) << 16); }
__device__ __forceinline__ float bf_lo(unsigned w) { return __uint_as_float(w << 16); }
__device__ __forceinline__ float bf_hi(unsigned w) { return __uint_as_float(w & 0xffff0000u); }
__device__ __forceinline__ float bf1(bf16_t b) { return __uint_as_float(((unsigned)b) << 16); }
__device__ __forceinline__ float wave_sum(float v) {
#pragma unroll
    for (int o = 1; o < 64; o <<= 1) v += __shfl_xor(v, o);
    return v;
}
__device__ __forceinline__ int wave_sum_i(int v) {
#pragma unroll
    for (int o = 1; o < 64; o <<= 1) v += __shfl_xor(v, o);
    return v;
}

#define XB_TMO      128
#define XB_XCNT(j)  (256  + 64 * (j))
#define XB_XSUB(j)  (1280 + 64 * (j))
#define XB_XGEN(j)  (2304 + 64 * (j))
#define XB_TOP      3328
#define XB_TOPGEN   3392
#define XCD_BAR_WORDS 3456
#define XB_SPIN_CAP (1u << 22)

__device__ __forceinline__ unsigned xb_ld(unsigned* p)              { return __hip_atomic_load(p, __ATOMIC_RELAXED, __HIP_MEMORY_SCOPE_AGENT); }
__device__ __forceinline__ unsigned xb_add(unsigned* p, unsigned v) { return __hip_atomic_fetch_add(p, v, __ATOMIC_RELAXED, __HIP_MEMORY_SCOPE_AGENT); }
__device__ __forceinline__ unsigned xb_xcc_id() { return (unsigned)__builtin_amdgcn_s_getreg((3 << 11) | 20) & 0xFu; }
#define XB_SPIN(cond, bar) do { unsigned _sp = 0; while (cond) { __builtin_amdgcn_s_sleep(1); \
    if ((++_sp & 255u) == 0u) { if (xb_ld(&(bar)[XB_TMO])) break; if (_sp > XB_SPIN_CAP) { atomicAdd(&(bar)[XB_TMO], 1u); break; } } } } while (0)

struct XcdBarrier { unsigned* bar; unsigned x; volatile LAS unsigned* st; };

__device__ __forceinline__ XcdBarrier xcd_barrier_post(unsigned* bar, volatile LAS unsigned* st) {
    XcdBarrier b; b.bar = bar; b.x = xb_xcc_id(); b.st = st;
    if (threadIdx.x == 0) (void)xb_add(&bar[XB_XCNT(b.x)], 1u);
    return b;
}
__device__ __forceinline__ void xcd_barrier_complete(unsigned* bar, unsigned x, unsigned& nloc, unsigned& nx) {
    const unsigned G = gridDim.x * gridDim.y * gridDim.z;
    unsigned sum, cnt, mine, sp = 0u;
    for (;;) {
        sum = 0u; cnt = 0u; mine = 0u;
#pragma unroll
        for (unsigned j = 0; j < 16; ++j) { const unsigned c = xb_ld(&bar[XB_XCNT(j)]); sum += c; cnt += (c > 0u) ? 1u : 0u; mine = (j == x) ? c : mine; }
        if (sum == G) break;
        __builtin_amdgcn_s_sleep(1);
        if ((++sp & 255u) == 0u) { if (xb_ld(&bar[XB_TMO])) break; if (sp > XB_SPIN_CAP) { atomicAdd(&bar[XB_TMO], 1u); break; } }
    }
    nloc = mine > 0u ? mine : 1u; nx = cnt > 0u ? cnt : 1u;
}
__device__ __forceinline__ void xcd_barrier(const XcdBarrier& b) {
    asm volatile("s_waitcnt vmcnt(0)" ::: "memory");
    __syncthreads();
    if (threadIdx.x == 0) {
        unsigned* bar = b.bar;
        __builtin_amdgcn_s_waitcnt(0);
        unsigned nloc = b.st[0], nx = b.st[1];
        if (nloc == 0u) { xcd_barrier_complete(bar, b.x, nloc, nx); b.st[0] = nloc; b.st[1] = nx; }
        const unsigned old = xb_add(&bar[XB_XSUB(b.x)], 1u);
        const unsigned gen = old / nloc;
        if (old + 1u == (gen + 1u) * nloc) {
            __builtin_amdgcn_fence(__ATOMIC_RELEASE, "agent");
            asm volatile("s_waitcnt vmcnt(0)" ::: "memory");
            const unsigned og = xb_add(&bar[XB_TOP], 1u);
            const unsigned tg = og / nx;
            if (og + 1u == (tg + 1u) * nx) xb_add(&bar[XB_TOPGEN], 1u);
            else XB_SPIN(xb_ld(&bar[XB_TOPGEN]) == tg, bar);
            __builtin_amdgcn_fence(__ATOMIC_ACQUIRE, "agent");
            xb_add(&bar[XB_XGEN(b.x)], 1u);
            asm volatile("s_waitcnt vmcnt(0)" ::: "memory");
        } else {
            XB_SPIN(xb_ld(&bar[XB_XGEN(b.x)]) == gen, bar);
            __builtin_amdgcn_fence(__ATOMIC_ACQUIRE, "agent");
            asm volatile("s_waitcnt vmcnt(0)" ::: "memory");
        }
    }
    __syncthreads();
}

namespace pg8 {
constexpr int BM = 256, BK = 64, HALF = 128, HTB = HALF * BK * 2, STAGE_BYTES = 8 * HTB, NXCD = 8, WGM = 8;
__host__ __device__ __forceinline__ int lds_byte(int r, int c) { const int st = (r >> 4) * 2 + (c >> 5), rr = r & 15, cc = c & 31, ob = rr * 64 + cc * 2; return st * 1024 + (ob ^ (((ob >> 9) & 1) << 5)); }
__host__ __device__ __forceinline__ void stage_rc(int b, int& R, int& C) { const int st = b / 1024, sb = b % 1024, swz = sb ^ (((sb >> 9) & 1) << 5); R = (st >> 1) * 16 + swz / 64; C = (st & 1) * 32 + (swz % 64) / 2; }
__host__ __device__ __forceinline__ int perm32(int rho) { const int n = rho >> 4, i = rho & 15; return 8 * (i >> 2) + 4 * n + (i & 3); }

struct Unit { int pm, pn; };
struct Gemm { const void* A; const void* Bt; int M, N, K; int tpg; const int* rowlist; };

struct StaticOrder {
    int nM, nN, nwg, G, c;
    __device__ void init(int M, int N, int G_, int c_) { nM = M / BM; nN = N / BM; nwg = nM * nN; G = G_; c = c_; }
    __device__ bool next(int i, Unit& u) const {
        const long L = (long)i * G + c; if (L >= nwg) return false;
        int wgid = (int)L; { const int q = nwg / NXCD, r = nwg % NXCD, xcd = wgid % NXCD, off = wgid / NXCD; wgid = (xcd < r ? xcd * (q + 1) : r * (q + 1) + (xcd - r) * q) + off; }
        const int nig = WGM * nN, gid = wgid / nig, fm = gid * WGM, gsz = (nM - fm) < WGM ? (nM - fm) : WGM;
        u.pm = fm + ((wgid % nig) % gsz); u.pn = (wgid % nig) / gsz; return true;
    }
};

__device__ __forceinline__ unsigned cvt_pk_bf16(float lo, float hi) { unsigned r; asm volatile("v_cvt_pk_bf16_f32 %0, %1, %2" : "=v"(r) : "v"(lo), "v"(hi)); return r; }

typedef int i32x8 __attribute__((ext_vector_type(8)));
typedef int i32x4 __attribute__((ext_vector_type(4)));
template <class Epi, class Sched, bool GATHER, int ESZ = 2>
__device__ __forceinline__ void gemm_phase(LAS unsigned char* lds, const Gemm g, const Sched& S, const Epi& E) {
    int tid = threadIdx.x; asm volatile("" : "+v"(tid));
    const int wid = __builtin_amdgcn_readfirstlane(tid >> 6), lane = tid & 63, wr = wid >> 2, wc = wid & 3, fr = lane & 15, fq = lane >> 4;
    const int K = g.K * ESZ / 2  , nt = K / BK, nN = g.N / BM;
    const int kstep = BK * 2;
    const int hstep = HALF * K * 2;
    const int tstep = 2 * hstep;
    const int qstep = hstep / 2;
    const __amdgpu_buffer_rsrc_t rsA = __builtin_amdgcn_make_buffer_rsrc((void*)g.A, 0, 0x7fffffff, 0x00020000);
    const __amdgpu_buffer_rsrc_t rsB = __builtin_amdgcn_make_buffer_rsrc((void*)g.Bt, 0, 0x7fffffff, 0x00020000);
    int voffB[2], vA0[2]; int RA0 = 0, cby = 0; unsigned cP[2] = {0u, 0u}, nP[2] = {0u, 0u};
#pragma unroll
    for (int i = 0; i < 2; ++i) { int R, C; stage_rc(tid * 16 + i * 8192, R, C); const int Rb = Epi::PERM ? ((R & ~31) + perm32(R & 31)) : R;
        if (i == 0) { RA0 = R; cby = C * 2; }
        vA0[i] = (R * K + C) * 2;
        voffB[i] = (Rb * K + C) * 2; }
    const unsigned ldsw = (unsigned)wid * 1024u;
    const int lpart = lds_byte(fr, fq * 8); const int aoffU = wr * 8192, boffU = wc * 4096;
    const int aoffP = lpart + aoffU, boffP = lpart + boffU;
#define PG8_FRESH(u, pers) (pers)
#define PG8_SA(b, h) (((b) * 2 + (h)) * HTB)
#define PG8_SB(b, h) ((4 + (b) * 2 + (h)) * HTB)
#define PG8_STAGE(bufoff, rs, soff, voff) do { _Pragma("unroll") for (int _i = 0; _i < 2; ++_i) { \
        __builtin_amdgcn_raw_ptr_buffer_load_lds(rs, (LAS unsigned*)(lds + (bufoff) + ldsw + _i * 8192), 16, (voff)[0], (soff) + _i * qstep, 0, 0); } } while (0)
#define PG8_GOFF(p, h) ((int)((((h) ? ((p) >> 16) : ((p) & 0xffffu)) * (unsigned)(K * 2)) + (unsigned)cby))
#define PG8_GLOAD(bufoff, soff, h) do { _Pragma("unroll") for (int _i = 0; _i < 2; ++_i) __builtin_amdgcn_raw_ptr_buffer_load_lds(rsA, (LAS unsigned*)(lds + (bufoff) + ldsw + _i * 8192), 16, PG8_GOFF(cP[_i], h), (soff), 0, 0); } while (0)
#define PG8_ROWS(P, pm) do { _Pragma("unroll") for (int _i = 0; _i < 2; ++_i) { const int* _rl = g.rowlist + (pm) * BM + RA0 + _i * 64; P[_i] = (unsigned)_rl[0] | ((unsigned)_rl[HALF] << 16); } } while (0)
#define PG8_STAGE_A0(bufoff, soff) do { if constexpr (GATHER) PG8_GLOAD(bufoff, soff, 0); else PG8_STAGE(bufoff, rsA, soff, vA0); } while (0)
#define PG8_STAGE_A1(bufoff, soff) do { if constexpr (GATHER) PG8_GLOAD(bufoff, soff, 1); else PG8_STAGE(bufoff, rsA, (soff) + hstep, vA0); } while (0)
#define PG8_LDA(dst, b, h) do { const int aoff = PG8_FRESH(aoffU, aoffP); if constexpr (ESZ == 2) { _Pragma("unroll") for (int m = 0; m < 4; ++m) _Pragma("unroll") for (int k = 0; k < 2; ++k) dst[m][k] = *(const LAS bf16x8*)(lds + PG8_SA(b, h) + aoff + m * 2048 + k * 1024); } \
        else { _Pragma("unroll") for (int m = 0; m < 4; ++m) { const i32x4 _lo = *(const LAS i32x4*)(lds + PG8_SA(b, h) + aoff + m * 2048), _hi = *(const LAS i32x4*)(lds + PG8_SA(b, h) + aoff + m * 2048 + 1024); dst##8[m] = __builtin_shufflevector(_lo, _hi, 0, 1, 2, 3, 4, 5, 6, 7); } } } while (0)
#define PG8_LDB(dst, b, h) do { const int boff = PG8_FRESH(boffU, boffP); if constexpr (ESZ == 2) { _Pragma("unroll") for (int n = 0; n < 2; ++n) _Pragma("unroll") for (int k = 0; k < 2; ++k) dst[n][k] = *(const LAS bf16x8*)(lds + PG8_SB(b, h) + boff + n * 2048 + k * 1024); } \
        else { _Pragma("unroll") for (int n = 0; n < 2; ++n) { const i32x4 _lo = *(const LAS i32x4*)(lds + PG8_SB(b, h) + boff + n * 2048), _hi = *(const LAS i32x4*)(lds + PG8_SB(b, h) + boff + n * 2048 + 1024); dst##8[n] = __builtin_shufflevector(_lo, _hi, 0, 1, 2, 3, 4, 5, 6, 7); } } } while (0)
#define PG8_MMA(ai, bj, At, Bt) do { __builtin_amdgcn_s_setprio(1); _Pragma("unroll") for (int m = 0; m < 4; ++m) _Pragma("unroll") for (int n = 0; n < 2; ++n) { \
        if constexpr (ESZ == 2) { _Pragma("unroll") for (int k = 0; k < 2; ++k) acc[ai][bj][m][n] = __builtin_amdgcn_mfma_f32_16x16x32_bf16(Bt[n][k], At[m][k], acc[ai][bj][m][n], 0, 0, 0); } \
        else acc[ai][bj][m][n] = __builtin_amdgcn_mfma_scale_f32_16x16x128_f8f6f4(Bt##8[n], At##8[m], acc[ai][bj][m][n], 0, 0, 0, 0, 0, 0); } \
        __builtin_amdgcn_s_setprio(0); } while (0)
#define PG8_WAIT_V(n) asm volatile("s_waitcnt vmcnt(" #n ")" ::: "memory")
#define PG8_WAIT_L(n) asm volatile("s_waitcnt lgkmcnt(" #n ")" ::: "memory")
#define PG8_BAR __builtin_amdgcn_s_barrier()
#define PG8_SCHED __builtin_amdgcn_sched_barrier(0)
    Unit cur, nxt; int ui = 0;
    if (!S.next(0, cur)) return;
    f32x4 acc[2][2][4][2];
#pragma unroll
    for (int a = 0; a < 2; ++a)
#pragma unroll
        for (int b = 0; b < 2; ++b)
#pragma unroll
            for (int m = 0; m < 4; ++m)
#pragma unroll
                for (int n = 0; n < 2; ++n) acc[a][b][m][n] = (f32x4){0.f, 0.f, 0.f, 0.f};
    bf16x8 At[4][2], B0[2][2], B1[2][2]; i32x8 At8[4], B08[2], B18[2];
    int cA, cB = ((cur.pm / g.tpg) * nN + cur.pn) * tstep;
    if constexpr (GATHER) { cA = 0; PG8_ROWS(cP, cur.pm); } else cA = cur.pm * tstep;
    PG8_STAGE(PG8_SB(0, 0), rsB, cB, voffB); PG8_STAGE_A0(PG8_SA(0, 0), cA); PG8_STAGE(PG8_SB(0, 1), rsB, cB + hstep, voffB); PG8_STAGE_A1(PG8_SA(0, 1), cA);
    if (wr == 1) PG8_BAR;
    PG8_WAIT_V(4); PG8_BAR;
    PG8_STAGE(PG8_SB(1, 0), rsB, cB + kstep, voffB); PG8_STAGE_A0(PG8_SA(1, 0), cA + kstep); PG8_STAGE(PG8_SB(1, 1), rsB, cB + hstep + kstep, voffB);
    PG8_WAIT_V(6); PG8_BAR;
    for (;;) {
        const bool has_next = S.next(ui + 1, nxt);
        int nA; const int nB = has_next ? ((nxt.pm / g.tpg) * nN + nxt.pn) * tstep : cB;
        if constexpr (GATHER) { nA = 0; if (has_next) PG8_ROWS(nP, nxt.pm); else { nP[0] = cP[0]; nP[1] = cP[1]; } }
        else nA = has_next ? nxt.pm * tstep : cA;
#pragma unroll 1
        for (int t = 0; t < nt; t += 2) {
            const bool last = (t == nt - 2);
            const int a1 = cA + (t + 1) * kstep;
            const int a2 = last ? nA : cA + (t + 2) * kstep, b2 = last ? nB : cB + (t + 2) * kstep;
            const int a3 = a2 + kstep, b3 = b2 + kstep;
            PG8_LDB(B0, 0, 0); PG8_SCHED; PG8_LDA(At, 0, 0); PG8_STAGE_A1(PG8_SA(1, 1), a1);
            if constexpr (GATHER) { if (last) { cP[0] = nP[0]; cP[1] = nP[1]; } }
            PG8_WAIT_L(8); PG8_BAR; PG8_WAIT_L(0); PG8_MMA(0, 0, At, B0); PG8_BAR; PG8_SCHED;
            PG8_LDB(B1, 0, 1); PG8_STAGE(PG8_SB(0, 0), rsB, b2, voffB);
            PG8_BAR; PG8_WAIT_L(0); PG8_MMA(0, 1, At, B1); PG8_BAR;
            PG8_LDA(At, 0, 1); PG8_STAGE_A0(PG8_SA(0, 0), a2);
            PG8_BAR; PG8_WAIT_L(0); PG8_MMA(1, 0, At, B0); PG8_BAR; PG8_SCHED;
            PG8_STAGE(PG8_SB(0, 1), rsB, b2 + hstep, voffB);
            PG8_WAIT_V(6); PG8_BAR; PG8_MMA(1, 1, At, B1); PG8_BAR;
            PG8_LDB(B0, 1, 0); PG8_SCHED; PG8_LDA(At, 1, 0); PG8_STAGE_A1(PG8_SA(0, 1), a2);
            PG8_WAIT_L(8); PG8_BAR; PG8_WAIT_L(0); PG8_MMA(0, 0, At, B0); PG8_BAR; PG8_SCHED;
            PG8_LDB(B1, 1, 1); PG8_STAGE(PG8_SB(1, 0), rsB, b3, voffB);
            PG8_BAR; PG8_WAIT_L(0); PG8_MMA(0, 1, At, B1); PG8_BAR;
            PG8_LDA(At, 1, 1); PG8_STAGE_A0(PG8_SA(1, 0), a3);
            PG8_BAR; PG8_WAIT_L(0); PG8_MMA(1, 0, At, B0); PG8_BAR; PG8_SCHED;
            PG8_STAGE(PG8_SB(1, 1), rsB, b3 + hstep, voffB);
            PG8_WAIT_V(6); PG8_BAR; PG8_MMA(1, 1, At, B1); PG8_BAR;
        }
        E(acc, cur, wr, wc, fr, fq);
        if (!has_next) break;
#pragma unroll
        for (int a = 0; a < 2; ++a)
#pragma unroll
            for (int b = 0; b < 2; ++b)
#pragma unroll
                for (int m = 0; m < 4; ++m)
#pragma unroll
                    for (int n = 0; n < 2; ++n) acc[a][b][m][n] = (f32x4){0.f, 0.f, 0.f, 0.f};
        cur = nxt; cA = nA; cB = nB; ++ui;
    }
    PG8_WAIT_V(0);
    if (wr == 0) PG8_BAR;
    PG8_BAR;
#undef PG8_FRESH
#undef PG8_SA
#undef PG8_SB
#undef PG8_STAGE
#undef PG8_STAGE_A1
#undef PG8_STAGE_A0
#undef PG8_GLOAD
#undef PG8_GOFF
#undef PG8_ROWS
#undef PG8_LDA
#undef PG8_LDB
#undef PG8_MMA
#undef PG8_WAIT_V
#undef PG8_WAIT_L
#undef PG8_BAR
#undef PG8_SCHED
}

struct EpiBf16 {
    static constexpr bool PERM = true;
    bf16_t* O; int ldc;
    __device__ __forceinline__ void operator()(const f32x4 (&acc)[2][2][4][2], const Unit& u, int wr, int wc, int fr, int fq) const {
        const int row0 = u.pm * BM + wr * 64 + fr, col0 = u.pn * BM + wc * 32 + 8 * fq;
#pragma unroll
        for (int ai = 0; ai < 2; ++ai)
#pragma unroll
            for (int m = 0; m < 4; ++m) { bf16_t* rowp = O + (size_t)(row0 + ai * HALF + m * 16) * ldc + col0;
#pragma unroll
                for (int bj = 0; bj < 2; ++bj) { const f32x4 v0 = acc[ai][bj][m][0], v1 = acc[ai][bj][m][1];
                    u32x4 w; w.x = cvt_pk_bf16(v0[0], v0[1]); w.y = cvt_pk_bf16(v0[2], v0[3]); w.z = cvt_pk_bf16(v1[0], v1[1]); w.w = cvt_pk_bf16(v1[2], v1[3]);
                    *(u32x4*)(rowp + bj * HALF) = w; } }
    }
};
struct EpiScIn {
    static constexpr bool PERM = true;
    bf16_t* O;
    __device__ __forceinline__ void operator()(const f32x4 (&acc)[2][2][4][2], const Unit& u, int wr, int wc, int fr, int fq) const {
        const int row0 = u.pm * BM + wr * 64 + fr;
        if (u.pn < 4) { const int col0 = u.pn * BM + wc * 32 + 8 * fq;
#pragma unroll
            for (int ai = 0; ai < 2; ++ai)
#pragma unroll
                for (int m = 0; m < 4; ++m) { bf16_t* rowp = O + (size_t)(row0 + ai * HALF + m * 16) * 2048 + col0;
#pragma unroll
                    for (int bj = 0; bj < 2; ++bj) { const f32x4 v0 = acc[ai][bj][m][0], v1 = acc[ai][bj][m][1];
                        u32x4 w; w.x = cvt_pk_bf16(v0[0], v0[1]); w.y = cvt_pk_bf16(v0[2], v0[3]); w.z = cvt_pk_bf16(v1[0], v1[1]); w.w = cvt_pk_bf16(v1[2], v1[3]);
                        *(u32x4*)(rowp + bj * HALF) = w; } }
        } else { const int col0 = 1024 + (u.pn - 4) * HALF + wc * 32 + 8 * fq;
#pragma unroll
            for (int ai = 0; ai < 2; ++ai)
#pragma unroll
                for (int m = 0; m < 4; ++m) { const f32x4 v0 = acc[ai][0][m][0] * acc[ai][1][m][0], v1 = acc[ai][0][m][1] * acc[ai][1][m][1];
                    u32x4 w; w.x = cvt_pk_bf16(v0[0], v0[1]); w.y = cvt_pk_bf16(v0[2], v0[3]); w.z = cvt_pk_bf16(v1[0], v1[1]); w.w = cvt_pk_bf16(v1[2], v1[3]);
                    *(u32x4*)(O + (size_t)(row0 + ai * HALF + m * 16) * 2048 + col0) = w; }
        }
    }
};
template <bool F32BASE> struct EpiRes {
    static constexpr bool PERM = true;
    const void* baseL; const void* baseC; bf16_t* out; const float* gate;
    __device__ __forceinline__ void operator()(const f32x4 (&acc)[2][2][4][2], const Unit& u, int wr, int wc, int fr, int fq) const {
        const int row0 = u.pm * BM + wr * 64 + fr, col0 = u.pn * BM + wc * 32 + 8 * fq;
        const bool isc = u.pm >= NLAT / BM;
        const int midx = isc ? 8 : (u.pm >> 4);
        const float* gp = gate + (size_t)midx * MODW + col0;
        const size_t boff = isc ? (size_t)(row0 - NLAT) * DM + col0 : (size_t)row0 * DM + col0;
        const void* bbase = isc ? baseC : baseL;
        bf16_t* op = out + (size_t)row0 * DM + col0;
        f32x4 gv[2][2];
#pragma unroll
        for (int bj = 0; bj < 2; ++bj)
#pragma unroll
            for (int n = 0; n < 2; ++n) gv[bj][n] = *(const f32x4*)(gp + bj * HALF + n * 4);
        if constexpr (F32BASE) {
#pragma unroll
            for (int ai = 0; ai < 2; ++ai) {
                f32x4 bq[4][2][2];
#pragma unroll
                for (int m = 0; m < 4; ++m)
#pragma unroll
                    for (int bj = 0; bj < 2; ++bj) { const float* bp = (const float*)bbase + boff + (size_t)(ai * HALF + m * 16) * DM + bj * HALF; bq[m][bj][0] = *(const f32x4*)bp; bq[m][bj][1] = *(const f32x4*)(bp + 4); }
#pragma unroll
                for (int m = 0; m < 4; ++m) { const size_t ro = (size_t)(ai * HALF + m * 16) * DM;
#pragma unroll
                    for (int bj = 0; bj < 2; ++bj) {
                        const f32x4 v0 = bq[m][bj][0] + gv[bj][0] * acc[ai][bj][m][0], v1 = bq[m][bj][1] + gv[bj][1] * acc[ai][bj][m][1];
                        u32x4 o; o.x = cvt_pk_bf16(v0[0], v0[1]); o.y = cvt_pk_bf16(v0[2], v0[3]); o.z = cvt_pk_bf16(v1[0], v1[1]); o.w = cvt_pk_bf16(v1[2], v1[3]);
                        *(u32x4*)(op + ro + bj * HALF) = o; } }
                asm volatile("" ::: "memory"); }
        } else {
            u32x4 bw[2][4][2];
#pragma unroll
            for (int ai = 0; ai < 2; ++ai)
#pragma unroll
                for (int m = 0; m < 4; ++m)
#pragma unroll
                    for (int bj = 0; bj < 2; ++bj) bw[ai][m][bj] = *(const u32x4*)((const bf16_t*)bbase + boff + (size_t)(ai * HALF + m * 16) * DM + bj * HALF);
#pragma unroll
            for (int ai = 0; ai < 2; ++ai)
#pragma unroll
                for (int m = 0; m < 4; ++m) { const size_t ro = (size_t)(ai * HALF + m * 16) * DM;
#pragma unroll
                    for (int bj = 0; bj < 2; ++bj) { const u32x4 w = bw[ai][m][bj];
                        const f32x4 b0 = (f32x4){bf_lo(w.x), bf_hi(w.x), bf_lo(w.y), bf_hi(w.y)}, b1 = (f32x4){bf_lo(w.z), bf_hi(w.z), bf_lo(w.w), bf_hi(w.w)};
                        const f32x4 v0 = b0 + gv[bj][0] * acc[ai][bj][m][0], v1 = b1 + gv[bj][1] * acc[ai][bj][m][1];
                        u32x4 o; o.x = cvt_pk_bf16(v0[0], v0[1]); o.y = cvt_pk_bf16(v0[2], v0[3]); o.z = cvt_pk_bf16(v1[0], v1[1]); o.w = cvt_pk_bf16(v1[2], v1[3]);
                        *(u32x4*)(op + ro + bj * HALF) = o; } }
        }
    }
};
__device__ __forceinline__ unsigned pk4_fp8(float a, float b, float c, float d) { int w = 0; w = __builtin_amdgcn_cvt_pk_fp8_f32(a, b, w, false); w = __builtin_amdgcn_cvt_pk_fp8_f32(c, d, w, true); return (unsigned)w; }
struct EpiMoeUp {
    static constexpr bool PERM = true;
    unsigned char* H;
    __device__ __forceinline__ void operator()(const f32x4 (&acc)[2][2][4][2], const Unit& u, int wr, int wc, int fr, int fq) const {
        const int row0 = u.pm * BM + wr * 64 + fr, col0 = u.pn * HALF + wc * 32 + 8 * fq;
#pragma unroll
        for (int ai = 0; ai < 2; ++ai)
#pragma unroll
            for (int m = 0; m < 4; ++m) { unsigned char* rowp = H + (size_t)(row0 + ai * HALF + m * 16) * DM + col0;
                float h[8];
#pragma unroll
                for (int n = 0; n < 2; ++n)
#pragma unroll
                    for (int j = 0; j < 4; ++j) { const float gt = acc[ai][0][m][n][j] * 0.03125f, up = acc[ai][1][m][n][j] * 0.03125f;
                        h[n * 4 + j] = gt * __builtin_amdgcn_rcpf(1.0f + __expf(-gt)) * up; }
                u32x2 w; w.x = pk4_fp8(h[0], h[1], h[2], h[3]); w.y = pk4_fp8(h[4], h[5], h[6], h[7]);
                *(u32x2*)rowp = w; }
    }
};
struct EpiMoeDown {
    static constexpr bool PERM = true;
    unsigned char* Y; const float* gl;
    __device__ __forceinline__ void operator()(const f32x4 (&acc)[2][2][4][2], const Unit& u, int wr, int wc, int fr, int fq) const {
        const int row0 = u.pm * BM + wr * 64 + fr, col0 = u.pn * BM + wc * 32 + 8 * fq;
#pragma unroll
        for (int ai = 0; ai < 2; ++ai)
#pragma unroll
            for (int m = 0; m < 4; ++m) { const int row = row0 + ai * HALF + m * 16; const float gg = 0.5f; unsigned char* rowp = Y + (size_t)row * DM + col0;
#pragma unroll
                for (int bj = 0; bj < 2; ++bj) { const f32x4 v0 = acc[ai][bj][m][0] * gg, v1 = acc[ai][bj][m][1] * gg;
                    u32x2 w; w.x = pk4_fp8(v0[0], v0[1], v0[2], v0[3]); w.y = pk4_fp8(v1[0], v1[1], v1[2], v1[3]);
                    *(u32x2*)(rowp + bj * HALF) = w; } }
    }
};
}


namespace att {
constexpr int D = 128, NW = 8, QBLK = 32, KVBLK = 64;
constexpr float SCALE = 0.088388347648318440f;
constexpr float THR = 8.f;
constexpr int SDEPTH = 2;
constexpr int LDQ = 1536, LDK = 256, LDO = 1024;
constexpr size_t SHM_V = KVBLK * D * 2, SHM_K = KVBLK * D * 2, SHM_ATTN = 2 * SHM_V + 2 * SHM_K + NW * 64 * 4;
using s16x4  = __attribute__((ext_vector_type(4))) short;
using f32x16 = __attribute__((ext_vector_type(16))) float;
#define KSWZ(row, colB) ((row) * 256 + ((colB) ^ (((row) & 7) << 4)))
#define SBAR() __builtin_amdgcn_sched_barrier(0)
__device__ __forceinline__ int crow(int r, int hi) { return (r & 3) + 8 * (r >> 2) + 4 * hi; }
__device__ __forceinline__ unsigned cvtpk(float lo, float hi) { unsigned r; asm volatile("v_cvt_pk_bf16_f32 %0, %1, %2" : "=v"(r) : "v"(lo), "v"(hi)); return r; }
__device__ __forceinline__ bf16x8 ld8(const bf16_t* p) { return *reinterpret_cast<const bf16x8*>(p); }

__device__ __forceinline__ void partialSM(f32x16& p0, f32x16& p1, float& m_reg, float& mn, float& alpha) {
  constexpr float C = SCALE * 1.4426950408889634f;
  float pmax = p0[0]; for (int r = 1; r < 16; ++r) pmax = fmaxf(pmax, p0[r]); for (int r = 0; r < 16; ++r) pmax = fmaxf(pmax, p1[r]);
  { auto rr = __builtin_amdgcn_permlane32_swap(__float_as_uint(pmax), __float_as_uint(pmax), false, false);
    pmax = fmaxf(__uint_as_float(rr[0]), __uint_as_float(rr[1])); }
  if (__builtin_expect(__all(pmax - m_reg <= THR / SCALE), 1)) { mn = m_reg; alpha = 1.f; }
  else { mn = fmaxf(m_reg, pmax); alpha = __builtin_amdgcn_exp2f((m_reg - mn) * C); m_reg = mn; }
  float mnC = -mn * C;
  for (int r = 0; r < 16; ++r) p0[r] = fmaf(p0[r], C, mnC); for (int r = 0; r < 16; ++r) p1[r] = fmaf(p1[r], C, mnC);
  for (int r = 0; r < 16; ++r) p0[r] = __builtin_amdgcn_exp2f(p0[r]);
}
__device__ __forceinline__ void finishSM(f32x16& p0, f32x16& p1, float alpha, float& l_reg, bf16x8& pa0, bf16x8& pa1, bf16x8& pa2, bf16x8& pa3) {
  for (int r = 0; r < 16; ++r) p1[r] = __builtin_amdgcn_exp2f(p1[r]);
  float ps = 0; for (int r = 0; r < 16; ++r) ps += p0[r]; for (int r = 0; r < 16; ++r) ps += p1[r];
  { auto rr = __builtin_amdgcn_permlane32_swap(__float_as_uint(ps), __float_as_uint(ps), false, false);
    ps = __uint_as_float(rr[0]) + __uint_as_float(rr[1]); }
  l_reg = l_reg * alpha + ps;
#define PK4(P, BASE, OUT) do { unsigned a0 = cvtpk(P[BASE + 0], P[BASE + 1]), a1 = cvtpk(P[BASE + 2], P[BASE + 3]);   \
    unsigned b0 = cvtpk(P[BASE + 4], P[BASE + 5]), b1 = cvtpk(P[BASE + 6], P[BASE + 7]);                              \
    auto r0 = __builtin_amdgcn_permlane32_swap(a0, b0, false, false); auto r1 = __builtin_amdgcn_permlane32_swap(a1, b1, false, false); \
    u32x4 w = {r0[0], r1[0], r0[1], r1[1]}; OUT = *reinterpret_cast<bf16x8*>(&w); } while (0)
  PK4(p0, 0, pa0); PK4(p0, 8, pa1); PK4(p1, 0, pa2); PK4(p1, 8, pa3);
#undef PK4
}
__device__ __forceinline__ void qkt(f32x16& p0, f32x16& p1, const bf16_t* Ks, const bf16x8* qr, int r32, int hi) {
  p0 = f32x16{}; p1 = f32x16{};
  for (int d0 = 0; d0 < 8; ++d0) { int cb = (d0 * 16 + hi * 8) * 2;
    bf16x8 b0 = *reinterpret_cast<const bf16x8*>((const char*)Ks + KSWZ(r32, cb));
    bf16x8 b1 = *reinterpret_cast<const bf16x8*>((const char*)Ks + KSWZ(32 + r32, cb));
    p0 = __builtin_amdgcn_mfma_f32_32x32x16_bf16(b0, qr[d0], p0, 0, 0, 0);
    p1 = __builtin_amdgcn_mfma_f32_32x32x16_bf16(b1, qr[d0], p1, 0, 0, 0); }
}
__device__ __forceinline__ int v_st(int k, int c) { const int kk = (k & ~0xC) | ((k & 4) << 1) | ((k & 8) >> 1); return ((kk >> 3) * 4 + (c >> 5)) * 512 + ((kk & 7) * 32 + (c & 31)) * 2; }
__device__ __forceinline__ int v_rd_base(int lane) { return ((lane & 3) << 3) | (((lane >> 2) & 3) << 6) | (((lane >> 4) & 1) << 5) | (((lane >> 5) & 1) << 8); }
constexpr int v_rd_off(int d0, int ks, int half) { return d0 * 512 + ks * 4096 + half * 2048; }
template <int OFF> __device__ __forceinline__ s16x4 tr_read(int vb) {
  s16x4 r; asm volatile("ds_read_b64_tr_b16 %0, %1 offset:%2" : "=&v"(r) : "v"(vb), "i"(OFF) : "memory"); return r;
}
template <int D0> __device__ __forceinline__ void pv_one(f32x16& od, int vb, bf16x8 pa0, bf16x8 pa1, bf16x8 pa2, bf16x8 pa3) {
  const s16x4 l0 = tr_read<v_rd_off(D0, 0, 0)>(vb), h0 = tr_read<v_rd_off(D0, 0, 1)>(vb), l1 = tr_read<v_rd_off(D0, 1, 0)>(vb), h1 = tr_read<v_rd_off(D0, 1, 1)>(vb);
  const s16x4 l2 = tr_read<v_rd_off(D0, 2, 0)>(vb), h2 = tr_read<v_rd_off(D0, 2, 1)>(vb), l3 = tr_read<v_rd_off(D0, 3, 0)>(vb), h3 = tr_read<v_rd_off(D0, 3, 1)>(vb);
  asm volatile("s_waitcnt lgkmcnt(0)" ::: "memory"); SBAR();
#define PK(L, H) (bf16x8){L[0], L[1], L[2], L[3], H[0], H[1], H[2], H[3]}
  od = __builtin_amdgcn_mfma_f32_32x32x16_bf16(pa0, PK(l0, h0), od, 0, 0, 0);
  od = __builtin_amdgcn_mfma_f32_32x32x16_bf16(pa1, PK(l1, h1), od, 0, 0, 0);
  od = __builtin_amdgcn_mfma_f32_32x32x16_bf16(pa2, PK(l2, h2), od, 0, 0, 0);
  od = __builtin_amdgcn_mfma_f32_32x32x16_bf16(pa3, PK(l3, h3), od, 0, 0, 0);
#undef PK
}
__device__ __forceinline__ void pv_d0(f32x16* o, int vb, bf16x8 pa0, bf16x8 pa1, bf16x8 pa2, bf16x8 pa3) {
  pv_one<0>(o[0], vb, pa0, pa1, pa2, pa3); pv_one<1>(o[1], vb, pa0, pa1, pa2, pa3); pv_one<2>(o[2], vb, pa0, pa1, pa2, pa3); pv_one<3>(o[3], vb, pa0, pa1, pa2, pa3);
}
__device__ __forceinline__ void attn_dense_body(const bf16_t* __restrict__ Qb, const bf16_t* __restrict__ Kh, const bf16_t* __restrict__ Vh,
                                                bf16_t* __restrict__ Ob, int seq, char* lds) {
  const int tid = threadIdx.x, wid = tid >> 6, lane = tid & 63, r32 = lane & 31, hi = lane >> 5;
  bf16_t* V_lds = (bf16_t*)lds; bf16_t* K_lds = (bf16_t*)(lds + 2 * SHM_V);
  float* ws = (float*)(lds + 2 * SHM_V + 2 * SHM_K) + wid * 64; float* li_l = ws; float* al_l = ws + 32;
  float m_reg = -1e30f, l_reg = 0; f32x16 o[4] = {}; bf16x8 qr[8];
  const bf16_t* Qw = Qb + (long)(wid * QBLK + r32) * LDQ + hi * 8;
#pragma unroll
  for (int d0 = 0; d0 < 8; ++d0) qr[d0] = ld8(Qw + d0 * 16);
  const int sr = tid >> 4, sc = (tid & 15) * 8, vst0 = v_st(sr, sc), vst1 = v_st(32 + sr, sc);
  const int vb0 = (int)(uintptr_t)V_lds + v_rd_base(lane);
  struct { bf16x8 vs0, vs1, ks0, ks1; } sr_[SDEPTH];
#define SLOAD(i, k0) do { sr_[i].vs0 = ld8(&Vh[(long)((k0) + sr) * LDK + sc]); sr_[i].vs1 = ld8(&Vh[(long)((k0) + 32 + sr) * LDK + sc]); \
    sr_[i].ks0 = ld8(&Kh[(long)((k0) + sr) * LDK + sc]); sr_[i].ks1 = ld8(&Kh[(long)((k0) + 32 + sr) * LDK + sc]); } while (0)
#define SWRITE(b, i) do { *(bf16x8*)((char*)V_lds + (b) * SHM_V + vst0) = sr_[i].vs0;          \
    *(bf16x8*)((char*)V_lds + (b) * SHM_V + vst1) = sr_[i].vs1; int kc = sc * 2;               \
    *(bf16x8*)((char*)K_lds + (b) * SHM_K + KSWZ(sr, kc)) = sr_[i].ks0;                       \
    *(bf16x8*)((char*)K_lds + (b) * SHM_K + KSWZ(32 + sr, kc)) = sr_[i].ks1; } while (0)
#define SWAIT() do { if constexpr (SDEPTH == 2) asm volatile("s_waitcnt vmcnt(4)" ::: "memory"); else asm volatile("s_waitcnt vmcnt(0)" ::: "memory"); } while (0)
#define RESC(a) do { if (__any((a) < 1.f)) { if (hi == 0) al_l[r32] = (a); asm volatile("s_waitcnt lgkmcnt(0)" ::: "memory"); \
    for (int d = 0; d < 4; ++d) for (int r = 0; r < 16; ++r) o[d][r] *= al_l[crow(r, hi)]; } } while (0)
  f32x16 pA0, pA1, pB0, pB1; float mnA, mnB, alA, alB; bf16x8 pa0, pa1, pa2, pa3; const int NT = seq / KVBLK;
  constexpr int SE = 0, SO = SDEPTH - 1;
  SLOAD(SE, 0); asm volatile("s_waitcnt vmcnt(0)" ::: "memory"); SWRITE(0, SE); __syncthreads();
  qkt(pA0, pA1, K_lds, qr, r32, hi); partialSM(pA0, pA1, m_reg, mnA, alA);
  SLOAD(SO, KVBLK); if constexpr (SDEPTH == 2) { if (2 < NT) SLOAD(SE, 2 * KVBLK); }
  SWAIT(); SWRITE(1, SO); __syncthreads();
  for (int j = 1; j + 1 < NT; j += 2) {
    SBAR(); qkt(pB0, pB1, (bf16_t*)((char*)K_lds + SHM_K), qr, r32, hi);
    finishSM(pA0, pA1, alA, l_reg, pa0, pa1, pa2, pa3); SBAR();
    SLOAD(SO, (j + SDEPTH) * KVBLK); SBAR();
    pv_d0(o, vb0, pa0, pa1, pa2, pa3); partialSM(pB0, pB1, m_reg, mnB, alB);
    __syncthreads(); SWAIT(); SWRITE(0, SE);
    RESC(alB); __syncthreads();
    SBAR(); qkt(pA0, pA1, K_lds, qr, r32, hi);
    finishSM(pB0, pB1, alB, l_reg, pa0, pa1, pa2, pa3); SBAR();
    if (SDEPTH == 1 || j + 3 < NT) SLOAD(SE, (j + 1 + SDEPTH) * KVBLK); SBAR();
    pv_d0(o, vb0 + (int)SHM_V, pa0, pa1, pa2, pa3); partialSM(pA0, pA1, m_reg, mnA, alA);
    __syncthreads(); SWAIT(); SWRITE(1, SO);
    RESC(alA); __syncthreads();
  }
  SBAR(); qkt(pB0, pB1, (bf16_t*)((char*)K_lds + SHM_K), qr, r32, hi);
  finishSM(pA0, pA1, alA, l_reg, pa0, pa1, pa2, pa3); SBAR();
  pv_d0(o, vb0, pa0, pa1, pa2, pa3); partialSM(pB0, pB1, m_reg, mnB, alB);
  __syncthreads(); RESC(alB);
  finishSM(pB0, pB1, alB, l_reg, pa0, pa1, pa2, pa3); SBAR();
  pv_d0(o, vb0 + (int)SHM_V, pa0, pa1, pa2, pa3);
  if (hi == 0) li_l[r32] = l_reg; asm volatile("s_waitcnt lgkmcnt(0)" ::: "memory");
  float rli[16];
#pragma unroll
  for (int r = 0; r < 16; ++r) rli[r] = __builtin_amdgcn_rcpf(li_l[crow(r, hi)]);
  bf16_t* Ow = Ob + (long)(wid * QBLK) * LDO;
#pragma unroll
  for (int r = 0; r < 16; ++r) { int orow = crow(r, hi);
    for (int d0 = 0; d0 < 4; ++d0) Ow[(long)orow * LDO + d0 * 32 + r32] = (bf16_t)f2bf(o[d0][r] * rli[r]); }
#undef SLOAD
#undef SWRITE
#undef SWAIT
#undef RESC
}
#undef KSWZ
#undef SBAR
}

struct Frame {
    LAS unsigned char* lds;
    int wave, G, gw, NGW;
    __device__ __forceinline__ int tid_() const { int t = (int)threadIdx.x; asm volatile("" : "+v"(t)); return t; }
    __device__ __forceinline__ int lane_() const { int t = (int)threadIdx.x & 63; asm volatile("" : "+v"(t)); return t; }
};
#define FOR_ITEMS(var, total) for (int var = (int)(((long)(total) * (int)blockIdx.x) / F.G) + F.wave, var##_end = (int)(((long)(total) * ((int)blockIdx.x + 1)) / F.G); var < var##_end; var += 8)
struct Args { const float* in[28]; float* out; unsigned char* ws; int ph_lo, ph_hi; };
#define KARG_BASE ((const __attribute__((address_space(4))) unsigned char*)__builtin_amdgcn_kernarg_segment_ptr())
#define KIN(i) (*(const float* const __attribute__((address_space(4)))*)(KARG_BASE + 8 * (i)))
#define KOUT (*(float* const __attribute__((address_space(4)))*)(KARG_BASE + 8 * 28))
#define KWS (*(unsigned char* const __attribute__((address_space(4)))*)(KARG_BASE + 8 * 29))

enum { I_X = 0, I_C, I_CTX, I_CCTX, I_ADAW, I_ADAB, I_NORMG, I_SCWIN, I_SCCONV, I_SCWOUT, I_HYWIN, I_HYCONV, I_HYFW1, I_HYFB1, I_HYFW2, I_HYFB2, I_HYFW3, I_HYFREQ, I_HYSKIP, I_HYWOUT,
       I_ATQKV, I_ATQG, I_ATKG, I_ATWO, I_ROUTER, I_WGATE, I_WUP, I_WDOWN };

__device__ __forceinline__ void p0_mod(const Frame& F, const Args& a) {
    LAS float* s = (LAS float*)F.lds;
    LAS float* red = (LAS float*)(F.lds + 9 * 1024 * 4);
    const float* c = KIN(I_C); const float* cc = KIN(I_CCTX);
    { const int t = F.tid_(); f32x4 cv[5];
#pragma unroll
      for (int it = 0; it < 5; ++it) { const int i4 = t + 512 * it, m = i4 >> 8, k = (i4 & 255) * 4; cv[it] = (i4 < 9 * 256) ? *(const f32x4*)(m < 8 ? c + m * 1024 + k : cc + k) : (f32x4){0.f, 0.f, 0.f, 0.f}; }
#pragma unroll
      for (int it = 0; it < 5; ++it) { const int i4 = t + 512 * it; if (i4 < 9 * 256) { const f32x4 v = cv[it];
          *(LAS f32x4*)(s + 4 * i4) = (f32x4){v.x / (1.0f + __expf(-v.x)), v.y / (1.0f + __expf(-v.y)), v.z / (1.0f + __expf(-v.z)), v.w / (1.0f + __expf(-v.w))}; } } }
    __syncthreads();
    float* modv = (float*)(KWS + WS_MODV);
    for (int u = blockIdx.x; u < DEPTH * 96; u += F.G) {
        const int layer = u / 96, col0 = (u % 96) * 64, col = F.tid_() & 63, kp = F.tid_() >> 6;
        const float* w = KIN(I_ADAW) + (size_t)layer * DM * MODW + col0 + col;
        float acc[9];
#pragma unroll
        for (int m = 0; m < 9; ++m) acc[m] = 0.f;
#pragma unroll 32
        for (int k = kp * 128; k < kp * 128 + 128; ++k) { const float wv = w[(size_t)k * MODW];
#pragma unroll
            for (int m = 0; m < 9; ++m) acc[m] += s[m * 1024 + k] * wv; }
#pragma unroll
        for (int m = 0; m < 9; ++m) red[(kp * 9 + m) * 64 + col] = acc[m];
        __syncthreads();
        for (int o = F.tid_(); o < 9 * 64; o += 512) { const int m = o >> 6, cq = o & 63; float t = 0.f;
#pragma unroll
            for (int q = 0; q < 8; ++q) t += red[(q * 9 + m) * 64 + cq];
            modv[((size_t)layer * 9 + m) * MODW + col0 + cq] = t + KIN(I_ADAB)[layer * MODW + col0 + cq]; }
        __syncthreads();
    }
}

__device__ __forceinline__ void transpose_item(const float* W, int K, int N, bf16_t* WT, int k0, int n0, int drow0, LAS float* scr, int lane) {
    float tv[32];
#pragma unroll
    for (int i = 0; i < 32; ++i) tv[i] = W[(size_t)(k0 + 2 * i + (lane >> 5)) * N + n0 + (lane & 31)];
#pragma unroll
    for (int i = 0; i < 32; ++i) scr[(2 * i + (lane >> 5)) * 33 + (lane & 31)] = tv[i];
    LDS_WAIT(); asm volatile("" ::: "memory");
    const int c = lane & 7;
#pragma unroll
    for (int j = 0; j < 4; ++j) { const int n = (lane >> 3) + 8 * j; const LAS float* sp = scr + (8 * c) * 33 + n;
        u32x4 o; o.x = pk2(sp[0 * 33], sp[1 * 33]); o.y = pk2(sp[2 * 33], sp[3 * 33]); o.z = pk2(sp[4 * 33], sp[5 * 33]); o.w = pk2(sp[6 * 33], sp[7 * 33]);
        *(u32x4*)(WT + (size_t)(drow0 + n) * K + k0 + 8 * c) = o; }
    LDS_WAIT(); asm volatile("" ::: "memory");
}
__device__ __forceinline__ void transpose_item_fp8(const float* W, int K, int N, unsigned char* WT, int k0, int n0, int drow0, LAS float* scr, int lane) {
    float tv[32];
#pragma unroll
    for (int i = 0; i < 32; ++i) tv[i] = W[(size_t)(k0 + 2 * i + (lane >> 5)) * N + n0 + (lane & 31)];
#pragma unroll
    for (int i = 0; i < 32; ++i) scr[(2 * i + (lane >> 5)) * 33 + (lane & 31)] = tv[i];
    LDS_WAIT(); asm volatile("" ::: "memory");
    const int c = lane & 7;
#pragma unroll
    for (int j = 0; j < 4; ++j) { const int n = (lane >> 3) + 8 * j; const LAS float* sp = scr + (8 * c) * 33 + n;
        u32x2 o; o.x = pg8::pk4_fp8(sp[0 * 33] * 32.f, sp[1 * 33] * 32.f, sp[2 * 33] * 32.f, sp[3 * 33] * 32.f); o.y = pg8::pk4_fp8(sp[4 * 33] * 32.f, sp[5 * 33] * 32.f, sp[6 * 33] * 32.f, sp[7 * 33] * 32.f);
        *(u32x2*)(WT + (size_t)(drow0 + n) * K + k0 + 8 * c) = o; }
    LDS_WAIT(); asm volatile("" ::: "memory");
}
__device__ __forceinline__ void transpose_scin(const float* W, bf16_t* WT, int item, LAS float* scr, int lane) {
    const int nblk = 3072 / 32, kb = item / nblk, nb = item % nblk, n0 = 32 * nb;
    int d0; if (n0 < 1024) d0 = n0; else if (n0 < 2048) { const int j = n0 - 1024; d0 = 1024 + (j >> 7) * 256 + (j & 127); } else { const int j = n0 - 2048; d0 = 1024 + (j >> 7) * 256 + 128 + (j & 127); }
    transpose_item(W, DM, 3072, WT, 64 * kb, n0, d0, scr, lane);
}
__device__ __forceinline__ void transpose_plain(const float* W, int K, int N, bf16_t* WT, int item, LAS float* scr, int lane) {
    const int nblk = N / 32, kb = item / nblk, nb = item % nblk;
    transpose_item(W, K, N, WT, 64 * kb, 32 * nb, 32 * nb, scr, lane);
}

__device__ __forceinline__ void p0_convert_mixers(const Frame& F, const Args& a) {
    LAS float* scr = (LAS float*)(F.lds + 65536 + F.wave * 8704);
    bf16_t* wm = (bf16_t*)(KWS + WS_WMIX);
    constexpr int I_IN = 16 * 96, I_SQ = 16 * 32, I_QKV = 16 * 48;
    constexpr int NIT = 2 * I_IN + 2 * I_SQ + I_IN + I_SQ + I_QKV + I_SQ;
    for (int it = F.gw; it < NIT; it += F.NGW) {
        int r = it;
        if (r < I_IN) { transpose_scin(KIN(I_SCWIN), wm + WM_SC_IN, r, scr, F.lane_()); continue; } r -= I_IN;
        if (r < I_IN) { transpose_scin(KIN(I_SCWIN) + (size_t)DM * 3072, wm + WM_SC_IN + 3072ull * 1024, r, scr, F.lane_()); continue; } r -= I_IN;
        if (r < I_SQ) { transpose_plain(KIN(I_SCWOUT), DM, DM, wm + WM_SC_OUT, r, scr, F.lane_()); continue; } r -= I_SQ;
        if (r < I_SQ) { transpose_plain(KIN(I_SCWOUT) + (size_t)DM * DM, DM, DM, wm + WM_SC_OUT + 1024ull * 1024, r, scr, F.lane_()); continue; } r -= I_SQ;
        if (r < I_IN) { transpose_plain(KIN(I_HYWIN), DM, 3072, wm + WM_HY_IN, r, scr, F.lane_()); continue; } r -= I_IN;
        if (r < I_SQ) { transpose_plain(KIN(I_HYWOUT), DM, DM, wm + WM_HY_OUT, r, scr, F.lane_()); continue; } r -= I_SQ;
        if (r < I_QKV) { transpose_plain(KIN(I_ATQKV), DM, 1536, wm + WM_AT_QKV, r, scr, F.lane_()); continue; } r -= I_QKV;
        transpose_plain(KIN(I_ATWO), DM, DM, wm + WM_AT_O, r, scr, F.lane_());
    }
}

__device__ __forceinline__ float red16(float v) { v += __shfl_xor(v, 1); v += __shfl_xor(v, 2); v += __shfl_xor(v, 4); v += __shfl_xor(v, 8); return v; }
__device__ __forceinline__ float max16(float v) { v = fmaxf(v, __shfl_xor(v, 1)); v = fmaxf(v, __shfl_xor(v, 2)); v = fmaxf(v, __shfl_xor(v, 4)); v = fmaxf(v, __shfl_xor(v, 8)); return v; }
__device__ __forceinline__ void rowq_load(const float* rowp, int l, f32x4 (&v)[16]) {
#pragma unroll
    for (int j = 0; j < 8; ++j) { const f32x4* p = (const f32x4*)rowp + 2 * (l + 16 * j); v[2 * j] = p[0]; v[2 * j + 1] = p[1]; }
}
__device__ __forceinline__ void rowq_load_bf(const bf16_t* rowp, int l, f32x4 (&v)[16]) {
    u32x4 w[8];
#pragma unroll
    for (int j = 0; j < 8; ++j) w[j] = ((const u32x4*)rowp)[l + 16 * j];
#pragma unroll
    for (int j = 0; j < 8; ++j) { v[2 * j] = (f32x4){bf_lo(w[j].x), bf_hi(w[j].x), bf_lo(w[j].y), bf_hi(w[j].y)}; v[2 * j + 1] = (f32x4){bf_lo(w[j].z), bf_hi(w[j].z), bf_lo(w[j].w), bf_hi(w[j].w)}; }
}
__device__ __forceinline__ void build_ab(const Frame& F, LAS float* At, LAS float* Bt, const float* gvec, const float* modl, int sh_off, int sc_off) {
    const int t = F.tid_();
#pragma unroll
    for (int h = 0; h < 2; ++h) {
        f32x4 g[3], sc[3], sh[3];
#pragma unroll
        for (int k = 0; k < 3; ++k) { const int it = 3 * h + k, i4 = t + 512 * it, m = i4 >> 8, col = (i4 & 255) * 4;
            if (it < 5 && i4 < 9 * DM / 4) { g[k] = *(const f32x4*)(gvec + col); sc[k] = *(const f32x4*)(modl + (size_t)m * MODW + sc_off + col); sh[k] = *(const f32x4*)(modl + (size_t)m * MODW + sh_off + col); }
            else { g[k] = (f32x4){0.f, 0.f, 0.f, 0.f}; sc[k] = g[k]; sh[k] = g[k]; } }
#pragma unroll
        for (int k = 0; k < 3; ++k) { const int it = 3 * h + k, i4 = t + 512 * it, m = i4 >> 8, col = (i4 & 255) * 4;
            if (it < 5 && i4 < 9 * DM / 4) { *(LAS f32x4*)(At + m * DM + col) = g[k] * (1.0f + sc[k]); *(LAS f32x4*)(Bt + m * DM + col) = sh[k]; } }
        asm volatile("" ::: "memory");
    }
}
template <bool FP8 = false>
__device__ __forceinline__ void rowq_norm_store(f32x4 (&v)[16], float ss, const LAS float* At, const LAS float* Bt, int midx, int l, bf16_t* orow) {
    const float rstd = 1.0f / sqrtf(red16(ss) * (1.0f / DM) + EPS);
#pragma unroll
    for (int j = 0; j < 8; ++j) { const int cb = l + 16 * j;
#pragma unroll
        for (int h = 0; h < 2; ++h) { const f32x4 A4 = *(const LAS f32x4*)(At + midx * DM + 8 * cb + 4 * h), B4 = *(const LAS f32x4*)(Bt + midx * DM + 8 * cb + 4 * h);
            v[2 * j + h] = v[2 * j + h] * rstd * A4 + B4; }
        if constexpr (FP8) { u32x2 w; w.x = pg8::pk4_fp8(v[2 * j].x, v[2 * j].y, v[2 * j].z, v[2 * j].w); w.y = pg8::pk4_fp8(v[2 * j + 1].x, v[2 * j + 1].y, v[2 * j + 1].z, v[2 * j + 1].w);
            *(u32x2*)((unsigned char*)orow + 8 * cb) = w; }
        else { u32x4 w; w.x = pk2(v[2 * j].x, v[2 * j].y); w.y = pk2(v[2 * j].z, v[2 * j].w); w.z = pk2(v[2 * j + 1].x, v[2 * j + 1].y); w.w = pk2(v[2 * j + 1].z, v[2 * j + 1].w);
            *(u32x4*)(orow + 8 * cb) = w; } }
}
__device__ __forceinline__ void norm1_phase(const Frame& F, const float* srcL, const float* srcC, int nrows, const float* gvec, const float* modl, bf16_t* hl) {
    LAS float* At = (LAS float*)F.lds; LAS float* Bt = At + 9 * DM;
    __syncthreads(); build_ab(F, At, Bt, gvec, modl, 0, DM); __syncthreads();
    const int l = F.lane_() & 15, rg = F.lane_() >> 4;
    for (int qd = F.gw; qd < nrows / 4; qd += F.NGW) {
        const int row = 4 * qd + rg, midx = row < NLAT ? (row >> 12) : 8;
        const float* xr = row < NLAT ? srcL + (size_t)row * DM : srcC + (size_t)(row - NLAT) * DM;
        f32x4 v[16]; rowq_load(xr, l, v);
        float ss = 0.f;
#pragma unroll
        for (int i = 0; i < 16; ++i) ss += (v[i].x * v[i].x + v[i].y * v[i].y) + (v[i].z * v[i].z + v[i].w * v[i].w);
        rowq_norm_store(v, ss, At, Bt, midx, l, hl + (size_t)row * DM);
    }
}

__device__ __forceinline__ void sc_conv_phase(const Frame& F, const bf16_t* U, const float* convw  , bf16_t* Z, int nrows) {
    const int nitems = (nrows / 8) * 2, lane = F.lane_();
    FOR_ITEMS(it, nitems) {
        const int run = it >> 1, chunk = it & 1, r0 = run * 8, col = chunk * 512 + lane * 8;
        int pos0, slen; if (r0 < NLAT) { pos0 = r0 & (SEQ - 1); slen = SEQ; } else { pos0 = (r0 - NLAT) & (CTXL - 1); slen = CTXL; }
        const bool has_prev = pos0 > 0, has_next = pos0 + 8 < slen;
        u32x4 pp[10], gb[8];
        const bf16_t* base = U + (size_t)r0 * 2048 + col;
#pragma unroll
        for (int i = 0; i < 10; ++i) { const bool ok = (i == 0) ? has_prev : ((i == 9) ? has_next : true);
            if (ok) pp[i] = *(const u32x4*)(base + (ptrdiff_t)(i - 1) * 2048 + DM); else pp[i] = (u32x4){0u, 0u, 0u, 0u}; }
#pragma unroll
        for (int i = 0; i < 8; ++i) gb[i] = *(const u32x4*)(base + (size_t)i * 2048);
        float w0[8], w1[8], w2[8];
#pragma unroll
        for (int j = 0; j < 8; ++j) { w0[j] = convw[col + j]; w1[j] = convw[DM + col + j]; w2[j] = convw[2 * DM + col + j]; }
        float pm[8], pc[8], pn[8];
        auto unp = [&](const u32x4& g, float (&p)[8]) { p[0] = bf_lo(g.x); p[1] = bf_hi(g.x); p[2] = bf_lo(g.y); p[3] = bf_hi(g.y); p[4] = bf_lo(g.z); p[5] = bf_hi(g.z); p[6] = bf_lo(g.w); p[7] = bf_hi(g.w); };
        unp(pp[0], pm); unp(pp[1], pc);
#pragma unroll
        for (int i = 0; i < 8; ++i) {
            unp(pp[i + 2], pn);
            float g[8]; unp(gb[i], g);
            float o[8];
#pragma unroll
            for (int j = 0; j < 8; ++j) o[j] = g[j] * (w0[j] * pm[j] + w1[j] * pc[j] + w2[j] * pn[j]);
            u32x4 w; w.x = pk2(o[0], o[1]); w.y = pk2(o[2], o[3]); w.z = pk2(o[4], o[5]); w.w = pk2(o[6], o[7]);
            *(u32x4*)(Z + (size_t)(r0 + i) * DM + col) = w;
#pragma unroll
            for (int j = 0; j < 8; ++j) { pm[j] = pc[j]; pc[j] = pn[j]; }
        }
    }
}

__device__ __forceinline__ void norm2_router_phase(const Frame& F, const bf16_t* lat, int nrows, const float* gvec, const float* modl, bf16_t* hl,
                                                   const float* wrouter, float* affL, float* affC) {
    LAS float* Wp = (LAS float*)F.lds;
    LAS float* At = Wp + 16 * DM; LAS float* Bt = At + 9 * DM;
    const int lane = F.lane_(), r = lane & 15, q = lane >> 4;
    const int tile0 = (int)(((long)(nrows / 16) * (int)blockIdx.x) / F.G) + F.wave, tile_end = (int)(((long)(nrows / 16) * ((int)blockIdx.x + 1)) / F.G);
    u32x4 bufA[8], bufB[8], xw[16];
#define N2_FETCH(tile_) do { const u32x4* _xr = (const u32x4*)(lat + (size_t)(16 * (tile_) + r) * DM); _Pragma("unroll") for (int i = 0; i < 8; ++i) { bufA[i] = _xr[q + 4 * i]; bufB[i] = _xr[q + 4 * (8 + i)]; } \
        _Pragma("unroll") for (int i = 0; i < 16; ++i) xw[i] = _xr[q + 4 * (16 + i)]; } while (0)
    if (tile0 < tile_end) N2_FETCH(tile0);
    { PB(PT_SUB_GATHER)
    __syncthreads();
    { const int t = F.tid_(); f32x4 wv[8];
#pragma unroll
      for (int it = 0; it < 8; ++it) wv[it] = *(const f32x4*)(wrouter + 4 * (t + 512 * it));
#pragma unroll
      for (int it = 0; it < 8; ++it) { const int i4 = t + 512 * it, col = i4 >> 2, e0 = (i4 & 3) * 4, cb = col >> 3, j = col & 7, q = cb & 3, i = cb >> 2; *(LAS f32x4*)(Wp + ((i * 8 + j) * 4 + q) * 16 + e0) = wv[it]; } }
    build_ab(F, At, Bt, gvec, modl, 3 * DM, 4 * DM);
    __syncthreads();
    PE(PT_SUB_GATHER) }
    for (int tile = tile0; tile < tile_end; tile += 8) {
        const int row = 16 * tile + r, midx = (16 * tile) < NLAT ? ((16 * tile) >> 12) : 8;
        const u32x4* xr = (const u32x4*)(lat + (size_t)row * DM);
        float ss = 0.f;
        if (tile != tile0) N2_FETCH(tile);
        {
#define N2_SQ(v) do { const float a0 = bf_lo((v).x), a1 = bf_hi((v).x), a2 = bf_lo((v).y), a3 = bf_hi((v).y), a4 = bf_lo((v).z), a5 = bf_hi((v).z), a6 = bf_lo((v).w), a7 = bf_hi((v).w); \
              ss += ((a0 * a0 + a1 * a1) + (a2 * a2 + a3 * a3)) + ((a4 * a4 + a5 * a5) + (a6 * a6 + a7 * a7)); } while (0)
#pragma unroll
          for (int i = 0; i < 8; ++i) N2_SQ(bufA[i]);
#pragma unroll
          for (int i = 0; i < 8; ++i) N2_SQ(bufB[i]);
#pragma unroll
          for (int i = 0; i < 16; ++i) N2_SQ(xw[i]);
#undef N2_SQ
        }
        ss += __shfl_xor(ss, 16); ss += __shfl_xor(ss, 32);
        const float rstd = 1.0f / sqrtf(ss * (1.0f / DM) + EPS);
        asm volatile("" ::: "memory");
        f32x4 accA = (f32x4){0.f, 0.f, 0.f, 0.f}, accB = (f32x4){0.f, 0.f, 0.f, 0.f};
        unsigned char* orow = (unsigned char*)hl + (size_t)row * DM;
        const LAS float* atab = At + midx * DM; const LAS float* btab = Bt + midx * DM;
#define N2_BATCH(buf, bt) do { _Pragma("unroll") \
            for (int k = 0; k < 8; ++k) { const int i = 8 * (bt) + k, cb = q + 4 * i; const u32x4 xv = buf[k]; \
                const f32x4 A0 = *(const LAS f32x4*)(atab + 8 * cb), A1 = *(const LAS f32x4*)(atab + 8 * cb + 4), B0 = *(const LAS f32x4*)(btab + 8 * cb), B1 = *(const LAS f32x4*)(btab + 8 * cb + 4); \
                float y[8]; \
                y[0] = bf_lo(xv.x) * rstd * A0.x + B0.x; y[1] = bf_hi(xv.x) * rstd * A0.y + B0.y; y[2] = bf_lo(xv.y) * rstd * A0.z + B0.z; y[3] = bf_hi(xv.y) * rstd * A0.w + B0.w; \
                y[4] = bf_lo(xv.z) * rstd * A1.x + B1.x; y[5] = bf_hi(xv.z) * rstd * A1.y + B1.y; y[6] = bf_lo(xv.w) * rstd * A1.z + B1.z; y[7] = bf_hi(xv.w) * rstd * A1.w + B1.w; \
                u32x2 w8; w8.x = pg8::pk4_fp8(y[0], y[1], y[2], y[3]); w8.y = pg8::pk4_fp8(y[4], y[5], y[6], y[7]); \
                *(u32x2*)(orow + 8 * cb) = w8; \
                const LAS float* wp = Wp + (i * 8) * 64 + lane;            \
                _Pragma("unroll") \
                for (int j = 0; j < 8; j += 2) { accA = __builtin_amdgcn_mfma_f32_16x16x4f32(y[j], wp[j * 64], accA, 0, 0, 0); accB = __builtin_amdgcn_mfma_f32_16x16x4f32(y[j + 1], wp[(j + 1) * 64], accB, 0, 0, 0); } \
                asm volatile("" ::: "memory");            \
            } } while (0)
        N2_BATCH(bufA, 0);
#pragma unroll
        for (int k = 0; k < 8; ++k) bufA[k] = xr[q + 4 * (16 + k)];
        N2_BATCH(bufB, 1);
#pragma unroll
        for (int k = 0; k < 8; ++k) bufB[k] = xr[q + 4 * (24 + k)];
        N2_BATCH(bufA, 2);
        N2_BATCH(bufB, 3);
#undef N2_BATCH
        const f32x4 lg = accA + accB;
        float af[4];
#pragma unroll
        for (int k = 0; k < 4; ++k) { const float mx = max16(lg[k]), ex = __expf(lg[k] - mx); af[k] = ex / red16(ex); }
        const int e = lane & 15, row4 = 16 * tile + 4 * (lane >> 4);
        if (row4 < NLAT) *(f32x4*)(affL + ((size_t)((row4 >> 12) * NE + e) << 12) + (row4 & (SEQ - 1))) = (f32x4){af[0], af[1], af[2], af[3]};
        else { const int rc = row4 - NLAT; *(f32x4*)(affC + ((size_t)((rc >> 8) * NE + e) << 8) + (rc & (CTXL - 1))) = (f32x4){af[0], af[1], af[2], af[3]}; }
    }
}

__device__ __forceinline__ int block_excl_scan(int v, LAS int* tmp, int lane, int wave, int& total) {
    int incl = v;
#pragma unroll
    for (int o = 1; o < 64; o <<= 1) { const int t = __shfl_up(incl, o); if (lane >= o) incl += t; }
    if (lane == 63) tmp[wave] = incl;
    __syncthreads();
    int woff = 0, tot = 0;
#pragma unroll
    for (int w = 0; w < 8; ++w) { const int t = tmp[w]; tot += t; if (w < wave) woff += t; }
    __syncthreads();
    total = tot;
    return woff + incl - v;
}
__device__ __forceinline__ void topk_unit(const Frame& F, const float* aff, int N, int K, int e, int rbase, int tokbase, int* rowlist, float* gl, int* slotmap, const unsigned char* HL8, unsigned char* XG) {
    LAS int* sm = (LAS int*)F.lds;
    const int t = F.tid_(), lane = F.lane_(), wave = F.wave;
    unsigned vb[8];
    if (t * 8 < N) { const u32x4 q0 = *(const u32x4*)(aff + t * 8), q1 = *(const u32x4*)(aff + t * 8 + 4);
        vb[0] = q0.x; vb[1] = q0.y; vb[2] = q0.z; vb[3] = q0.w; vb[4] = q1.x; vb[5] = q1.y; vb[6] = q1.z; vb[7] = q1.w; }
    else {
#pragma unroll
        for (int j = 0; j < 8; ++j) vb[j] = 0u; }
    unsigned T = 0u;
#pragma unroll 1
    for (int g = 0; g < 11; ++g) {
        const int shift = g < 10 ? 28 - 3 * g : 0, nm = g < 10 ? 7 : 1;
        LAS int* cb = sm + (g & 1) * 64;
#pragma unroll 1
        for (int m = 0; m < nm; ++m) { const unsigned cand = T | ((unsigned)(m + 1) << shift); int c = 0;
#pragma unroll
            for (int j = 0; j < 8; ++j) c += (int)__popcll(__ballot(vb[j] >= cand));
            if (lane == 0) cb[wave * 8 + m] = c; }
        __syncthreads();
        pg8::i32x4 t0 = *(const LAS pg8::i32x4*)cb, t1 = *(const LAS pg8::i32x4*)(cb + 4);
#pragma unroll
        for (int w = 1; w < 8; ++w) { const pg8::i32x4 q0 = *(const LAS pg8::i32x4*)(cb + w * 8), q1 = *(const LAS pg8::i32x4*)(cb + w * 8 + 4);
            t0.x += q0.x; t0.y += q0.y; t0.z += q0.z; t0.w += q0.w; t1.x += q1.x; t1.y += q1.y; t1.z += q1.z; }
        int ms = (t0.x >= K) ? 1 : 0;
        if (nm > 1) ms += ((t0.y >= K) ? 1 : 0) + ((t0.z >= K) ? 1 : 0) + ((t0.w >= K) ? 1 : 0) + ((t1.x >= K) ? 1 : 0) + ((t1.y >= K) ? 1 : 0) + ((t1.z >= K) ? 1 : 0);
        T = (unsigned)__builtin_amdgcn_readfirstlane((int)(T | ((unsigned)ms << shift)));
    }
    __syncthreads();
    int ngt = 0, neq = 0;
#pragma unroll
    for (int j = 0; j < 8; ++j) { ngt += (vb[j] > T) ? 1 : 0; neq += (vb[j] == T) ? 1 : 0; }
    int tot_pk;
    const int pre_pk = block_excl_scan((ngt << 16) | neq, sm + 16, lane, wave, tot_pk);
    const int tot_gt = tot_pk >> 16, gt_pre = pre_pk >> 16, eq_pre = pre_pk & 0xffff;
    const int need_eq = K - tot_gt;
    int sel[8], nsel = 0, eqr = eq_pre;
#pragma unroll
    for (int j = 0; j < 8; ++j) { int s = 0; if (vb[j] > T) s = 1; else if (vb[j] == T) { s = (eqr < need_eq) ? 1 : 0; ++eqr; } sel[j] = s; nsel += s; }
    int slot = gt_pre + (eq_pre < need_eq ? eq_pre : need_eq);
    (void)nsel;
    if (t * 8 < N) {
#pragma unroll
        for (int j = 0; j < 8; ++j) { const int row = tokbase + t * 8 + j;
            if (sel[j]) { const int pos = rbase + slot; rowlist[pos] = row; gl[pos] = __uint_as_float(vb[j]); slotmap[row * NE + e] = pos; ++slot; }
            else slotmap[row * NE + e] = -1; }
    }
    __syncthreads();
    (void)HL8; (void)XG;
}
constexpr int MOE_QL = 24576;
__device__ __forceinline__ constexpr size_t moe_wup_off(int wb) { return wb == 2 ? WS_END : WS_WMOE + (size_t)wb * 32 * MiB; }
__device__ __forceinline__ constexpr size_t moe_wdn_off(int wb) { return wb == 2 ? WS_END + 32 * MiB : WS_WMOE_DN + (size_t)wb * 16 * MiB; }
__device__ __forceinline__ void moe_convert_item(const Frame& F, int q) {
    LAS float* scr = (LAS float*)(F.lds + 65536 + F.wave * 8704);
    const int layer = (q >= MOE_QL) + (q >= 2 * MOE_QL) + (q >= 3 * MOE_QL), it = q - layer * MOE_QL, wb = layer == 3 ? 0 : layer;
    unsigned char* wup = KWS + moe_wup_off(wb); unsigned char* wdn = KWS + moe_wdn_off(wb);
    if (it < 16384) { const int e = it >> 10, r = it & 1023, half = r >> 9, q = r & 511, kb = q >> 5, nb = q & 31, n0 = nb * 32;
        const float* W = (half ? KIN(I_WUP) : KIN(I_WGATE)) + ((size_t)(layer * NE + e) << 20);
        transpose_item_fp8(W, DM, DM, wup + ((size_t)e << 21), kb * 64, n0, (n0 >> 7) * 256 + half * 128 + (n0 & 127), scr, F.lane_()); }
    else { const int r = it - 16384, e = r >> 9, q = r & 511, kb = q >> 5, nb = q & 31;
        const float* W = KIN(I_WDOWN) + ((size_t)(layer * NE + e) << 20);
        transpose_item_fp8(W, DM, DM, wdn + ((size_t)e << 20), kb * 64, nb * 32, nb * 32, scr, F.lane_()); }
}
__device__ __forceinline__ void moe_convert_tail(const Frame& F, int first_blk, int it0, int it1) {
    if (F.G != 256 || (int)blockIdx.x < first_blk) return;
    const int nw = (256 - first_blk) * 8, w = ((int)blockIdx.x - first_blk) * 8 + F.wave;
    for (int it = it0 + w; it < it1; it += nw) moe_convert_item(F, it);
}
__device__ __forceinline__ void topk_convert_phase(const Frame& F, const Args& a, int layer, bool with_ctx, const float* affL, const float* affC, int* rowlist, float* gl, int* slotmap, const unsigned char* HL8, unsigned char* XG, int q0, int q1, int q2) {
    const int RE = with_ctx ? (REL + REC) : REL;
    const int nunits = with_ctx ? 256 : 128;
    PB(PT_SUB_TOPKU)
    for (int u = blockIdx.x; u < nunits; u += F.G) {
        if (u < 128) { const int b = u >> 4, e = u & 15; topk_unit(F, affL + ((size_t)(b * NE + e) << 12), SEQ, CAPL, e, e * RE + b * CAPL, b * SEQ, rowlist, gl, slotmap, HL8, XG); }
        else { const int v = u - 128, b = v >> 4, e = v & 15; topk_unit(F, affC + ((size_t)(b * NE + e) << 8), CTXL, CAPC, e, e * RE + REL + b * CAPC, NLAT + b * CTXL, rowlist, gl, slotmap, HL8, XG); }
        __syncthreads();
    }
    __syncthreads();
    PE(PT_SUB_TOPKU)
    const bool deal = F.G == 256;
    const int slow = blockIdx.x < 128, wv = (blockIdx.x & 127) * 8 + F.wave;
    const unsigned it_first = (unsigned)((deal && slow) ? q1 : q0), it_end = (unsigned)((deal && !slow) ? q1 : q2);
    for (unsigned it0 = it_first + (deal ? 0u : (unsigned)F.gw); it0 < it_end; it0 += deal ? (slow ? 1024u : 2048u) : (unsigned)F.NGW) {
        unsigned it = it0;
        if (deal) { if (slow) it = it0 + wv; else { it = it0 + 2 * wv; } }
        for (int rep = 0; rep < ((deal && !slow) ? 2 : 1); ++rep, ++it) if (it < it_end) moe_convert_item(F, (int)it);
    }
}

__device__ __forceinline__ void combine_phase(const Frame& F, bf16_t* lat, int nrows, const bf16_t* YS, const int* slotmap, const float* gl, const float* modl,
                                              bool final_layer, float* out, const float* gnext, const float* modnext, bf16_t* hl) {
    LAS float* At = (LAS float*)F.lds; LAS float* Bt = At + 9 * DM; LAS float* Gt = Bt + 9 * DM;
    __syncthreads();
    if (!final_layer) build_ab(F, At, Bt, gnext, modnext, 0, DM);
    { const int t = F.tid_(); f32x4 gq[5];
#pragma unroll
      for (int it = 0; it < 5; ++it) { const int i4 = t + 512 * it, m = i4 >> 8, col = (i4 & 255) * 4; gq[it] = (i4 < 9 * DM / 4) ? *(const f32x4*)(modl + (size_t)m * MODW + 5 * DM + col) : (f32x4){0.f, 0.f, 0.f, 0.f}; }
#pragma unroll
      for (int it = 0; it < 5; ++it) { const int i4 = t + 512 * it, m = i4 >> 8, col = (i4 & 255) * 4; if (i4 < 9 * DM / 4) *(LAS f32x4*)(Gt + m * DM + col) = gq[it] * 0.0625f; } }
    __syncthreads();
    const int lane = F.lane_(), l = lane & 15, rg = lane >> 4;
    for (int qd = F.gw; qd < nrows / 4; qd += F.NGW) {
        const int row = 4 * qd + rg, midx = row < NLAT ? (row >> 12) : 8;
        const int mypos = slotmap[row * NE + l];
        const float myg = mypos >= 0 ? gl[mypos] : 0.f;
        f32x4 v[16]; rowq_load_bf(lat + (size_t)row * DM, l, v);
        f32x4 acc[16];
#pragma unroll
        for (int i = 0; i < 16; ++i) acc[i] = (f32x4){0.f, 0.f, 0.f, 0.f};
        unsigned m16 = (unsigned)((__ballot(mypos >= 0) >> (16 * rg)) & 0xffffull);
        while (__any(m16 != 0u)) {
            const int e = m16 ? (__builtin_ctz(m16)) : 0; const bool act = m16 != 0u; m16 &= m16 - 1u;
            const int pos = __shfl(mypos, rg * 16 + e); const float ge = __shfl(myg, rg * 16 + e);
            if (act) { const u32x2* yr = (const u32x2*)((const unsigned char*)YS + (size_t)pos * DM);
                u32x2 w[8];
#pragma unroll
                for (int j = 0; j < 8; ++j) w[j] = yr[l + 16 * j];
#pragma unroll
                for (int j = 0; j < 8; ++j) { const f32x2 a0 = __builtin_amdgcn_cvt_pk_f32_fp8((int)w[j].x, false), a1 = __builtin_amdgcn_cvt_pk_f32_fp8((int)w[j].x, true),
                                                          a2 = __builtin_amdgcn_cvt_pk_f32_fp8((int)w[j].y, false), a3 = __builtin_amdgcn_cvt_pk_f32_fp8((int)w[j].y, true);
                    acc[2 * j] += (f32x4){a0.x, a0.y, a1.x, a1.y} * ge; acc[2 * j + 1] += (f32x4){a2.x, a2.y, a3.x, a3.y} * ge; } }
        }
        float ss = 0.f;
#pragma unroll
        for (int j = 0; j < 8; ++j)
#pragma unroll
            for (int h = 0; h < 2; ++h) { const f32x4 g2 = *(const LAS f32x4*)(Gt + midx * DM + 8 * (l + 16 * j) + 4 * h);
                const f32x4 x = v[2 * j + h] + g2 * acc[2 * j + h]; v[2 * j + h] = x; ss += (x.x * x.x + x.y * x.y) + (x.z * x.z + x.w * x.w); }
        if (final_layer) { float* orow = out + (size_t)row * DM;
#pragma unroll
            for (int j = 0; j < 8; ++j) { f32x4* p = (f32x4*)orow + 2 * (l + 16 * j); p[0] = v[2 * j]; p[1] = v[2 * j + 1]; }
        } else { u32x4* orow = (u32x4*)(lat + (size_t)row * DM);
#pragma unroll
            for (int j = 0; j < 8; ++j) { u32x4 w; w.x = pk2(v[2 * j].x, v[2 * j].y); w.y = pk2(v[2 * j].z, v[2 * j].w); w.z = pk2(v[2 * j + 1].x, v[2 * j + 1].y); w.w = pk2(v[2 * j + 1].z, v[2 * j + 1].w); orow[l + 16 * j] = w; }
        }
        if (!final_layer) rowq_norm_store(v, ss, At, Bt, midx, l, hl + (size_t)row * DM);
    }
}

__device__ __forceinline__ void attn_prep_phase(const Frame& F, bf16_t* U, const float* qg, const float* kg, bf16_t* Kb, bf16_t* Vb) {
    LAS f32x2* T = (LAS f32x2*)F.lds;
    __syncthreads();
    for (int idx = F.tid_(); idx < 2048; idx += 512) { const int pos = idx >> 5, f = idx & 31; float s, c; sincosf((float)pos * exp2f(-(float)f * (13.287712379549449f / 32.0f)), &s, &c); T[idx] = (f32x2){c, s}; }
    __syncthreads();
    const int lane = F.lane_(), l = lane & 15, rg = lane >> 4, blk = l >> 3, sub = l & 7, e0 = blk * 64 + sub * 4;
    float gq[8], gk[8];
#pragma unroll
    for (int j = 0; j < 4; ++j) { gq[j] = qg[e0 + j]; gq[4 + j] = qg[e0 + 32 + j]; gk[j] = kg[e0 + j]; gk[4 + j] = kg[e0 + 32 + j]; }
    FOR_ITEMS(qd, MALL / 4) {
        const int row = 4 * qd + rg; const bool lat = (4 * qd) < NLAT;
        bf16_t* ur = U + (size_t)row * 1536;
        int b, t; if (lat) { b = row >> 12; t = row & (SEQ - 1); } else { b = (row - NLAT) >> 8; t = (row - NLAT) & (CTXL - 1); }
        const size_t krow = (size_t)(b * (CTXL + SEQ) + (lat ? CTXL + t : t)) * 256;
        u32x2 xlo[12], xhi[12];
#pragma unroll
        for (int h = 0; h < 12; ++h) { if (lat || h >= 8) { xlo[h] = *(const u32x2*)(ur + h * 128 + e0); xhi[h] = *(const u32x2*)(ur + h * 128 + e0 + 32); } }
        f32x2 cs[4];
        if (lat) { const int pos = blk ? (t & 63) : (t >> 6);
#pragma unroll
            for (int j = 0; j < 4; ++j) cs[j] = T[pos * 32 + sub * 4 + j]; }
#pragma unroll
        for (int h = 0; h < 10; ++h) {
            if (!lat && h < 8) continue;
            float x[8] = {bf_lo(xlo[h].x), bf_hi(xlo[h].x), bf_lo(xlo[h].y), bf_hi(xlo[h].y), bf_lo(xhi[h].x), bf_hi(xhi[h].x), bf_lo(xhi[h].y), bf_hi(xhi[h].y)};
            float ss = 0.f;
#pragma unroll
            for (int j = 0; j < 8; ++j) ss += x[j] * x[j];
            const float rstd = 1.0f / sqrtf(red16(ss) * (1.0f / 128.0f) + EPS);
#pragma unroll
            for (int j = 0; j < 8; ++j) x[j] = x[j] * rstd * (h < 8 ? gq[j] : gk[j]);
            if (lat) {
#pragma unroll
                for (int j = 0; j < 4; ++j) { const float lo = x[j], hi = x[4 + j]; x[j] = lo * cs[j].x - hi * cs[j].y; x[4 + j] = hi * cs[j].x + lo * cs[j].y; } }
            u32x2 olo, ohi; olo.x = pk2(x[0], x[1]); olo.y = pk2(x[2], x[3]); ohi.x = pk2(x[4], x[5]); ohi.y = pk2(x[6], x[7]);
            if (h < 8) { *(u32x2*)(ur + h * 128 + e0) = olo; *(u32x2*)(ur + h * 128 + e0 + 32) = ohi; }
            else { *(u32x2*)(Kb + krow + (h - 8) * 128 + e0) = olo; *(u32x2*)(Kb + krow + (h - 8) * 128 + e0 + 32) = ohi; }
        }
#pragma unroll
        for (int h = 0; h < 2; ++h) { *(u32x2*)(Vb + krow + h * 128 + e0) = xlo[10 + h]; *(u32x2*)(Vb + krow + h * 128 + e0 + 32) = xhi[10 + h]; }
    }
}
__device__ __forceinline__ void attn_phase(const Frame& F, const bf16_t* U, const bf16_t* Kb, const bf16_t* Vb, bf16_t* Z) {
    for (int i = 0; i < 1024; ++i) {
        int u;
        if (F.G == 256) { if (i >= 4) break; u = (blockIdx.x & 7) * 128 + i * 32 + (blockIdx.x >> 3); }
        else { u = blockIdx.x + i * F.G; if (u >= 1024) break; }
        const int pair = u >> 6, within = u & 63, g = within >> 4, qb = within & 15, b = pair >> 1, kvh = pair & 1, h = kvh * 4 + g;
        att::attn_dense_body(U + (size_t)(b * SEQ + qb * 256) * 1536 + h * 128, Kb + (size_t)b * (CTXL + SEQ) * 256 + kvh * 128, Vb + (size_t)b * (CTXL + SEQ) * 256 + kvh * 128,
                             Z + (size_t)(b * SEQ + qb * 256) * DM + h * 128, CTXL + SEQ, (char*)((unsigned char*)F.lds));
        __syncthreads();
    }
}


constexpr float HY_DLO = -3.0701134573253944f, HY_DHI = -15.350567286626972f;
__device__ __forceinline__ void p0_hyena_tables(const Frame& F, const Args& a) {
    float* a2L = (float*)(KWS + WS_A2); float* a2C = (float*)(KWS + WS_A2C); f32x2* tw = (f32x2*)(KWS + WS_TW);
    const float* w1 = KIN(I_HYFW1); const float* b1 = KIN(I_HYFB1); const float* w2 = KIN(I_HYFW2); const float* b2 = KIN(I_HYFB2); const float* fr = KIN(I_HYFREQ);
    const int j = F.lane_(); const float fj = fr[j];
    for (int item = F.gw; item < SEQ + CTXL; item += F.NGW) {
        const int L = item < SEQ ? SEQ : CTXL, lag = item < SEQ ? item : item - SEQ;
        const float t = (float)lag / (float)(L - 1);
        float acc = b1[j] + t * w1[j];
        const float base = (6.283185307179586f / (float)L) * (float)lag;
#pragma unroll 4
        for (int k = 0; k < 16; ++k) { const float band = 1e-4f + (float)k * ((15.0f - 1e-4f) / 15.0f); float s, c; sincosf(base * band, &s, &c);
            acc += c * w1[(1 + k) * 64 + j] - s * w1[(17 + k) * 64 + j]; }
        const float a1 = sinf(fj * acc);
        float acc2 = b2[j];
#pragma unroll 8
        for (int i = 0; i < 64; ++i) acc2 += __shfl(a1, i) * w2[i * 64 + j];
        const float a2 = sinf(fj * acc2);
        (item < SEQ ? a2L : a2C)[(size_t)lag * 64 + j] = a2;
    }
    for (int k = blockIdx.x * 512 + F.tid_(); k < 2048; k += F.G * 512) { float s, c; sincospif((float)k * (1.0f / 4096.0f), &s, &c); tw[k] = (f32x2){c, -s}; }
}


__device__ __forceinline__ void hy_filter_table_phase(const Frame& F, const Args& a) {
    LAS float* a2t = (LAS float*)F.lds;
    LAS float* w3t = (LAS float*)(F.lds + 16640);
    const float* w3 = KIN(I_HYFW3);
    float* HT = (float*)(KWS + WS_HT); float* HTC = (float*)(KWS + WS_HTC);
    const int tid = F.tid_(), lane = F.lane_(), wave = F.wave;
    for (int tile = blockIdx.x; tile < 68 * 16; tile += F.G) {
        const int lt = tile >> 4, ct = tile & 15, col0 = ct * 256;
        const bool isL = lt < 64; const int L = isL ? SEQ : CTXL, lag0 = isL ? lt * 64 : (lt - 64) * 64;
        const float* a2 = isL ? (const float*)(KWS + WS_A2) : (const float*)(KWS + WS_A2C);
        __syncthreads();
        { f32x4 av4[2], wv4[8];
#pragma unroll
          for (int it = 0; it < 2; ++it) av4[it] = *(const f32x4*)(a2 + (size_t)lag0 * 64 + 4 * (tid + 512 * it));
#pragma unroll
          for (int it = 0; it < 8; ++it) { const int i4 = tid + 512 * it, k = i4 >> 6, j4 = (i4 & 63) * 4; wv4[it] = *(const f32x4*)(w3 + (size_t)k * 4096 + col0 + j4); }
#pragma unroll
          for (int it = 0; it < 2; ++it) { const int i4 = tid + 512 * it, lg = i4 >> 4, k = (i4 & 15) * 4; a2t[k * 65 + lg] = av4[it].x; a2t[(k + 1) * 65 + lg] = av4[it].y; a2t[(k + 2) * 65 + lg] = av4[it].z; a2t[(k + 3) * 65 + lg] = av4[it].w; }
#pragma unroll
          for (int it = 0; it < 8; ++it) *(LAS f32x4*)(w3t + 4 * (tid + 512 * it)) = wv4[it]; }
        __syncthreads();
        const int mi = lane & 15, mq = lane >> 4, ls = wave & 3, cs0 = (wave >> 2) * 8;
        float av[16];
#pragma unroll
        for (int s = 0; s < 16; ++s) av[s] = a2t[(16 * mq + s) * 65 + 16 * ls + mi];
        const int dir = col0 >> 11, o = (col0 >> 10) & 1;
        const int lagb = lag0 + 16 * ls + 4 * mq;
#pragma unroll 2
        for (int cs = 0; cs < 8; ++cs) {
            f32x4 accA = (f32x4){0.f, 0.f, 0.f, 0.f}, accB = (f32x4){0.f, 0.f, 0.f, 0.f};
            const LAS float* wp = w3t + (16 * mq) * 256 + (cs0 + cs) * 16 + mi;
#pragma unroll
            for (int s = 0; s < 16; s += 2) { accA = __builtin_amdgcn_mfma_f32_16x16x4f32(av[s], wp[s * 256], accA, 0, 0, 0); accB = __builtin_amdgcn_mfma_f32_16x16x4f32(av[s + 1], wp[(s + 1) * 256], accB, 0, 0, 0); }
            const f32x4 acc = accA + accB;
            const int c = (col0 & 1023) + (cs0 + cs) * 16 + mi; const float delta = fabsf(HY_DLO + (float)c * ((HY_DHI - HY_DLO) / 1023.0f));
            float* hb = isL ? HT + ((size_t)(o * DM + c) << 13) : HTC + ((size_t)(o * DM + c) << 9);
#pragma unroll
            for (int r = 0; r < 4; ++r) { const int lag = lagb + r; const float v = acc[r] * __expf(-((float)lag / (float)(L - 1)) * delta);
                if (dir == 0) hb[lag] = v; else if (lag > 0) hb[2 * L - lag] = v; }
        }
    }
}

__device__ __forceinline__ void hy_dwconv_phase(const Frame& F, const bf16_t* U, const float* convw, bf16_t* XTL, bf16_t* XTC) {
    LAS unsigned* tile2 = (LAS unsigned*)(F.lds + F.wave * 16896);
    const int lane = F.lane_(), rr = lane >> 3, cq = lane & 7;
    constexpr int NITEMS = (MALL / 64) * 24;
    FOR_ITEMS(it, NITEMS) {
        const int rb = it / 24, cb = it - rb * 24, r0 = rb * 64, ch0 = cb * 128;
        int b, pos0, slen; if (r0 < NLAT) { b = r0 >> 12; pos0 = r0 & (SEQ - 1); slen = SEQ; } else { const int rc = r0 - NLAT; b = rc >> 8; pos0 = rc & (CTXL - 1); slen = CTXL; }
        const bf16_t* up = U + (size_t)r0 * 3072 + ch0 + 2 * lane;
        unsigned x[66];
#pragma unroll
        for (int i = 0; i < 66; ++i) { const bool ok = (i == 0) ? (pos0 > 0) : ((i == 65) ? (pos0 + 64 < slen) : true); x[i] = ok ? *(const unsigned*)(up + (ptrdiff_t)(i - 1) * 3072) : 0u; }
        const float* wp = convw + ch0 + 2 * lane;
        const float w0a = wp[0], w0b = wp[1], w1a = wp[3072], w1b = wp[3073], w2a = wp[6144], w2b = wp[6145];
#pragma unroll
        for (int t = 0; t < 64; t += 2) {
            const float a0 = w0a * bf_lo(x[t]) + w1a * bf_lo(x[t + 1]) + w2a * bf_lo(x[t + 2]), a1 = w0a * bf_lo(x[t + 1]) + w1a * bf_lo(x[t + 2]) + w2a * bf_lo(x[t + 3]);
            const float b0 = w0b * bf_hi(x[t]) + w1b * bf_hi(x[t + 1]) + w2b * bf_hi(x[t + 2]), b1 = w0b * bf_hi(x[t + 1]) + w1b * bf_hi(x[t + 2]) + w2b * bf_hi(x[t + 3]);
            tile2[(2 * lane) * 33 + (t >> 1)] = pk2(a0, a1); tile2[(2 * lane + 1) * 33 + (t >> 1)] = pk2(b0, b1); }
        LDS_WAIT(); asm volatile("" ::: "memory");
        const int part = ch0 >> 10, c0 = ch0 & 1023;
        bf16_t* ob = (r0 < NLAT) ? XTL + ((size_t)((part * NB + b) * DM + c0) << 12) + pos0 : XTC + ((size_t)((part * NB + b) * DM + c0) << 8) + pos0;
#pragma unroll
        for (int g = 0; g < 16; ++g) { const int c = g * 8 + rr; u32x4 o; const LAS unsigned* sp = tile2 + c * 33 + cq * 4; o.x = sp[0]; o.y = sp[1]; o.z = sp[2]; o.w = sp[3];
            *(u32x4*)(ob + (size_t)c * slen + cq * 8) = o; }
        LDS_WAIT(); asm volatile("" ::: "memory");
    }
}

__device__ __forceinline__ void hy_untranspose_phase(const Frame& F, const bf16_t* zTL, const bf16_t* zTC, bf16_t* Z) {
    LAS unsigned* tile = (LAS unsigned*)(F.lds + F.wave * 8448);
    const int lane = F.lane_(), hi8 = lane >> 3, lo8 = lane & 7;
    constexpr int NITL = NB * 16 * 64, NITC = NB * 16 * 4;
    FOR_ITEMS(it, NITL + NITC) {
        int b, cb, tb, slen; const bf16_t* src; int rowbase;
        if (it < NITL) { b = it >> 10; cb = (it >> 6) & 15; tb = it & 63; slen = SEQ; src = zTL; rowbase = b * SEQ; }
        else { const int i2 = it - NITL; b = i2 >> 6; cb = (i2 >> 2) & 15; tb = i2 & 3; slen = CTXL; src = zTC; rowbase = NLAT + b * CTXL; }
        const int c0 = cb * 64, t0 = tb * 64;
#pragma unroll
        for (int g = 0; g < 8; ++g) { const int c = g * 8 + hi8;
            const u32x4 v = *(const u32x4*)(src + (size_t)(b * DM + c0 + c) * slen + t0 + lo8 * 8);
            LAS unsigned* tp = tile + c * 33 + lo8 * 4; tp[0] = v.x; tp[1] = v.y; tp[2] = v.z; tp[3] = v.w; }
        LDS_WAIT(); asm volatile("" ::: "memory");
#pragma unroll
        for (int g = 0; g < 8; ++g) { const int t = g * 8 + hi8; unsigned e[8];
#pragma unroll
            for (int i = 0; i < 8; ++i) { const unsigned w = tile[(lo8 * 8 + i) * 33 + (t >> 1)]; e[i] = (t & 1) ? (w >> 16) : (w & 0xffffu); }
            u32x4 o; o.x = e[0] | (e[1] << 16); o.y = e[2] | (e[3] << 16); o.z = e[4] | (e[5] << 16); o.w = e[6] | (e[7] << 16);
            *(u32x4*)(Z + (size_t)(rowbase + t0 + t) * DM + c0 + lo8 * 8) = o; }
        LDS_WAIT(); asm volatile("" ::: "memory");
    }
}

constexpr int FFT_N = 8192;
__device__ __forceinline__ int PX(int i) { return i + (i >> 5); }
__device__ __forceinline__ f32x2 cmul(f32x2 a, f32x2 b) { return (f32x2){a.x * b.x - a.y * b.y, a.x * b.y + a.y * b.x}; }
__device__ __forceinline__ f32x2 cmulc(f32x2 a, f32x2 w) { return (f32x2){a.x * w.x + a.y * w.y, a.y * w.x - a.x * w.y}; }
__device__ __forceinline__ f32x2 twv(const LAS f32x2* TW, int k) { const f32x2 t = TW[k & 2047]; return (k & 2048) ? (f32x2){t.y, -t.x} : t; }
template <int J, bool CONJ> __device__ __forceinline__ f32x2 mulc16(f32x2 a) {
    constexpr float CR[8] = {1.0f, 0.92387953251128674f, 0.70710678118654752f, 0.38268343236508977f, 0.0f, -0.38268343236508977f, -0.70710678118654752f, -0.92387953251128674f};
    constexpr float CI[8] = {0.0f, -0.38268343236508977f, -0.70710678118654752f, -0.92387953251128674f, -1.0f, -0.92387953251128674f, -0.70710678118654752f, -0.38268343236508977f};
    if constexpr (J == 0) return a;
    else if constexpr (J == 4) return CONJ ? (f32x2){-a.y, a.x} : (f32x2){a.y, -a.x};
    else { constexpr float cr = CR[J], ci = CONJ ? -CI[J] : CI[J]; return (f32x2){a.x * cr - a.y * ci, a.x * ci + a.y * cr}; }
}
template <int H, int M, int E, bool INV> __device__ __forceinline__ void bfly(f32x2 (&v)[16]) {
    if constexpr (!(E & H)) { constexpr int J = (E & (H - 1)) << M;
        if constexpr (!INV) { const f32x2 x = v[E], y = v[E + H]; v[E] = x + y; v[E + H] = mulc16<J, false>(x - y); }
        else { const f32x2 x = v[E], y = mulc16<J, true>(v[E + H]); v[E] = x + y; v[E + H] = x - y; } }
}
template <int H, int M, bool INV> __device__ __forceinline__ void stage16(f32x2 (&v)[16]) {
    bfly<H, M, 0, INV>(v); bfly<H, M, 1, INV>(v); bfly<H, M, 2, INV>(v); bfly<H, M, 3, INV>(v); bfly<H, M, 4, INV>(v); bfly<H, M, 5, INV>(v); bfly<H, M, 6, INV>(v); bfly<H, M, 7, INV>(v);
    bfly<H, M, 8, INV>(v); bfly<H, M, 9, INV>(v); bfly<H, M, 10, INV>(v); bfly<H, M, 11, INV>(v); bfly<H, M, 12, INV>(v); bfly<H, M, 13, INV>(v); bfly<H, M, 14, INV>(v); bfly<H, M, 15, INV>(v);
}
template <bool INV> __device__ __forceinline__ void r16(f32x2 (&v)[16], f32x2 b) {
    f32x2 p[16];
    p[1] = b; p[2] = cmul(b, b); p[3] = cmul(p[2], b); p[4] = cmul(p[2], p[2]); p[5] = cmul(p[4], b); p[6] = cmul(p[3], p[3]); p[7] = cmul(p[6], b);
    p[8] = cmul(p[4], p[4]); p[9] = cmul(p[8], b); p[10] = cmul(p[5], p[5]); p[11] = cmul(p[10], b); p[12] = cmul(p[6], p[6]); p[13] = cmul(p[12], b); p[14] = cmul(p[7], p[7]); p[15] = cmul(p[14], b);
    constexpr int REV[16] = {0, 8, 4, 12, 2, 10, 6, 14, 1, 9, 5, 13, 3, 11, 7, 15};
    if constexpr (!INV) {
        stage16<8, 0, false>(v); stage16<4, 1, false>(v); stage16<2, 2, false>(v); stage16<1, 3, false>(v);
#pragma unroll
        for (int e = 1; e < 16; ++e) v[e] = cmul(v[e], p[REV[e]]);
    } else {
#pragma unroll
        for (int e = 1; e < 16; ++e) v[e] = cmulc(v[e], p[REV[e]]);
        stage16<1, 3, true>(v); stage16<2, 2, true>(v); stage16<4, 1, true>(v); stage16<8, 0, true>(v);
    }
}
template <bool INV> __device__ __forceinline__ void fft_pass16(LAS f32x2* X, const LAS f32x2* TW, int ls, int tid) {
    const int lst = ls - 3, pos = tid & ((1 << lst) - 1), g = tid >> lst, ibase = (g << (ls + 1)) + pos;
    f32x2 v[16];
#pragma unroll
    for (int e = 0; e < 16; ++e) v[e] = X[PX(ibase + (e << lst))];
    r16<INV>(v, twv(TW, pos << (12 - ls)));
#pragma unroll
    for (int e = 0; e < 16; ++e) X[PX(ibase + (e << lst))] = v[e];
    __syncthreads();
}

template <int J, bool CONJ> __device__ __forceinline__ f32x2 mulc32(f32x2 a) {
    constexpr float CR[16] = {1.000000000e+00f, 9.807852804e-01f, 9.238795325e-01f, 8.314696123e-01f, 7.071067812e-01f, 5.555702330e-01f, 3.826834324e-01f, 1.950903220e-01f, 6.123233996e-17f, -1.950903220e-01f, -3.826834324e-01f, -5.555702330e-01f, -7.071067812e-01f, -8.314696123e-01f, -9.238795325e-01f, -9.807852804e-01f};
    constexpr float CI[16] = {-0.000000000e+00f, -1.950903220e-01f, -3.826834324e-01f, -5.555702330e-01f, -7.071067812e-01f, -8.314696123e-01f, -9.238795325e-01f, -9.807852804e-01f, -1.000000000e+00f, -9.807852804e-01f, -9.238795325e-01f, -8.314696123e-01f, -7.071067812e-01f, -5.555702330e-01f, -3.826834324e-01f, -1.950903220e-01f};
    if constexpr (J == 0) return a;
    else if constexpr (J == 8) return CONJ ? (f32x2){-a.y, a.x} : (f32x2){a.y, -a.x};
    else { constexpr float cr = CR[J], ci = CONJ ? -CI[J] : CI[J]; return (f32x2){a.x * cr - a.y * ci, a.x * ci + a.y * cr}; }
}
template <int H, int E, bool INV> __device__ __forceinline__ void bfly32(f32x2 (&v)[32]) {
    if constexpr (!(E & H)) { constexpr int J = (E & (H - 1)) * (16 / H);
        if constexpr (!INV) { const f32x2 x = v[E], y = v[E + H]; v[E] = x + y; v[E + H] = mulc32<J, false>(x - y); }
        else { const f32x2 x = v[E], y = mulc32<J, true>(v[E + H]); v[E] = x + y; v[E + H] = x - y; } }
}
template <int H, bool INV> __device__ __forceinline__ void stage32(f32x2 (&v)[32]) {
#define B4(e) bfly32<H, e, INV>(v); bfly32<H, e + 1, INV>(v); bfly32<H, e + 2, INV>(v); bfly32<H, e + 3, INV>(v);
    B4(0) B4(4) B4(8) B4(12) B4(16) B4(20) B4(24) B4(28)
#undef B4
}
__device__ __forceinline__ void fft32_fwd(f32x2 (&v)[32]) { stage32<16, false>(v); stage32<8, false>(v); stage32<4, false>(v); stage32<2, false>(v); stage32<1, false>(v); }
__device__ __forceinline__ void fft32_inv(f32x2 (&v)[32]) { stage32<1, true>(v); stage32<2, true>(v); stage32<4, true>(v); stage32<8, true>(v); stage32<16, true>(v); }
__device__ __forceinline__ float block_sum(float v, LAS float* scr, int lane, int wave) {
    v = wave_sum(v); __syncthreads(); if (lane == 0) scr[wave] = v; __syncthreads();
    float t = 0.f;
#pragma unroll
    for (int w = 0; w < 8; ++w) t += scr[w];
    return t;
}
__device__ __forceinline__ void hy_longconv_phase(const Frame& F, const Args& a, const bf16_t* XTL, bf16_t* z1T, bf16_t* z2T, const bf16_t* XTC, bf16_t* z2Tc) {
    LAS f32x2* W = (LAS f32x2*)F.lds;
    LAS f32x2* HF = (LAS f32x2*)(F.lds + 67584);
    LAS f32x2* TW = (LAS f32x2*)(F.lds + 135168);
    LAS float* wfb = (LAS float*)(F.lds + 151552);
    LAS float* scr = wfb + 128;
    const int tid = F.tid_(), lane = F.lane_(), wave = F.wave;
    const f32x2* twg = (const f32x2*)(KWS + WS_TW);
    for (int k = tid; k < 2048; k += 512) TW[k] = twg[k];
    const float* a2L = (const float*)(KWS + WS_A2); const float* a2C = (const float*)(KWS + WS_A2C);
    const float* w3 = KIN(I_HYFW3); const float* skip = KIN(I_HYSKIP);
    __syncthreads();
    const float* HT = (const float*)(KWS + WS_HT); const float* HTC = (const float*)(KWS + WS_HTC);
    for (int c = blockIdx.x; c < DM; c += F.G) {
        for (int o = 0; o < 2; ++o) {
            __syncthreads();
            PB(PT_SUB_FILT)
            const bf16_t* usrc = o == 0 ? XTL : z1T; const bf16_t* gsrc = XTL + ((size_t)(1 + o) * NB * DM << 12); bf16_t* dst = o == 0 ? z1T : z2T;
            bf16_t pu0[8], pu1[8];
#pragma unroll
            for (int e = 0; e < 8; ++e) { const int t = tid + 512 * e; pu0[e] = usrc[((size_t)c << 12) + t]; pu1[e] = usrc[((size_t)(DM + c) << 12) + t]; }
            f32x2 v[16]; float lsum = 0.f;
            { const float* hp = HT + ((size_t)(o * DM + c) << 13) + tid;
#pragma unroll
                for (int e = 0; e < 16; ++e) { float h = hp[512 * e]; if (e == 8 && tid == 0) h = 0.f; v[e] = (f32x2){h, 0.f}; lsum += fabsf(h); } }
            r16<false>(v, twv(TW, tid));
#pragma unroll
            for (int e = 0; e < 16; ++e) W[PX(tid + 512 * e)] = v[e];
            const float ssum = block_sum(lsum, scr, lane, wave);
            fft_pass16<false>(W, TW, 8, tid);
            const float scale = 1.0f / (ssum * (float)FFT_N);
            if (tid < 256) { f32x2 q[32];
#pragma unroll
                for (int e = 0; e < 32; ++e) q[e] = W[33 * tid + e];
                fft32_fwd(q);
#pragma unroll
                for (int e = 0; e < 32; ++e) HF[33 * tid + e] = q[e] * scale; }
            __syncthreads();
            PE(PT_SUB_FILT)
            const float sk = skip[o * DM + c];
            for (int bp = 0; bp < 4; ++bp) {
                const size_t o0 = (size_t)((2 * bp) * DM + c) << 12, o1 = (size_t)((2 * bp + 1) * DM + c) << 12;
                float ur[8], ui[8];
#pragma unroll
                for (int e = 0; e < 8; ++e) { ur[e] = bf1(pu0[e]); ui[e] = bf1(pu1[e]); v[e] = (f32x2){ur[e], ui[e]}; v[e + 8] = (f32x2){0.f, 0.f}; }
                bf16_t pg0[8], pg1[8];
#pragma unroll
                for (int e = 0; e < 8; ++e) { const int t = tid + 512 * e; pg0[e] = gsrc[o0 + t]; pg1[e] = gsrc[o1 + t]; }
                if (bp < 3) {
#pragma unroll
                    for (int e = 0; e < 8; ++e) { const int t = tid + 512 * e; pu0[e] = usrc[o0 + ((size_t)(2 * DM) << 12) + t]; pu1[e] = usrc[o1 + ((size_t)(2 * DM) << 12) + t]; } }
                r16<false>(v, twv(TW, tid));
#pragma unroll
                for (int e = 0; e < 16; ++e) W[PX(tid + 512 * e)] = v[e];
                __syncthreads();
                fft_pass16<false>(W, TW, 8, tid);
                if (tid < 256) { f32x2 q[32];
#pragma unroll
                    for (int e = 0; e < 32; ++e) q[e] = W[33 * tid + e];
                    fft32_fwd(q);
#pragma unroll
                    for (int e = 0; e < 32; ++e) q[e] = cmul(q[e], HF[33 * tid + e]);
                    fft32_inv(q);
#pragma unroll
                    for (int e = 0; e < 32; ++e) W[33 * tid + e] = q[e]; }
                __syncthreads();
                fft_pass16<true>(W, TW, 8, tid);
#pragma unroll
                for (int e = 0; e < 16; ++e) v[e] = W[PX(tid + 512 * e)];
                r16<true>(v, twv(TW, tid));
#pragma unroll
                for (int e = 0; e < 8; ++e) { const int t = tid + 512 * e;
                    const float r0 = bf1(pg0[e]) * (v[e].x + ur[e] * sk), r1 = bf1(pg1[e]) * (v[e].y + ui[e] * sk);
                    dst[o0 + t] = (bf16_t)f2bf(r0); dst[o1 + t] = (bf16_t)f2bf(r1); }
            }
        }
    }
    PB(PT_SUB_CTX)
    LAS float* ucA = (LAS float*)F.lds;
    LAS float* hf0 = ucA + 2048;
    LAS float* hf1 = hf0 + 512;
    LAS float* ucB = hf1 + 512;
    LAS float* scr2 = scr + 8;
    const int mi = lane & 15, mk = lane >> 4, tA = (2 * wave) * 16, tB = tA + 16;
    for (int c = blockIdx.x; c < DM; c += F.G) {
        __syncthreads();
        for (int idx = tid; idx < 2048; idx += 512) ucA[idx] = bf1(XTC[(size_t)((idx >> 8) * DM + c) * CTXL + (idx & 255)]);
        float l0 = 0.f, l1 = 0.f;
        if (tid < 511) { const int d = tid - 255, si = (d >= 0 ? d : 512 + d); const float h0 = HTC[((size_t)c << 9) + si], h1 = HTC[((size_t)(DM + c) << 9) + si]; hf0[tid] = h0; hf1[tid] = h1; l0 = fabsf(h0); l1 = fabsf(h1); }
        u32x2 gq[2][2];
#pragma unroll
        for (int o = 0; o < 2; ++o)
#pragma unroll
            for (int tt = 0; tt < 2; ++tt) gq[o][tt] = *(const u32x2*)(XTC + (size_t)(((1 + o) * NB + (mi & 7)) * DM + c) * CTXL + (tt ? tB : tA) + 4 * mk);
        l0 = wave_sum(l0); l1 = wave_sum(l1);
        if (lane == 0) { scr[wave] = l0; scr2[wave] = l1; }
        __syncthreads();
        float s0sum = 0.f, s1sum = 0.f;
#pragma unroll
        for (int w = 0; w < 8; ++w) { s0sum += scr[w]; s1sum += scr2[w]; }
        for (int o = 0; o < 2; ++o) {
            const LAS float* us = o ? ucB : ucA; const LAS float* hfull = o ? hf1 : hf0;
            const float rs = 1.0f / (o ? s1sum : s0sum), sk = skip[o * DM + c];
            f32x4 acc0 = (f32x4){0.f, 0.f, 0.f, 0.f}, acc1 = (f32x4){0.f, 0.f, 0.f, 0.f};
            const LAS float* hA = hfull + 255 + tA + mi - mk; const LAS float* hB = hA + 16; const LAS float* ub = us + (mi & 7) * 256 + mk;
#pragma unroll 8
            for (int s0 = 0; s0 < 256; s0 += 4) { const float bv = ub[s0];
                acc0 = __builtin_amdgcn_mfma_f32_16x16x4f32(hA[-s0], bv, acc0, 0, 0, 0); acc1 = __builtin_amdgcn_mfma_f32_16x16x4f32(hB[-s0], bv, acc1, 0, 0, 0); }
            if (mi < 8) {
#pragma unroll
                for (int tt = 0; tt < 2; ++tt) { const int t0 = (tt ? tB : tA) + 4 * mk; const f32x4 y = tt ? acc1 : acc0;
                    const u32x2 gw = o ? gq[1][tt] : gq[0][tt];
                    const float g[4] = {bf_lo(gw.x), bf_hi(gw.x), bf_lo(gw.y), bf_hi(gw.y)};
                    float r[4];
#pragma unroll
                    for (int k = 0; k < 4; ++k) r[k] = g[k] * (y[k] * rs + us[mi * 256 + t0 + k] * sk);
                    if (o == 0) {
#pragma unroll
                        for (int k = 0; k < 4; ++k) ucB[mi * 256 + t0 + k] = bf1((bf16_t)f2bf(r[k]));
                    } else { u32x2 w; w.x = pk2(r[0], r[1]); w.y = pk2(r[2], r[3]); *(u32x2*)(z2Tc + (size_t)(mi * DM + c) * CTXL + t0) = w; } }
            }
            __syncthreads();
        }
    }
    __syncthreads();
    PE(PT_SUB_CTX)
}

__device__ __forceinline__ void copy_rows(const Frame& F, const float* src, float* dst, size_t n4) {
    for (size_t i = (size_t)blockIdx.x * 512 + F.tid_(); i < n4; i += (size_t)F.G * 512) ((f32x4*)dst)[i] = ((const f32x4*)src)[i];
}


constexpr int PH_P0 = 0, PH_N0 = 1, PH_L0 = 2, PH_PER = 12, PH_END = PH_L0 + DEPTH * PH_PER;
#ifndef DBG_LAST
#define DBG_LAST 100
#endif

constexpr int CQ_P0 = 8192;
constexpr int CQ_A0 = CQ_P0 + 5120, CQ_B0 = CQ_A0 + 8960, CQ_T0 = CQ_B0 + 5376;
constexpr int CQ_A1 = CQ_T0 + 5120, CQ_B1 = CQ_A1 + 8960, CQ_T1 = CQ_B1 + 10496;
constexpr int CQ_A2 = CQ_T1 + 11648, CQ_T2F = CQ_A2 + 12288, CQ_T2 = CQ_T2F + 3968;
constexpr int CQ_T3F = CQ_T2 + 12288, CQ_T3 = 4 * MOE_QL;
static_assert(CQ_T0 >= MOE_QL && CQ_T1 >= 2 * MOE_QL && CQ_T2 >= 3 * MOE_QL && CQ_T3F <= CQ_T3, "conversion schedule");
constexpr int CQ_IN[4][3]  = {{96, CQ_P0, CQ_A0}, {96, CQ_T0, CQ_A1}, {48, CQ_T1, CQ_A2}, {256, 0, 0}};
constexpr int CQ_OUT[4][3] = {{32, CQ_A0, CQ_B0}, {32, CQ_A1, CQ_B1}, {256, 0, 0}, {256, 0, 0}};
constexpr int CQ_UP[4][3]  = {{256, 0, 0}, {256, 0, 0}, {256, 0, 0}, {256, 0, 0}};
constexpr int CQ_DN[4][3]  = {{256, 0, 0}, {256, 0, 0}, {256, 0, 0}, {256, 0, 0}};
constexpr int CQ_TOPK[4][3] = {{CQ_B0, CQ_T0, CQ_T0}, {CQ_B1, CQ_T1, CQ_T1}, {CQ_A2, CQ_T2F, CQ_T2}, {CQ_T2, CQ_T3F, CQ_T3}};
template <int layer>
__device__ __forceinline__ void run_layer(const Frame& F, const Args& a, const XcdBarrier& bar, const int lo, const int hi) {
    float* modv = (float*)(KWS + WS_MODV);
    bf16_t* LAT = (bf16_t*)(KWS + WS_LAT);
    bf16_t* HL = (bf16_t*)(KWS + WS_HL);
    bf16_t* U = (bf16_t*)(KWS + WS_U);
    bf16_t* Z = (bf16_t*)(KWS + WS_Z);
    bf16_t* wm = (bf16_t*)(KWS + WS_WMIX);
    bf16_t* HB = (bf16_t*)(KWS + WS_H);
    bf16_t* YS = (bf16_t*)(KWS + WS_YS);
    bf16_t* XTL = (bf16_t*)(KWS + WS_H); bf16_t* XTC = (bf16_t*)(KWS + WS_H + 192 * MiB);
    bf16_t* Z1T = (bf16_t*)(KWS + WS_U); bf16_t* Z2T = (bf16_t*)(KWS + WS_U + 68 * MiB); bf16_t* Z2TC = (bf16_t*)(KWS + WS_U + 136 * MiB);
    bf16_t* KB = (bf16_t*)(KWS + WS_H); bf16_t* VB = (bf16_t*)(KWS + WS_H + 17 * MiB);
    float* affL = (float*)(KWS + WS_AFF); float* affC = (float*)(KWS + WS_AFFC);
    int* rowlist = (int*)(KWS + WS_ROWL); float* gl = (float*)(KWS + WS_GL); int* slotmap = (int*)(KWS + WS_SLOT);
#define IN(k) (lo <= (k) && (k) < hi)
#define SEAM(k) do { if ((k) + 1 < hi) { unsigned long long _st0 = 0; const bool _sp = ((PROBE_MASK >> 20) & 1u) || ((PROBE_SEAMMASK >> _ptype) & 1u); if ((PROBE_MASK >> 21) & 1u) xcd_barrier(bar); if (_sp) _st0 = wall_clock64(); xcd_barrier(bar); if (_sp) { if (threadIdx.x == 0) { volatile LAS unsigned long long* _pa = (volatile LAS unsigned long long*)(F.lds + LDS_MISC + 128); *_pa = *_pa + (wall_clock64() - _st0); } } } } while (0)
        constexpr int pb = PH_L0 + layer * PH_PER;
        if (pb >= hi) return;
        constexpr int kind = layer % 3, jj = layer / 3;
        constexpr bool need_ctx = layer <= 2, upd_ctx = layer < 2;
        constexpr int m_in = need_ctx ? MALL : NLAT, m_out = upd_ctx ? MALL : NLAT;
        const float* modl = modv + (size_t)layer * 9 * MODW;
        const void* baseL = layer == 0 ? (const void*)KIN(I_X) : (const void*)LAT;
        const void* baseC = layer == 0 ? (const void*)KIN(I_CTX) : (const void*)(LAT + (size_t)NLAT * DM);
        const bf16_t* w_in = kind == 0 ? wm + WM_SC_IN + (size_t)jj * 3072 * 1024 : (kind == 1 ? wm + WM_HY_IN : wm + WM_AT_QKV);
        const bf16_t* w_out = kind == 0 ? wm + WM_SC_OUT + (size_t)jj * 1024 * 1024 : (kind == 1 ? wm + WM_HY_OUT : wm + WM_AT_O);
        constexpr int n_in = kind == 2 ? 1536 : 3072;
        if (IN(pb + 0)) { PB(PT_INGEMM)
            if constexpr (CQ_IN[layer][0] < 256) { moe_convert_tail(F, CQ_IN[layer][0], CQ_IN[layer][1], CQ_IN[layer][2]); __syncthreads(); }
            pg8::Gemm g{HL, w_in, m_in, n_in, DM, 1 << 20, nullptr}; pg8::StaticOrder S; S.init(m_in, n_in, F.G, (int)blockIdx.x);
            if constexpr (kind == 0) { pg8::EpiScIn E{U}; pg8::gemm_phase<pg8::EpiScIn, pg8::StaticOrder, false>(F.lds, g, S, E); }
            else { pg8::EpiBf16 E{U, n_in};
            pg8::gemm_phase<pg8::EpiBf16, pg8::StaticOrder, false>(F.lds, g, S, E); }
            SEAM(pb + 0); PE(PT_INGEMM)
        }
        if (IN(pb + 1)) { PB(kind == 0 ? PT_SCCONV : (kind == 1 ? PT_HYDW : PT_ATPREP))
            if constexpr (kind == 0) sc_conv_phase(F, U, KIN(I_SCCONV) + (size_t)jj * 3 * DM, Z, m_out);
            if constexpr (kind == 2) attn_prep_phase(F, U, KIN(I_ATQG), KIN(I_ATKG), KB, VB);
            if constexpr (kind == 1) hy_dwconv_phase(F, U, KIN(I_HYCONV), XTL, XTC);
            SEAM(pb + 1); PE(kind == 0 ? PT_SCCONV : (kind == 1 ? PT_HYDW : PT_ATPREP))
        }
        if constexpr (kind != 0) if (IN(pb + 2)) { PB(kind == 1 ? PT_HYLC : PT_ATTN)
            if constexpr (kind == 2) attn_phase(F, U, KB, VB, Z);
            if constexpr (kind == 1) hy_longconv_phase(F, a, XTL, Z1T, Z2T, XTC, Z2TC);
            SEAM(pb + 2); PE(kind == 1 ? PT_HYLC : PT_ATTN)
        }
        if constexpr (kind == 1) if (IN(pb + 3)) { PB(PT_HYUT) hy_untranspose_phase(F, Z2T, Z2TC, Z); SEAM(pb + 3); PE(PT_HYUT) }
        if (IN(pb + 4)) { PB(PT_OUTGEMM)
            if constexpr (CQ_OUT[layer][0] < 256) { moe_convert_tail(F, CQ_OUT[layer][0], CQ_OUT[layer][1], CQ_OUT[layer][2]); __syncthreads(); }
            pg8::Gemm g{Z, w_out, m_out, DM, DM, 1 << 20, nullptr}; pg8::StaticOrder S; S.init(m_out, DM, F.G, (int)blockIdx.x);
            pg8::EpiRes<layer == 0> E{baseL, baseC, LAT, modl + 2 * DM};
            pg8::gemm_phase<pg8::EpiRes<layer == 0>, pg8::StaticOrder, false>(F.lds, g, S, E);
            SEAM(pb + 4); PE(PT_OUTGEMM)
        }
        if (IN(pb + 5)) { PB(PT_NORM2)
            norm2_router_phase(F, LAT, m_out, KIN(I_NORMG) + (size_t)(layer * 2 + 1) * DM, modl, HL, KIN(I_ROUTER) + (size_t)layer * DM * NE, affL, affC);
            SEAM(pb + 5); PE(PT_NORM2)
        }
        if (IN(pb + 6)) { PB(PT_TOPK) topk_convert_phase(F, a, layer, upd_ctx, affL, affC, rowlist, gl, slotmap, (const unsigned char*)HL, (unsigned char*)Z, F.G == 256 ? CQ_TOPK[layer][0] : layer * MOE_QL, F.G == 256 ? CQ_TOPK[layer][1] : (layer + 1) * MOE_QL, F.G == 256 ? CQ_TOPK[layer][2] : (layer + 1) * MOE_QL); SEAM(pb + 6); PE(PT_TOPK) }
        constexpr int RE = upd_ctx ? (REL + REC) : REL;
        if (IN(pb + 7)) { PB(PT_MOEUP)
            if constexpr (CQ_UP[layer][0] < 256) { moe_convert_tail(F, CQ_UP[layer][0], CQ_UP[layer][1], CQ_UP[layer][2]); __syncthreads(); }
            pg8::Gemm g{HL, KWS + moe_wup_off(layer == 3 ? 0 : layer), NE * RE, 2048, DM, RE / 256, rowlist}; pg8::StaticOrder S; S.init(NE * RE, 2048, F.G, (int)blockIdx.x);
            pg8::EpiMoeUp E{(unsigned char*)HB};
            pg8::gemm_phase<pg8::EpiMoeUp, pg8::StaticOrder, true, 1>(F.lds, g, S, E);
            SEAM(pb + 7); PE(PT_MOEUP)
        }
        if (IN(pb + 8)) { PB(PT_MOEDN)
            if constexpr (CQ_DN[layer][0] < 256) { moe_convert_tail(F, CQ_DN[layer][0], CQ_DN[layer][1], CQ_DN[layer][2]); __syncthreads(); }
            pg8::Gemm g{HB, KWS + moe_wdn_off(layer == 3 ? 0 : layer), NE * RE, DM, DM, RE / 256, nullptr}; pg8::StaticOrder S; S.init(NE * RE, DM, F.G, (int)blockIdx.x);
            pg8::EpiMoeDown E{(unsigned char*)YS, gl};
            pg8::gemm_phase<pg8::EpiMoeDown, pg8::StaticOrder, false, 1>(F.lds, g, S, E);
            SEAM(pb + 8); PE(PT_MOEDN)
        }
        if (IN(pb + 9)) { PB(PT_COMB)
            const bool fin = layer == DEPTH - 1;
            combine_phase(F, LAT, m_out, YS, slotmap, gl, modl, fin, KOUT, KIN(I_NORMG) + (size_t)((layer + 1) * 2) * DM, modv + (size_t)(layer + 1) * 9 * MODW, HL);
            SEAM(pb + 9); PE(PT_COMB)
        }
    #undef IN
#undef SEAM
}

__global__ void __launch_bounds__(512, 2) fwd_kernel(Args a) {
    extern __shared__ __attribute__((aligned(16))) unsigned char lds_raw[];
    Frame F;
    F.lds = (LAS unsigned char*)lds_raw;
    F.wave = __builtin_amdgcn_readfirstlane((int)threadIdx.x >> 6);
    F.G = gridDim.x; F.gw = blockIdx.x * 8 + F.wave; F.NGW = F.G * 8;
    volatile LAS unsigned* MISC = (volatile LAS unsigned*)(F.lds + LDS_MISC);
    for (int u = F.tid_(); u < (LDS_BYTES - LDS_MISC) / 4; u += 512) MISC[u] = 0u;
    __syncthreads();
    unsigned* ctl = (unsigned*)(KWS + WS_CTL);
    const int lo = a.ph_lo, hi = a.ph_hi;
    const bool multi = (hi - lo) > 1;
    XcdBarrier bar; bar.bar = ctl + CW_BAR; bar.x = 0; bar.st = nullptr;
    if (multi) bar = xcd_barrier_post(ctl + CW_BAR, MISC + 8);
#define IN(k) (lo <= (k) && (k) < hi)
#define SEAM(k) do { if ((k) + 1 < hi) { unsigned long long _st0 = 0; const bool _sp = ((PROBE_MASK >> 20) & 1u) || ((PROBE_SEAMMASK >> _ptype) & 1u); if ((PROBE_MASK >> 21) & 1u) xcd_barrier(bar); if (_sp) _st0 = wall_clock64(); xcd_barrier(bar); if (_sp) { if (threadIdx.x == 0) { volatile LAS unsigned long long* _pa = (volatile LAS unsigned long long*)(F.lds + LDS_MISC + 128); *_pa = *_pa + (wall_clock64() - _st0); } } } } while (0)

    float* modv = (float*)(KWS + WS_MODV);
    bf16_t* LAT = (bf16_t*)(KWS + WS_LAT);
    bf16_t* HL = (bf16_t*)(KWS + WS_HL);
    bf16_t* U = (bf16_t*)(KWS + WS_U);
    bf16_t* Z = (bf16_t*)(KWS + WS_Z);
    bf16_t* wm = (bf16_t*)(KWS + WS_WMIX);
    bf16_t* HB = (bf16_t*)(KWS + WS_H);
    bf16_t* YS = (bf16_t*)(KWS + WS_YS);
    bf16_t* XTL = (bf16_t*)(KWS + WS_H); bf16_t* XTC = (bf16_t*)(KWS + WS_H + 192 * MiB);
    bf16_t* Z1T = (bf16_t*)(KWS + WS_U); bf16_t* Z2T = (bf16_t*)(KWS + WS_U + 68 * MiB); bf16_t* Z2TC = (bf16_t*)(KWS + WS_U + 136 * MiB);
    bf16_t* KB = (bf16_t*)(KWS + WS_H); bf16_t* VB = (bf16_t*)(KWS + WS_H + 17 * MiB);
    float* affL = (float*)(KWS + WS_AFF); float* affC = (float*)(KWS + WS_AFFC);
    int* rowlist = (int*)(KWS + WS_ROWL); float* gl = (float*)(KWS + WS_GL); int* slotmap = (int*)(KWS + WS_SLOT);

    if (IN(PH_P0)) { PB(PT_P0) p0_mod(F, a); __syncthreads(); p0_convert_mixers(F, a); p0_hyena_tables(F, a); __syncthreads(); moe_convert_tail(F, 128, 0, CQ_P0); SEAM(PH_P0); PE(PT_P0) }
    if (IN(PH_N0)) { PB(PT_N1) norm1_phase(F, KIN(I_X), KIN(I_CTX), MALL, KIN(I_NORMG), modv, HL); hy_filter_table_phase(F, a); SEAM(PH_N0); PE(PT_N1) }

    if (DBG_LAST >= PH_L0 + 0 * PH_PER) run_layer<0>(F, a, bar, lo, hi);
    if (DBG_LAST >= PH_L0 + 1 * PH_PER) run_layer<1>(F, a, bar, lo, hi);
    if (DBG_LAST >= PH_L0 + 2 * PH_PER) run_layer<2>(F, a, bar, lo, hi);
    if (DBG_LAST >= PH_L0 + 3 * PH_PER) run_layer<3>(F, a, bar, lo, hi);
    if ((PROBE_MASK >> 26) & 1u) { if (xb_xcc_id() != (blockIdx.x & 7u)) { const unsigned long long t0 = wall_clock64(); while (wall_clock64() - t0 < 50000ull) __builtin_amdgcn_s_sleep(8); } }
    if (PROBE_MASK != 0u) { __syncthreads(); const unsigned long long tot = *(volatile LAS unsigned long long*)(F.lds + LDS_MISC + 128) * (unsigned long long)PROBE_K;
        const unsigned long long t0 = wall_clock64(); while (wall_clock64() - t0 < tot) __builtin_amdgcn_s_sleep(8); }
#undef IN
#undef SEAM
}

#ifndef ONE_LAUNCH
#define ONE_LAUNCH 1
#endif
extern "C" void kernel_launch(void* const* d_in, const int* in_sizes, int n_in, void* d_out, int out_size, void* d_ws, size_t ws_size, hipStream_t stream) {
    static int grid = 0;
    if (grid == 0) {
        if (n_in != 28 || out_size != NLAT * DM || ws_size < WS_END + 48 * MiB) { fprintf(stderr, "kernel_launch: unexpected shapes n_in %d out %d ws %zu (need %zu)\n", n_in, out_size, ws_size, (size_t)(WS_END + 48 * MiB)); grid = -1; return; }
        int dev = 0, cus = 0, per_cu = 0;
        if (hipGetDevice(&dev) != hipSuccess || hipDeviceGetAttribute(&cus, hipDeviceAttributeMultiprocessorCount, dev) != hipSuccess) { grid = -1; return; }
        if (hipFuncSetAttribute((const void*)fwd_kernel, hipFuncAttributeMaxDynamicSharedMemorySize, LDS_BYTES) != hipSuccess) { fprintf(stderr, "kernel_launch: hipFuncSetAttribute failed\n"); grid = -1; return; }
        if (hipOccupancyMaxActiveBlocksPerMultiprocessor(&per_cu, (const void*)fwd_kernel, 512, LDS_BYTES) != hipSuccess || per_cu < 1) fprintf(stderr, "kernel_launch: occupancy query says %d\n", per_cu);
        (void)hipGetLastError();
        grid = cus;
    }
    if (grid < 0) return;
    hipMemsetAsync((char*)d_ws + WS_CTL, 0, CTL_ZERO_BYTES, stream);
    Args a{};
    for (int i = 0; i < 28; ++i) a.in[i] = (const float*)d_in[i];
    a.out = (float*)d_out; a.ws = (unsigned char*)d_ws;
    if (ONE_LAUNCH) { a.ph_lo = 0; a.ph_hi = PH_L0 + (DEPTH - 1) * PH_PER + 10;   hipLaunchKernelGGL(fwd_kernel, dim3(grid), dim3(512), LDS_BYTES, stream, a); }
    else {
        for (int ph = 0; ph <= PH_END; ++ph) {
            bool exists = (ph == PH_P0 || ph == PH_N0 || ph == PH_END);
            if (ph >= PH_L0 && ph < PH_END) { const int layer = (ph - PH_L0) / PH_PER, k = (ph - PH_L0) % PH_PER, kind = layer % 3;
                exists = (k == 0 || k == 1 || k == 4 || (k >= 5 && k <= 9) || (k == 2 && kind != 0) || (k == 3 && kind == 1));
                if (ph > DBG_LAST) exists = false; }
            if (!exists) continue;
            a.ph_lo = ph; a.ph_hi = ph + 1;
            hipLaunchKernelGGL(fwd_kernel, dim3(grid), dim3(512), LDS_BYTES, stream, a);
        }
    }
}
```

```cpp
#include <hip/hip_runtime.h>
#include <cstdio>
#include <cstdint>

#define GAS __attribute__((address_space(1)))
#define LAS __attribute__((address_space(3)))
typedef unsigned short bf16_t;
typedef short bf16x8 __attribute__((ext_vector_type(8)));
typedef float f32x4 __attribute__((ext_vector_type(4)));
typedef float f32x2 __attribute__((ext_vector_type(2)));
typedef unsigned u32x4 __attribute__((ext_vector_type(4)));
typedef unsigned u32x2 __attribute__((ext_vector_type(2)));

constexpr int DM = 1024, NB = 8, SEQ = 4096, CTXL = 256, DEPTH = 4;
constexpr int NLAT = NB * SEQ, NCTX = NB * CTXL, MALL = NLAT + NCTX;
constexpr int NE = 16, CAPL = 512, CAPC = 32, REL = NB * CAPL, REC = NB * CAPC;
constexpr int MODW = 6 * DM;
constexpr float EPS = 1e-6f;

constexpr size_t MiB = 1u << 20;
constexpr size_t WS_CTL = 0, CTL_ZERO_BYTES = 1 * MiB;
constexpr size_t WS_MODV = 1 * MiB;
constexpr size_t WS_A2 = 2 * MiB;
constexpr size_t WS_A2C = WS_A2 + 4096 * 64 * 4;
constexpr size_t WS_TW = WS_A2C + 256 * 64 * 4;
constexpr size_t WS_AFF = 4 * MiB;
constexpr size_t WS_AFFC = WS_AFF + 2 * MiB;
constexpr size_t WS_ROWL = 7 * MiB;
constexpr size_t WS_GL = WS_ROWL + 512 * 1024;
constexpr size_t WS_SLOT = 8 * MiB;
constexpr size_t WS_WMIX = 11 * MiB;
constexpr size_t WS_WMOE = 43 * MiB;
constexpr size_t WS_WMOE_DN = WS_WMOE + 64 * MiB;
constexpr size_t WS_LAT = 139 * MiB;
constexpr size_t WS_HL = 275 * MiB;
constexpr size_t WS_U = 343 * MiB;
constexpr size_t WS_Z = 547 * MiB;
constexpr size_t WS_H = 615 * MiB;
constexpr size_t WS_YS = 751 * MiB;
constexpr size_t WS_HT = 887 * MiB;
constexpr size_t WS_HTC = 951 * MiB;
constexpr size_t WS_END = 955 * MiB;
constexpr size_t WM_SC_IN = 0;
constexpr size_t WM_SC_OUT = WM_SC_IN + 2ull * 3072 * 1024;
constexpr size_t WM_HY_IN = WM_SC_OUT + 2ull * 1024 * 1024;
constexpr size_t WM_HY_OUT = WM_HY_IN + 3072ull * 1024;
constexpr size_t WM_AT_QKV = WM_HY_OUT + 1024ull * 1024;
constexpr size_t WM_AT_O = WM_AT_QKV + 1536ull * 1024;
static_assert((WM_AT_O + 1024ull * 1024) * 2 <= 32 * MiB, "mixer weights");
constexpr int CW_BAR = 4096;
constexpr int CW_WQ = 16384;

constexpr int LDS_MAIN = 155648;
constexpr int LDS_MISC = LDS_MAIN;
constexpr int LDS_BYTES = LDS_MAIN + 4096;

#ifndef PROBE_MASK
#define PROBE_MASK 0u
#endif
#ifndef PROBE_K
#define PROBE_K 1
#endif
#ifndef PROBE_SEAMMASK
#define PROBE_SEAMMASK 0u
#endif
#define PB(type) const int _ptype = (type); (void)_ptype; unsigned long long _pt0 = 0; if ((PROBE_MASK >> (type)) & 1u) _pt0 = wall_clock64();
#define PE(type) if ((PROBE_MASK >> (type)) & 1u) { if (threadIdx.x == 0) { volatile LAS unsigned long long* _pa = (volatile LAS unsigned long long*)(F.lds + LDS_MISC + 128); *_pa = *_pa + (wall_clock64() - _pt0); } }
enum { PT_SUB_FILT = 16, PT_SUB_CTX = 17, PT_SUB_TOPKU = 18, PT_SUB_GATHER = 19 };
enum { PT_P0 = 0, PT_N1, PT_INGEMM, PT_SCCONV, PT_ATPREP, PT_ATTN, PT_HYDW, PT_HYLC, PT_HYUT, PT_OUTGEMM, PT_NORM2, PT_TOPK, PT_MOEUP, PT_MOEDN, PT_COMB };
#define LDS_WAIT() asm volatile("s_waitcnt lgkmcnt(0)" ::: "memory")
#define VM_WAIT() asm volatile("s_waitcnt vmcnt(0)" ::: "memory")

__device__ __forceinline__ unsigned f2bf(float f) { unsigned u = __builtin_bit_cast(unsigned, f); return (u + 0x7fffu + ((u >> 16) & 1u)) >> 16; }
__device__ __forceinline__ unsigned pk2(float lo, float hi) { return f2bf(lo) | (f2bf(hi) << 16); }
__device__ __forceinline__ float bf_lo(unsigned w) { return __uint_as_float(w << 16); }
__device__ __forceinline__ float bf_hi(unsigned w) { return __uint_as_float(w & 0xffff0000u); }
__device__ __forceinline__ float bf1(bf16_t b) { return __uint_as_float(((unsigned)b) << 16); }
__device__ __forceinline__ float wave_sum(float v) {
#pragma unroll
    for (int o = 1; o < 64; o <<= 1) v += __shfl_xor(v, o);
    return v;
}
__device__ __forceinline__ int wave_sum_i(int v) {
#pragma unroll
    for (int o = 1; o < 64; o <<= 1) v += __shfl_xor(v, o);
    return v;
}

#define XB_TMO      128
#define XB_XCNT(j)  (256  + 64 * (j))
#define XB_XSUB(j)  (1280 + 64 * (j))
#define XB_XGEN(j)  (2304 + 64 * (j))
#define XB_TOP      3328
#define XB_TOPGEN   3392
#define XCD_BAR_WORDS 3456
#define XB_SPIN_CAP (1u << 22)

__device__ __forceinline__ unsigned xb_ld(unsigned* p)              { return __hip_atomic_load(p, __ATOMIC_RELAXED, __HIP_MEMORY_SCOPE_AGENT); }
__device__ __forceinline__ unsigned xb_add(unsigned* p, unsigned v) { return __hip_atomic_fetch_add(p, v, __ATOMIC_RELAXED, __HIP_MEMORY_SCOPE_AGENT); }
__device__ __forceinline__ unsigned xb_xcc_id() { return (unsigned)__builtin_amdgcn_s_getreg((3 << 11) | 20) & 0xFu; }
#define XB_SPIN(cond, bar) do { unsigned _sp = 0; while (cond) { __builtin_amdgcn_s_sleep(1); \
    if ((++_sp & 255u) == 0u) { if (xb_ld(&(bar)[XB_TMO])) break; if (_sp > XB_SPIN_CAP) { atomicAdd(&(bar)[XB_TMO], 1u); break; } } } } while (0)

struct XcdBarrier { unsigned* bar; unsigned x; volatile LAS unsigned* st; };

__device__ __forceinline__ XcdBarrier xcd_barrier_post(unsigned* bar, volatile LAS unsigned* st) {
    XcdBarrier b; b.bar = bar; b.x = xb_xcc_id(); b.st = st;
    if (threadIdx.x == 0) (void)xb_add(&bar[XB_XCNT(b.x)], 1u);
    return b;
}
__device__ __forceinline__ void xcd_barrier_complete(unsigned* bar, unsigned x, unsigned& nloc, unsigned& nx) {
    const unsigned G = gridDim.x * gridDim.y * gridDim.z;
    unsigned sum, cnt, mine, sp = 0u;
    for (;;) {
        sum = 0u; cnt = 0u; mine = 0u;
#pragma unroll
        for (unsigned j = 0; j < 16; ++j) { const unsigned c = xb_ld(&bar[XB_XCNT(j)]); sum += c; cnt += (c > 0u) ? 1u : 0u; mine = (j == x) ? c : mine; }
        if (sum == G) break;
        __builtin_amdgcn_s_sleep(1);
        if ((++sp & 255u) == 0u) { if (xb_ld(&bar[XB_TMO])) break; if (sp > XB_SPIN_CAP) { atomicAdd(&bar[XB_TMO], 1u); break; } }
    }
    nloc = mine > 0u ? mine : 1u; nx = cnt > 0u ? cnt : 1u;
}
__device__ __forceinline__ void xcd_barrier(const XcdBarrier& b) {
    asm volatile("s_waitcnt vmcnt(0)" ::: "memory");
    __syncthreads();
    if (threadIdx.x == 0) {
        unsigned* bar = b.bar;
        __builtin_amdgcn_s_waitcnt(0);
        unsigned nloc = b.st[0], nx = b.st[1];
        if (nloc == 0u) { xcd_barrier_complete(bar, b.x, nloc, nx); b.st[0] = nloc; b.st[1] = nx; }
        const unsigned old = xb_add(&bar[XB_XSUB(b.x)], 1u);
        const unsigned gen = old / nloc;
        if (old + 1u == (gen + 1u) * nloc) {
            __builtin_amdgcn_fence(__ATOMIC_RELEASE, "agent");
            asm volatile("s_waitcnt vmcnt(0)" ::: "memory");
            const unsigned og = xb_add(&bar[XB_TOP], 1u);
            const unsigned tg = og / nx;
            if (og + 1u == (tg + 1u) * nx) xb_add(&bar[XB_TOPGEN], 1u);
            else XB_SPIN(xb_ld(&bar[XB_TOPGEN]) == tg, bar);
            __builtin_amdgcn_fence(__ATOMIC_ACQUIRE, "agent");
            xb_add(&bar[XB_XGEN(b.x)], 1u);
            asm volatile("s_waitcnt vmcnt(0)" ::: "memory");
        } else {
            XB_SPIN(xb_ld(&bar[XB_XGEN(b.x)]) == gen, bar);
            __builtin_amdgcn_fence(__ATOMIC_ACQUIRE, "agent");
            asm volatile("s_waitcnt vmcnt(0)" ::: "memory");
        }
    }
    __syncthreads();
}

namespace pg8 {
constexpr int BM = 256, BK = 64, HALF = 128, HTB = HALF * BK * 2, STAGE_BYTES = 8 * HTB, NXCD = 8, WGM = 8;
__host__ __device__ __forceinline__ int lds_byte(int r, int c) { const int st = (r >> 4) * 2 + (c >> 5), rr = r & 15, cc = c & 31, ob = rr * 64 + cc * 2; return st * 1024 + (ob ^ (((ob >> 9) & 1) << 5)); }
__host__ __device__ __forceinline__ void stage_rc(int b, int& R, int& C) { const int st = b / 1024, sb = b % 1024, swz = sb ^ (((sb >> 9) & 1) << 5); R = (st >> 1) * 16 + swz / 64; C = (st & 1) * 32 + (swz % 64) / 2; }
__host__ __device__ __forceinline__ int perm32(int rho) { const int n = rho >> 4, i = rho & 15; return 8 * (i >> 2) + 4 * n + (i & 3); }

struct Unit { int pm, pn; };
struct Gemm { const void* A; const void* Bt; int M, N, K; int tpg; const int* rowlist; };

struct StaticOrder {
    int nM, nN, nwg, G, c;
    __device__ void init(int M, int N, int G_, int c_) { nM = M / BM; nN = N / BM; nwg = nM * nN; G = G_; c = c_; }
    __device__ bool next(int i, Unit& u) const {
        const long L = (long)i * G + c; if (L >= nwg) return false;
        int wgid = (int)L; { const int q = nwg / NXCD, r = nwg % NXCD, xcd = wgid % NXCD, off = wgid / NXCD; wgid = (xcd < r ? xcd * (q + 1) : r * (q + 1) + (xcd - r) * q) + off; }
        const int nig = WGM * nN, gid = wgid / nig, fm = gid * WGM, gsz = (nM - fm) < WGM ? (nM - fm) : WGM;
        u.pm = fm + ((wgid % nig) % gsz); u.pn = (wgid % nig) / gsz; return true;
    }
};

__device__ __forceinline__ unsigned cvt_pk_bf16(float lo, float hi) { unsigned r; asm volatile("v_cvt_pk_bf16_f32 %0, %1, %2" : "=v"(r) : "v"(lo), "v"(hi)); return r; }

typedef int i32x8 __attribute__((ext_vector_type(8)));
typedef int i32x4 __attribute__((ext_vector_type(4)));
template <class Epi, class Sched, bool GATHER, int ESZ = 2>
__device__ __forceinline__ void gemm_phase(LAS unsigned char* lds, const Gemm g, const Sched& S, const Epi& E) {
    int tid = threadIdx.x; asm volatile("" : "+v"(tid));
    const int wid = __builtin_amdgcn_readfirstlane(tid >> 6), lane = tid & 63, wr = wid >> 2, wc = wid & 3, fr = lane & 15, fq = lane >> 4;
    const int K = g.K * ESZ / 2  , nt = K / BK, nN = g.N / BM;
    const int kstep = BK * 2;
    const int hstep = HALF * K * 2;
    const int tstep = 2 * hstep;
    const int qstep = hstep / 2;
    const __amdgpu_buffer_rsrc_t rsA = __builtin_amdgcn_make_buffer_rsrc((void*)g.A, 0, 0x7fffffff, 0x00020000);
    const __amdgpu_buffer_rsrc_t rsB = __builtin_amdgcn_make_buffer_rsrc((void*)g.Bt, 0, 0x7fffffff, 0x00020000);
    int voffB[2], vA0[2]; int RA0 = 0, cby = 0; unsigned cP[2] = {0u, 0u}, nP[2] = {0u, 0u};
#pragma unroll
    for (int i = 0; i < 2; ++i) { int R, C; stage_rc(tid * 16 + i * 8192, R, C); const int Rb = Epi::PERM ? ((R & ~31) + perm32(R & 31)) : R;
        if (i == 0) { RA0 = R; cby = C * 2; }
        vA0[i] = (R * K + C) * 2;
        voffB[i] = (Rb * K + C) * 2; }
    const unsigned ldsw = (unsigned)wid * 1024u;
    const int lpart = lds_byte(fr, fq * 8); const int aoffU = wr * 8192, boffU = wc * 4096;
    const int aoffP = lpart + aoffU, boffP = lpart + boffU;
#define PG8_FRESH(u, pers) (pers)
#define PG8_SA(b, h) (((b) * 2 + (h)) * HTB)
#define PG8_SB(b, h) ((4 + (b) * 2 + (h)) * HTB)
#define PG8_STAGE(bufoff, rs, soff, voff) do { _Pragma("unroll") for (int _i = 0; _i < 2; ++_i) { \
        __builtin_amdgcn_raw_ptr_buffer_load_lds(rs, (LAS unsigned*)(lds + (bufoff) + ldsw + _i * 8192), 16, (voff)[0], (soff) + _i * qstep, 0, 0); } } while (0)
#define PG8_GOFF(p, h) ((int)((((h) ? ((p) >> 16) : ((p) & 0xffffu)) * (unsigned)(K * 2)) + (unsigned)cby))
#define PG8_GLOAD(bufoff, soff, h) do { _Pragma("unroll") for (int _i = 0; _i < 2; ++_i) __builtin_amdgcn_raw_ptr_buffer_load_lds(rsA, (LAS unsigned*)(lds + (bufoff) + ldsw + _i * 8192), 16, PG8_GOFF(cP[_i], h), (soff), 0, 0); } while (0)
#define PG8_ROWS(P, pm) do { _Pragma("unroll") for (int _i = 0; _i < 2; ++_i) { const int* _rl = g.rowlist + (pm) * BM + RA0 + _i * 64; P[_i] = (unsigned)_rl[0] | ((unsigned)_rl[HALF] << 16); } } while (0)
#define PG8_STAGE_A0(bufoff, soff) do { if constexpr (GATHER) PG8_GLOAD(bufoff, soff, 0); else PG8_STAGE(bufoff, rsA, soff, vA0); } while (0)
#define PG8_STAGE_A1(bufoff, soff) do { if constexpr (GATHER) PG8_GLOAD(bufoff, soff, 1); else PG8_STAGE(bufoff, rsA, (soff) + hstep, vA0); } while (0)
#define PG8_LDA(dst, b, h) do { const int aoff = PG8_FRESH(aoffU, aoffP); if constexpr (ESZ == 2) { _Pragma("unroll") for (int m = 0; m < 4; ++m) _Pragma("unroll") for (int k = 0; k < 2; ++k) dst[m][k] = *(const LAS bf16x8*)(lds + PG8_SA(b, h) + aoff + m * 2048 + k * 1024); } \
        else { _Pragma("unroll") for (int m = 0; m < 4; ++m) { const i32x4 _lo = *(const LAS i32x4*)(lds + PG8_SA(b, h) + aoff + m * 2048), _hi = *(const LAS i32x4*)(lds + PG8_SA(b, h) + aoff + m * 2048 + 1024); dst##8[m] = __builtin_shufflevector(_lo, _hi, 0, 1, 2, 3, 4, 5, 6, 7); } } } while (0)
#define PG8_LDB(dst, b, h) do { const int boff = PG8_FRESH(boffU, boffP); if constexpr (ESZ == 2) { _Pragma("unroll") for (int n = 0; n < 2; ++n) _Pragma("unroll") for (int k = 0; k < 2; ++k) dst[n][k] = *(const LAS bf16x8*)(lds + PG8_SB(b, h) + boff + n * 2048 + k * 1024); } \
        else { _Pragma("unroll") for (int n = 0; n < 2; ++n) { const i32x4 _lo = *(const LAS i32x4*)(lds + PG8_SB(b, h) + boff + n * 2048), _hi = *(const LAS i32x4*)(lds + PG8_SB(b, h) + boff + n * 2048 + 1024); dst##8[n] = __builtin_shufflevector(_lo, _hi, 0, 1, 2, 3, 4, 5, 6, 7); } } } while (0)
#define PG8_MMA(ai, bj, At, Bt) do { __builtin_amdgcn_s_setprio(1); _Pragma("unroll") for (int m = 0; m < 4; ++m) _Pragma("unroll") for (int n = 0; n < 2; ++n) { \
        if constexpr (ESZ == 2) { _Pragma("unroll") for (int k = 0; k < 2; ++k) acc[ai][bj][m][n] = __builtin_amdgcn_mfma_f32_16x16x32_bf16(Bt[n][k], At[m][k], acc[ai][bj][m][n], 0, 0, 0); } \
        else acc[ai][bj][m][n] = __builtin_amdgcn_mfma_scale_f32_16x16x128_f8f6f4(Bt##8[n], At##8[m], acc[ai][bj][m][n], 0, 0, 0, 0, 0, 0); } \
        __builtin_amdgcn_s_setprio(0); } while (0)
#define PG8_WAIT_V(n) asm volatile("s_waitcnt vmcnt(" #n ")" ::: "memory")
#define PG8_WAIT_L(n) asm volatile("s_waitcnt lgkmcnt(" #n ")" ::: "memory")
#define PG8_BAR __builtin_amdgcn_s_barrier()
#define PG8_SCHED __builtin_amdgcn_sched_barrier(0)
    Unit cur, nxt; int ui = 0;
    if (!S.next(0, cur)) return;
    f32x4 acc[2][2][4][2];
#pragma unroll
    for (int a = 0; a < 2; ++a)
#pragma unroll
        for (int b = 0; b < 2; ++b)
#pragma unroll
            for (int m = 0; m < 4; ++m)
#pragma unroll
                for (int n = 0; n < 2; ++n) acc[a][b][m][n] = (f32x4){0.f, 0.f, 0.f, 0.f};
    bf16x8 At[4][2], B0[2][2], B1[2][2]; i32x8 At8[4], B08[2], B18[2];
    int cA, cB = ((cur.pm / g.tpg) * nN + cur.pn) * tstep;
    if constexpr (GATHER) { cA = 0; PG8_ROWS(cP, cur.pm); } else cA = cur.pm * tstep;
    PG8_STAGE(PG8_SB(0, 0), rsB, cB, voffB); PG8_STAGE_A0(PG8_SA(0, 0), cA); PG8_STAGE(PG8_SB(0, 1), rsB, cB + hstep, voffB); PG8_STAGE_A1(PG8_SA(0, 1), cA);
    if (wr == 1) PG8_BAR;
    PG8_WAIT_V(4); PG8_BAR;
    PG8_STAGE(PG8_SB(1, 0), rsB, cB + kstep, voffB); PG8_STAGE_A0(PG8_SA(1, 0), cA + kstep); PG8_STAGE(PG8_SB(1, 1), rsB, cB + hstep + kstep, voffB);
    PG8_WAIT_V(6); PG8_BAR;
    for (;;) {
        const bool has_next = S.next(ui + 1, nxt);
        int nA; const int nB = has_next ? ((nxt.pm / g.tpg) * nN + nxt.pn) * tstep : cB;
        if constexpr (GATHER) { nA = 0; if (has_next) PG8_ROWS(nP, nxt.pm); else { nP[0] = cP[0]; nP[1] = cP[1]; } }
        else nA = has_next ? nxt.pm * tstep : cA;
#pragma unroll 1
        for (int t = 0; t < nt; t += 2) {
            const bool last = (t == nt - 2);
            const int a1 = cA + (t + 1) * kstep;
            const int a2 = last ? nA : cA + (t + 2) * kstep, b2 = last ? nB : cB + (t + 2) * kstep;
            const int a3 = a2 + kstep, b3 = b2 + kstep;
            PG8_LDB(B0, 0, 0); PG8_SCHED; PG8_LDA(At, 0, 0); PG8_STAGE_A1(PG8_SA(1, 1), a1);
            if constexpr (GATHER) { if (last) { cP[0] = nP[0]; cP[1] = nP[1]; } }
            PG8_WAIT_L(8); PG8_BAR; PG8_WAIT_L(0); PG8_MMA(0, 0, At, B0); PG8_BAR; PG8_SCHED;
            PG8_LDB(B1, 0, 1); PG8_STAGE(PG8_SB(0, 0), rsB, b2, voffB);
            PG8_BAR; PG8_WAIT_L(0); PG8_MMA(0, 1, At, B1); PG8_BAR;
            PG8_LDA(At, 0, 1); PG8_STAGE_A0(PG8_SA(0, 0), a2);
            PG8_BAR; PG8_WAIT_L(0); PG8_MMA(1, 0, At, B0); PG8_BAR; PG8_SCHED;
            PG8_STAGE(PG8_SB(0, 1), rsB, b2 + hstep, voffB);
            PG8_WAIT_V(6); PG8_BAR; PG8_MMA(1, 1, At, B1); PG8_BAR;
            PG8_LDB(B0, 1, 0); PG8_SCHED; PG8_LDA(At, 1, 0); PG8_STAGE_A1(PG8_SA(0, 1), a2);
            PG8_WAIT_L(8); PG8_BAR; PG8_WAIT_L(0); PG8_MMA(0, 0, At, B0); PG8_BAR; PG8_SCHED;
            PG8_LDB(B1, 1, 1); PG8_STAGE(PG8_SB(1, 0), rsB, b3, voffB);
            PG8_BAR; PG8_WAIT_L(0); PG8_MMA(0, 1, At, B1); PG8_BAR;
            PG8_LDA(At, 1, 1); PG8_STAGE_A0(PG8_SA(1, 0), a3);
            PG8_BAR; PG8_WAIT_L(0); PG8_MMA(1, 0, At, B0); PG8_BAR; PG8_SCHED;
            PG8_STAGE(PG8_SB(1, 1), rsB, b3 + hstep, voffB);
            PG8_WAIT_V(6); PG8_BAR; PG8_MMA(1, 1, At, B1); PG8_BAR;
        }
        E(acc, cur, wr, wc, fr, fq);
        if (!has_next) break;
#pragma unroll
        for (int a = 0; a < 2; ++a)
#pragma unroll
            for (int b = 0; b < 2; ++b)
#pragma unroll
                for (int m = 0; m < 4; ++m)
#pragma unroll
                    for (int n = 0; n < 2; ++n) acc[a][b][m][n] = (f32x4){0.f, 0.f, 0.f, 0.f};
        cur = nxt; cA = nA; cB = nB; ++ui;
    }
    PG8_WAIT_V(0);
    if (wr == 0) PG8_BAR;
    PG8_BAR;
#undef PG8_FRESH
#undef PG8_SA
#undef PG8_SB
#undef PG8_STAGE
#undef PG8_STAGE_A1
#undef PG8_STAGE_A0
#undef PG8_GLOAD
#undef PG8_GOFF
#undef PG8_ROWS
#undef PG8_LDA
#undef PG8_LDB
#undef PG8_MMA
#undef PG8_WAIT_V
#undef PG8_WAIT_L
#undef PG8_BAR
#undef PG8_SCHED
}

struct EpiBf16 {
    static constexpr bool PERM = true;
    bf16_t* O; int ldc;
    __device__ __forceinline__ void operator()(const f32x4 (&acc)[2][2][4][2], const Unit& u, int wr, int wc, int fr, int fq) const {
        const int row0 = u.pm * BM + wr * 64 + fr, col0 = u.pn * BM + wc * 32 + 8 * fq;
#pragma unroll
        for (int ai = 0; ai < 2; ++ai)
#pragma unroll
            for (int m = 0; m < 4; ++m) { bf16_t* rowp = O + (size_t)(row0 + ai * HALF + m * 16) * ldc + col0;
#pragma unroll
                for (int bj = 0; bj < 2; ++bj) { const f32x4 v0 = acc[ai][bj][m][0], v1 = acc[ai][bj][m][1];
                    u32x4 w; w.x = cvt_pk_bf16(v0[0], v0[1]); w.y = cvt_pk_bf16(v0[2], v0[3]); w.z = cvt_pk_bf16(v1[0], v1[1]); w.w = cvt_pk_bf16(v1[2], v1[3]);
                    *(u32x4*)(rowp + bj * HALF) = w; } }
    }
};
struct EpiScIn {
    static constexpr bool PERM = true;
    bf16_t* O;
    __device__ __forceinline__ void operator()(const f32x4 (&acc)[2][2][4][2], const Unit& u, int wr, int wc, int fr, int fq) const {
        const int row0 = u.pm * BM + wr * 64 + fr;
        if (u.pn < 4) { const int col0 = u.pn * BM + wc * 32 + 8 * fq;
#pragma unroll
            for (int ai = 0; ai < 2; ++ai)
#pragma unroll
                for (int m = 0; m < 4; ++m) { bf16_t* rowp = O + (size_t)(row0 + ai * HALF + m * 16) * 2048 + col0;
#pragma unroll
                    for (int bj = 0; bj < 2; ++bj) { const f32x4 v0 = acc[ai][bj][m][0], v1 = acc[ai][bj][m][1];
                        u32x4 w; w.x = cvt_pk_bf16(v0[0], v0[1]); w.y = cvt_pk_bf16(v0[2], v0[3]); w.z = cvt_pk_bf16(v1[0], v1[1]); w.w = cvt_pk_bf16(v1[2], v1[3]);
                        *(u32x4*)(rowp + bj * HALF) = w; } }
        } else { const int col0 = 1024 + (u.pn - 4) * HALF + wc * 32 + 8 * fq;
#pragma unroll
            for (int ai = 0; ai < 2; ++ai)
#pragma unroll
                for (int m = 0; m < 4; ++m) { const f32x4 v0 = acc[ai][0][m][0] * acc[ai][1][m][0], v1 = acc[ai][0][m][1] * acc[ai][1][m][1];
                    u32x4 w; w.x = cvt_pk_bf16(v0[0], v0[1]); w.y = cvt_pk_bf16(v0[2], v0[3]); w.z = cvt_pk_bf16(v1[0], v1[1]); w.w = cvt_pk_bf16(v1[2], v1[3]);
                    *(u32x4*)(O + (size_t)(row0 + ai * HALF + m * 16) * 2048 + col0) = w; }
        }
    }
};
template <bool F32BASE> struct EpiRes {
    static constexpr bool PERM = true;
    const void* baseL; const void* baseC; bf16_t* out; const float* gate;
    __device__ __forceinline__ void operator()(const f32x4 (&acc)[2][2][4][2], const Unit& u, int wr, int wc, int fr, int fq) const {
        const int row0 = u.pm * BM + wr * 64 + fr, col0 = u.pn * BM + wc * 32 + 8 * fq;
        const bool isc = u.pm >= NLAT / BM;
        const int midx = isc ? 8 : (u.pm >> 4);
        const float* gp = gate + (size_t)midx * MODW + col0;
        const size_t boff = isc ? (size_t)(row0 - NLAT) * DM + col0 : (size_t)row0 * DM + col0;
        const void* bbase = isc ? baseC : baseL;
        bf16_t* op = out + (size_t)row0 * DM + col0;
        f32x4 gv[2][2];
#pragma unroll
        for (int bj = 0; bj < 2; ++bj)
#pragma unroll
            for (int n = 0; n < 2; ++n) gv[bj][n] = *(const f32x4*)(gp + bj * HALF + n * 4);
        if constexpr (F32BASE) {
#pragma unroll
            for (int ai = 0; ai < 2; ++ai) {
                f32x4 bq[4][2][2];
#pragma unroll
                for (int m = 0; m < 4; ++m)
#pragma unroll
                    for (int bj = 0; bj < 2; ++bj) { const float* bp = (const float*)bbase + boff + (size_t)(ai * HALF + m * 16) * DM + bj * HALF; bq[m][bj][0] = *(const f32x4*)bp; bq[m][bj][1] = *(const f32x4*)(bp + 4); }
#pragma unroll
                for (int m = 0; m < 4; ++m) { const size_t ro = (size_t)(ai * HALF + m * 16) * DM;
#pragma unroll
                    for (int bj = 0; bj < 2; ++bj) {
                        const f32x4 v0 = bq[m][bj][0] + gv[bj][0] * acc[ai][bj][m][0], v1 = bq[m][bj][1] + gv[bj][1] * acc[ai][bj][m][1];
                        u32x4 o; o.x = cvt_pk_bf16(v0[0], v0[1]); o.y = cvt_pk_bf16(v0[2], v0[3]); o.z = cvt_pk_bf16(v1[0], v1[1]); o.w = cvt_pk_bf16(v1[2], v1[3]);
                        *(u32x4*)(op + ro + bj * HALF) = o; } }
                asm volatile("" ::: "memory"); }
        } else {
            u32x4 bw[2][4][2];
#pragma unroll
            for (int ai = 0; ai < 2; ++ai)
#pragma unroll
                for (int m = 0; m < 4; ++m)
#pragma unroll
                    for (int bj = 0; bj < 2; ++bj) bw[ai][m][bj] = *(const u32x4*)((const bf16_t*)bbase + boff + (size_t)(ai * HALF + m * 16) * DM + bj * HALF);
#pragma unroll
            for (int ai = 0; ai < 2; ++ai)
#pragma unroll
                for (int m = 0; m < 4; ++m) { const size_t ro = (size_t)(ai * HALF + m * 16) * DM;
#pragma unroll
                    for (int bj = 0; bj < 2; ++bj) { const u32x4 w = bw[ai][m][bj];
                        const f32x4 b0 = (f32x4){bf_lo(w.x), bf_hi(w.x), bf_lo(w.y), bf_hi(w.y)}, b1 = (f32x4){bf_lo(w.z), bf_hi(w.z), bf_lo(w.w), bf_hi(w.w)};
                        const f32x4 v0 = b0 + gv[bj][0] * acc[ai][bj][m][0], v1 = b1 + gv[bj][1] * acc[ai][bj][m][1];
                        u32x4 o; o.x = cvt_pk_bf16(v0[0], v0[1]); o.y = cvt_pk_bf16(v0[2], v0[3]); o.z = cvt_pk_bf16(v1[0], v1[1]); o.w = cvt_pk_bf16(v1[2], v1[3]);
                        *(u32x4*)(op + ro + bj * HALF) = o; } }
        }
    }
};
__device__ __forceinline__ unsigned pk4_fp8(float a, float b, float c, float d) { int w = 0; w = __builtin_amdgcn_cvt_pk_fp8_f32(a, b, w, false); w = __builtin_amdgcn_cvt_pk_fp8_f32(c, d, w, true); return (unsigned)w; }
struct EpiMoeUp {
    static constexpr bool PERM = true;
    unsigned char* H;
    __device__ __forceinline__ void operator()(const f32x4 (&acc)[2][2][4][2], const Unit& u, int wr, int wc, int fr, int fq) const {
        const int row0 = u.pm * BM + wr * 64 + fr, col0 = u.pn * HALF + wc * 32 + 8 * fq;
#pragma unroll
        for (int ai = 0; ai < 2; ++ai)
#pragma unroll
            for (int m = 0; m < 4; ++m) { unsigned char* rowp = H + (size_t)(row0 + ai * HALF + m * 16) * DM + col0;
                float h[8];
#pragma unroll
                for (int n = 0; n < 2; ++n)
#pragma unroll
                    for (int j = 0; j < 4; ++j) { const float gt = acc[ai][0][m][n][j] * 0.03125f, up = acc[ai][1][m][n][j] * 0.03125f;
                        h[n * 4 + j] = gt * __builtin_amdgcn_rcpf(1.0f + __expf(-gt)) * up; }
                u32x2 w; w.x = pk4_fp8(h[0], h[1], h[2], h[3]); w.y = pk4_fp8(h[4], h[5], h[6], h[7]);
                *(u32x2*)rowp = w; }
    }
};
struct EpiMoeDown {
    static constexpr bool PERM = true;
    unsigned char* Y; const float* gl;
    __device__ __forceinline__ void operator()(const f32x4 (&acc)[2][2][4][2], const Unit& u, int wr, int wc, int fr, int fq) const {
        const int row0 = u.pm * BM + wr * 64 + fr, col0 = u.pn * BM + wc * 32 + 8 * fq;
#pragma unroll
        for (int ai = 0; ai < 2; ++ai)
#pragma unroll
            for (int m = 0; m < 4; ++m) { const int row = row0 + ai * HALF + m * 16; const float gg = 0.5f; unsigned char* rowp = Y + (size_t)row * DM + col0;
#pragma unroll
                for (int bj = 0; bj < 2; ++bj) { const f32x4 v0 = acc[ai][bj][m][0] * gg, v1 = acc[ai][bj][m][1] * gg;
                    u32x2 w; w.x = pk4_fp8(v0[0], v0[1], v0[2], v0[3]); w.y = pk4_fp8(v1[0], v1[1], v1[2], v1[3]);
                    *(u32x2*)(rowp + bj * HALF) = w; } }
    }
};
}


namespace att {
constexpr int D = 128, NW = 8, QBLK = 32, KVBLK = 64;
constexpr float SCALE = 0.088388347648318440f;
constexpr float THR = 8.f;
constexpr int SDEPTH = 2;
constexpr int LDQ = 1536, LDK = 256, LDO = 1024;
constexpr size_t SHM_V = KVBLK * D * 2, SHM_K = KVBLK * D * 2, SHM_ATTN = 2 * SHM_V + 2 * SHM_K + NW * 64 * 4;
using s16x4  = __attribute__((ext_vector_type(4))) short;
using f32x16 = __attribute__((ext_vector_type(16))) float;
#define KSWZ(row, colB) ((row) * 256 + ((colB) ^ (((row) & 7) << 4)))
#define SBAR() __builtin_amdgcn_sched_barrier(0)
__device__ __forceinline__ int crow(int r, int hi) { return (r & 3) + 8 * (r >> 2) + 4 * hi; }
__device__ __forceinline__ unsigned cvtpk(float lo, float hi) { unsigned r; asm volatile("v_cvt_pk_bf16_f32 %0, %1, %2" : "=v"(r) : "v"(lo), "v"(hi)); return r; }
__device__ __forceinline__ bf16x8 ld8(const bf16_t* p) { return *reinterpret_cast<const bf16x8*>(p); }

__device__ __forceinline__ void partialSM(f32x16& p0, f32x16& p1, float& m_reg, float& mn, float& alpha) {
  constexpr float C = SCALE * 1.4426950408889634f;
  float pmax = p0[0]; for (int r = 1; r < 16; ++r) pmax = fmaxf(pmax, p0[r]); for (int r = 0; r < 16; ++r) pmax = fmaxf(pmax, p1[r]);
  { auto rr = __builtin_amdgcn_permlane32_swap(__float_as_uint(pmax), __float_as_uint(pmax), false, false);
    pmax = fmaxf(__uint_as_float(rr[0]), __uint_as_float(rr[1])); }
  if (__builtin_expect(__all(pmax - m_reg <= THR / SCALE), 1)) { mn = m_reg; alpha = 1.f; }
  else { mn = fmaxf(m_reg, pmax); alpha = __builtin_amdgcn_exp2f((m_reg - mn) * C); m_reg = mn; }
  float mnC = -mn * C;
  for (int r = 0; r < 16; ++r) p0[r] = fmaf(p0[r], C, mnC); for (int r = 0; r < 16; ++r) p1[r] = fmaf(p1[r], C, mnC);
  for (int r = 0; r < 16; ++r) p0[r] = __builtin_amdgcn_exp2f(p0[r]);
}
__device__ __forceinline__ void finishSM(f32x16& p0, f32x16& p1, float alpha, float& l_reg, bf16x8& pa0, bf16x8& pa1, bf16x8& pa2, bf16x8& pa3) {
  for (int r = 0; r < 16; ++r) p1[r] = __builtin_amdgcn_exp2f(p1[r]);
  float ps = 0; for (int r = 0; r < 16; ++r) ps += p0[r]; for (int r = 0; r < 16; ++r) ps += p1[r];
  { auto rr = __builtin_amdgcn_permlane32_swap(__float_as_uint(ps), __float_as_uint(ps), false, false);
    ps = __uint_as_float(rr[0]) + __uint_as_float(rr[1]); }
  l_reg = l_reg * alpha + ps;
#define PK4(P, BASE, OUT) do { unsigned a0 = cvtpk(P[BASE + 0], P[BASE + 1]), a1 = cvtpk(P[BASE + 2], P[BASE + 3]);   \
    unsigned b0 = cvtpk(P[BASE + 4], P[BASE + 5]), b1 = cvtpk(P[BASE + 6], P[BASE + 7]);                              \
    auto r0 = __builtin_amdgcn_permlane32_swap(a0, b0, false, false); auto r1 = __builtin_amdgcn_permlane32_swap(a1, b1, false, false); \
    u32x4 w = {r0[0], r1[0], r0[1], r1[1]}; OUT = *reinterpret_cast<bf16x8*>(&w); } while (0)
  PK4(p0, 0, pa0); PK4(p0, 8, pa1); PK4(p1, 0, pa2); PK4(p1, 8, pa3);
#undef PK4
}
__device__ __forceinline__ void qkt(f32x16& p0, f32x16& p1, const bf16_t* Ks, const bf16x8* qr, int r32, int hi) {
  p0 = f32x16{}; p1 = f32x16{};
  for (int d0 = 0; d0 < 8; ++d0) { int cb = (d0 * 16 + hi * 8) * 2;
    bf16x8 b0 = *reinterpret_cast<const bf16x8*>((const char*)Ks + KSWZ(r32, cb));
    bf16x8 b1 = *reinterpret_cast<const bf16x8*>((const char*)Ks + KSWZ(32 + r32, cb));
    p0 = __builtin_amdgcn_mfma_f32_32x32x16_bf16(b0, qr[d0], p0, 0, 0, 0);
    p1 = __builtin_amdgcn_mfma_f32_32x32x16_bf16(b1, qr[d0], p1, 0, 0, 0); }
}
__device__ __forceinline__ int v_st(int k, int c) { const int kk = (k & ~0xC) | ((k & 4) << 1) | ((k & 8) >> 1); return ((kk >> 3) * 4 + (c >> 5)) * 512 + ((kk & 7) * 32 + (c & 31)) * 2; }
__device__ __forceinline__ int v_rd_base(int lane) { return ((lane & 3) << 3) | (((lane >> 2) & 3) << 6) | (((lane >> 4) & 1) << 5) | (((lane >> 5) & 1) << 8); }
constexpr int v_rd_off(int d0, int ks, int half) { return d0 * 512 + ks * 4096 + half * 2048; }
template <int OFF> __device__ __forceinline__ s16x4 tr_read(int vb) {
  s16x4 r; asm volatile("ds_read_b64_tr_b16 %0, %1 offset:%2" : "=&v"(r) : "v"(vb), "i"(OFF) : "memory"); return r;
}
template <int D0> __device__ __forceinline__ void pv_one(f32x16& od, int vb, bf16x8 pa0, bf16x8 pa1, bf16x8 pa2, bf16x8 pa3) {
  const s16x4 l0 = tr_read<v_rd_off(D0, 0, 0)>(vb), h0 = tr_read<v_rd_off(D0, 0, 1)>(vb), l1 = tr_read<v_rd_off(D0, 1, 0)>(vb), h1 = tr_read<v_rd_off(D0, 1, 1)>(vb);
  const s16x4 l2 = tr_read<v_rd_off(D0, 2, 0)>(vb), h2 = tr_read<v_rd_off(D0, 2, 1)>(vb), l3 = tr_read<v_rd_off(D0, 3, 0)>(vb), h3 = tr_read<v_rd_off(D0, 3, 1)>(vb);
  asm volatile("s_waitcnt lgkmcnt(0)" ::: "memory"); SBAR();
#define PK(L, H) (bf16x8){L[0], L[1], L[2], L[3], H[0], H[1], H[2], H[3]}
  od = __builtin_amdgcn_mfma_f32_32x32x16_bf16(pa0, PK(l0, h0), od, 0, 0, 0);
  od = __builtin_amdgcn_mfma_f32_32x32x16_bf16(pa1, PK(l1, h1), od, 0, 0, 0);
  od = __builtin_amdgcn_mfma_f32_32x32x16_bf16(pa2, PK(l2, h2), od, 0, 0, 0);
  od = __builtin_amdgcn_mfma_f32_32x32x16_bf16(pa3, PK(l3, h3), od, 0, 0, 0);
#undef PK
}
__device__ __forceinline__ void pv_d0(f32x16* o, int vb, bf16x8 pa0, bf16x8 pa1, bf16x8 pa2, bf16x8 pa3) {
  pv_one<0>(o[0], vb, pa0, pa1, pa2, pa3); pv_one<1>(o[1], vb, pa0, pa1, pa2, pa3); pv_one<2>(o[2], vb, pa0, pa1, pa2, pa3); pv_one<3>(o[3], vb, pa0, pa1, pa2, pa3);
}
__device__ __forceinline__ void attn_dense_body(const bf16_t* __restrict__ Qb, const bf16_t* __restrict__ Kh, const bf16_t* __restrict__ Vh,
                                                bf16_t* __restrict__ Ob, int seq, char* lds) {
  const int tid = threadIdx.x, wid = tid >> 6, lane = tid & 63, r32 = lane & 31, hi = lane >> 5;
  bf16_t* V_lds = (bf16_t*)lds; bf16_t* K_lds = (bf16_t*)(lds + 2 * SHM_V);
  float* ws = (float*)(lds + 2 * SHM_V + 2 * SHM_K) + wid * 64; float* li_l = ws; float* al_l = ws + 32;
  float m_reg = -1e30f, l_reg = 0; f32x16 o[4] = {}; bf16x8 qr[8];
  const bf16_t* Qw = Qb + (long)(wid * QBLK + r32) * LDQ + hi * 8;
#pragma unroll
  for (int d0 = 0; d0 < 8; ++d0) qr[d0] = ld8(Qw + d0 * 16);
  const int sr = tid >> 4, sc = (tid & 15) * 8, vst0 = v_st(sr, sc), vst1 = v_st(32 + sr, sc);
  const int vb0 = (int)(uintptr_t)V_lds + v_rd_base(lane);
  struct { bf16x8 vs0, vs1, ks0, ks1; } sr_[SDEPTH];
#define SLOAD(i, k0) do { sr_[i].vs0 = ld8(&Vh[(long)((k0) + sr) * LDK + sc]); sr_[i].vs1 = ld8(&Vh[(long)((k0) + 32 + sr) * LDK + sc]); \
    sr_[i].ks0 = ld8(&Kh[(long)((k0) + sr) * LDK + sc]); sr_[i].ks1 = ld8(&Kh[(long)((k0) + 32 + sr) * LDK + sc]); } while (0)
#define SWRITE(b, i) do { *(bf16x8*)((char*)V_lds + (b) * SHM_V + vst0) = sr_[i].vs0;          \
    *(bf16x8*)((char*)V_lds + (b) * SHM_V + vst1) = sr_[i].vs1; int kc = sc * 2;               \
    *(bf16x8*)((char*)K_lds + (b) * SHM_K + KSWZ(sr, kc)) = sr_[i].ks0;                       \
    *(bf16x8*)((char*)K_lds + (b) * SHM_K + KSWZ(32 + sr, kc)) = sr_[i].ks1; } while (0)
#define SWAIT() do { if constexpr (SDEPTH == 2) asm volatile("s_waitcnt vmcnt(4)" ::: "memory"); else asm volatile("s_waitcnt vmcnt(0)" ::: "memory"); } while (0)
#define RESC(a) do { if (__any((a) < 1.f)) { if (hi == 0) al_l[r32] = (a); asm volatile("s_waitcnt lgkmcnt(0)" ::: "memory"); \
    for (int d = 0; d < 4; ++d) for (int r = 0; r < 16; ++r) o[d][r] *= al_l[crow(r, hi)]; } } while (0)
  f32x16 pA0, pA1, pB0, pB1; float mnA, mnB, alA, alB; bf16x8 pa0, pa1, pa2, pa3; const int NT = seq / KVBLK;
  constexpr int SE = 0, SO = SDEPTH - 1;
  SLOAD(SE, 0); asm volatile("s_waitcnt vmcnt(0)" ::: "memory"); SWRITE(0, SE); __syncthreads();
  qkt(pA0, pA1, K_lds, qr, r32, hi); partialSM(pA0, pA1, m_reg, mnA, alA);
  SLOAD(SO, KVBLK); if constexpr (SDEPTH == 2) { if (2 < NT) SLOAD(SE, 2 * KVBLK); }
  SWAIT(); SWRITE(1, SO); __syncthreads();
  for (int j = 1; j + 1 < NT; j += 2) {
    SBAR(); qkt(pB0, pB1, (bf16_t*)((char*)K_lds + SHM_K), qr, r32, hi);
    finishSM(pA0, pA1, alA, l_reg, pa0, pa1, pa2, pa3); SBAR();
    SLOAD(SO, (j + SDEPTH) * KVBLK); SBAR();
    pv_d0(o, vb0, pa0, pa1, pa2, pa3); partialSM(pB0, pB1, m_reg, mnB, alB);
    __syncthreads(); SWAIT(); SWRITE(0, SE);
    RESC(alB); __syncthreads();
    SBAR(); qkt(pA0, pA1, K_lds, qr, r32, hi);
    finishSM(pB0, pB1, alB, l_reg, pa0, pa1, pa2, pa3); SBAR();
    if (SDEPTH == 1 || j + 3 < NT) SLOAD(SE, (j + 1 + SDEPTH) * KVBLK); SBAR();
    pv_d0(o, vb0 + (int)SHM_V, pa0, pa1, pa2, pa3); partialSM(pA0, pA1, m_reg, mnA, alA);
    __syncthreads(); SWAIT(); SWRITE(1, SO);
    RESC(alA); __syncthreads();
  }
  SBAR(); qkt(pB0, pB1, (bf16_t*)((char*)K_lds + SHM_K), qr, r32, hi);
  finishSM(pA0, pA1, alA, l_reg, pa0, pa1, pa2, pa3); SBAR();
  pv_d0(o, vb0, pa0, pa1, pa2, pa3); partialSM(pB0, pB1, m_reg, mnB, alB);
  __syncthreads(); RESC(alB);
  finishSM(pB0, pB1, alB, l_reg, pa0, pa1, pa2, pa3); SBAR();
  pv_d0(o, vb0 + (int)SHM_V, pa0, pa1, pa2, pa3);
  if (hi == 0) li_l[r32] = l_reg; asm volatile("s_waitcnt lgkmcnt(0)" ::: "memory");
  float rli[16];
#pragma unroll
  for (int r = 0; r < 16; ++r) rli[r] = __builtin_amdgcn_rcpf(li_l[crow(r, hi)]);
  bf16_t* Ow = Ob + (long)(wid * QBLK) * LDO;
#pragma unroll
  for (int r = 0; r < 16; ++r) { int orow = crow(r, hi);
    for (int d0 = 0; d0 < 4; ++d0) Ow[(long)orow * LDO + d0 * 32 + r32] = (bf16_t)f2bf(o[d0][r] * rli[r]); }
#undef SLOAD
#undef SWRITE
#undef SWAIT
#undef RESC
}
#undef KSWZ
#undef SBAR
}

struct Frame {
    LAS unsigned char* lds;
    int wave, G, gw, NGW;
    __device__ __forceinline__ int tid_() const { int t = (int)threadIdx.x; asm volatile("" : "+v"(t)); return t; }
    __device__ __forceinline__ int lane_() const { int t = (int)threadIdx.x & 63; asm volatile("" : "+v"(t)); return t; }
};
#define FOR_ITEMS(var, total) for (int var = (int)(((long)(total) * (int)blockIdx.x) / F.G) + F.wave, var##_end = (int)(((long)(total) * ((int)blockIdx.x + 1)) / F.G); var < var##_end; var += 8)
struct Args { const float* in[28]; float* out; unsigned char* ws; int ph_lo, ph_hi; };
#define KARG_BASE ((const __attribute__((address_space(4))) unsigned char*)__builtin_amdgcn_kernarg_segment_ptr())
#define KIN(i) (*(const float* const __attribute__((address_space(4)))*)(KARG_BASE + 8 * (i)))
#define KOUT (*(float* const __attribute__((address_space(4)))*)(KARG_BASE + 8 * 28))
#define KWS (*(unsigned char* const __attribute__((address_space(4)))*)(KARG_BASE + 8 * 29))

enum { I_X = 0, I_C, I_CTX, I_CCTX, I_ADAW, I_ADAB, I_NORMG, I_SCWIN, I_SCCONV, I_SCWOUT, I_HYWIN, I_HYCONV, I_HYFW1, I_HYFB1, I_HYFW2, I_HYFB2, I_HYFW3, I_HYFREQ, I_HYSKIP, I_HYWOUT,
       I_ATQKV, I_ATQG, I_ATKG, I_ATWO, I_ROUTER, I_WGATE, I_WUP, I_WDOWN };

__device__ __forceinline__ void p0_mod(const Frame& F, const Args& a) {
    LAS float* s = (LAS float*)F.lds;
    LAS float* red = (LAS float*)(F.lds + 9 * 1024 * 4);
    const float* c = KIN(I_C); const float* cc = KIN(I_CCTX);
    { const int t = F.tid_(); f32x4 cv[5];
#pragma unroll
      for (int it = 0; it < 5; ++it) { const int i4 = t + 512 * it, m = i4 >> 8, k = (i4 & 255) * 4; cv[it] = (i4 < 9 * 256) ? *(const f32x4*)(m < 8 ? c + m * 1024 + k : cc + k) : (f32x4){0.f, 0.f, 0.f, 0.f}; }
#pragma unroll
      for (int it = 0; it < 5; ++it) { const int i4 = t + 512 * it; if (i4 < 9 * 256) { const f32x4 v = cv[it];
          *(LAS f32x4*)(s + 4 * i4) = (f32x4){v.x / (1.0f + __expf(-v.x)), v.y / (1.0f + __expf(-v.y)), v.z / (1.0f + __expf(-v.z)), v.w / (1.0f + __expf(-v.w))}; } } }
    __syncthreads();
    float* modv = (float*)(KWS + WS_MODV);
    for (int u = blockIdx.x; u < DEPTH * 96; u += F.G) {
        const int layer = u / 96, col0 = (u % 96) * 64, col = F.tid_() & 63, kp = F.tid_() >> 6;
        const float* w = KIN(I_ADAW) + (size_t)layer * DM * MODW + col0 + col;
        float acc[9];
#pragma unroll
        for (int m = 0; m < 9; ++m) acc[m] = 0.f;
#pragma unroll 32
        for (int k = kp * 128; k < kp * 128 + 128; ++k) { const float wv = w[(size_t)k * MODW];
#pragma unroll
            for (int m = 0; m < 9; ++m) acc[m] += s[m * 1024 + k] * wv; }
#pragma unroll
        for (int m = 0; m < 9; ++m) red[(kp * 9 + m) * 64 + col] = acc[m];
        __syncthreads();
        for (int o = F.tid_(); o < 9 * 64; o += 512) { const int m = o >> 6, cq = o & 63; float t = 0.f;
#pragma unroll
            for (int q = 0; q < 8; ++q) t += red[(q * 9 + m) * 64 + cq];
            modv[((size_t)layer * 9 + m) * MODW + col0 + cq] = t + KIN(I_ADAB)[layer * MODW + col0 + cq]; }
        __syncthreads();
    }
}

__device__ __forceinline__ void transpose_item(const float* W, int K, int N, bf16_t* WT, int k0, int n0, int drow0, LAS float* scr, int lane) {
    float tv[32];
#pragma unroll
    for (int i = 0; i < 32; ++i) tv[i] = W[(size_t)(k0 + 2 * i + (lane >> 5)) * N + n0 + (lane & 31)];
#pragma unroll
    for (int i = 0; i < 32; ++i) scr[(2 * i + (lane >> 5)) * 33 + (lane & 31)] = tv[i];
    LDS_WAIT(); asm volatile("" ::: "memory");
    const int c = lane & 7;
#pragma unroll
    for (int j = 0; j < 4; ++j) { const int n = (lane >> 3) + 8 * j; const LAS float* sp = scr + (8 * c) * 33 + n;
        u32x4 o; o.x = pk2(sp[0 * 33], sp[1 * 33]); o.y = pk2(sp[2 * 33], sp[3 * 33]); o.z = pk2(sp[4 * 33], sp[5 * 33]); o.w = pk2(sp[6 * 33], sp[7 * 33]);
        *(u32x4*)(WT + (size_t)(drow0 + n) * K + k0 + 8 * c) = o; }
    LDS_WAIT(); asm volatile("" ::: "memory");
}
__device__ __forceinline__ void transpose_item_fp8(const float* W, int K, int N, unsigned char* WT, int k0, int n0, int drow0, LAS float* scr, int lane) {
    float tv[32];
#pragma unroll
    for (int i = 0; i < 32; ++i) tv[i] = W[(size_t)(k0 + 2 * i + (lane >> 5)) * N + n0 + (lane & 31)];
#pragma unroll
    for (int i = 0; i < 32; ++i) scr[(2 * i + (lane >> 5)) * 33 + (lane & 31)] = tv[i];
    LDS_WAIT(); asm volatile("" ::: "memory");
    const int c = lane & 7;
#pragma unroll
    for (int j = 0; j < 4; ++j) { const int n = (lane >> 3) + 8 * j; const LAS float* sp = scr + (8 * c) * 33 + n;
        u32x2 o; o.x = pg8::pk4_fp8(sp[0 * 33] * 32.f, sp[1 * 33] * 32.f, sp[2 * 33] * 32.f, sp[3 * 33] * 32.f); o.y = pg8::pk4_fp8(sp[4 * 33] * 32.f, sp[5 * 33] * 32.f, sp[6 * 33] * 32.f, sp[7 * 33] * 32.f);
        *(u32x2*)(WT + (size_t)(drow0 + n) * K + k0 + 8 * c) = o; }
    LDS_WAIT(); asm volatile("" ::: "memory");
}
__device__ __forceinline__ void transpose_scin(const float* W, bf16_t* WT, int item, LAS float* scr, int lane) {
    const int nblk = 3072 / 32, kb = item / nblk, nb = item % nblk, n0 = 32 * nb;
    int d0; if (n0 < 1024) d0 = n0; else if (n0 < 2048) { const int j = n0 - 1024; d0 = 1024 + (j >> 7) * 256 + (j & 127); } else { const int j = n0 - 2048; d0 = 1024 + (j >> 7) * 256 + 128 + (j & 127); }
    transpose_item(W, DM, 3072, WT, 64 * kb, n0, d0, scr, lane);
}
__device__ __forceinline__ void transpose_plain(const float* W, int K, int N, bf16_t* WT, int item, LAS float* scr, int lane) {
    const int nblk = N / 32, kb = item / nblk, nb = item % nblk;
    transpose_item(W, K, N, WT, 64 * kb, 32 * nb, 32 * nb, scr, lane);
}

__device__ __forceinline__ void p0_convert_mixers(const Frame& F, const Args& a) {
    LAS float* scr = (LAS float*)(F.lds + 65536 + F.wave * 8704);
    bf16_t* wm = (bf16_t*)(KWS + WS_WMIX);
    constexpr int I_IN = 16 * 96, I_SQ = 16 * 32, I_QKV = 16 * 48;
    constexpr int NIT = 2 * I_IN + 2 * I_SQ + I_IN + I_SQ + I_QKV + I_SQ;
    for (int it = F.gw; it < NIT; it += F.NGW) {
        int r = it;
        if (r < I_IN) { transpose_scin(KIN(I_SCWIN), wm + WM_SC_IN, r, scr, F.lane_()); continue; } r -= I_IN;
        if (r < I_IN) { transpose_scin(KIN(I_SCWIN) + (size_t)DM * 3072, wm + WM_SC_IN + 3072ull * 1024, r, scr, F.lane_()); continue; } r -= I_IN;
        if (r < I_SQ) { transpose_plain(KIN(I_SCWOUT), DM, DM, wm + WM_SC_OUT, r, scr, F.lane_()); continue; } r -= I_SQ;
        if (r < I_SQ) { transpose_plain(KIN(I_SCWOUT) + (size_t)DM * DM, DM, DM, wm + WM_SC_OUT + 1024ull * 1024, r, scr, F.lane_()); continue; } r -= I_SQ;
        if (r < I_IN) { transpose_plain(KIN(I_HYWIN), DM, 3072, wm + WM_HY_IN, r, scr, F.lane_()); continue; } r -= I_IN;
        if (r < I_SQ) { transpose_plain(KIN(I_HYWOUT), DM, DM, wm + WM_HY_OUT, r, scr, F.lane_()); continue; } r -= I_SQ;
        if (r < I_QKV) { transpose_plain(KIN(I_ATQKV), DM, 1536, wm + WM_AT_QKV, r, scr, F.lane_()); continue; } r -= I_QKV;
        transpose_plain(KIN(I_ATWO), DM, DM, wm + WM_AT_O, r, scr, F.lane_());
    }
}

__device__ __forceinline__ float red16(float v) { v += __shfl_xor(v, 1); v += __shfl_xor(v, 2); v += __shfl_xor(v, 4); v += __shfl_xor(v, 8); return v; }
__device__ __forceinline__ float max16(float v) { v = fmaxf(v, __shfl_xor(v, 1)); v = fmaxf(v, __shfl_xor(v, 2)); v = fmaxf(v, __shfl_xor(v, 4)); v = fmaxf(v, __shfl_xor(v, 8)); return v; }
__device__ __forceinline__ void rowq_load(const float* rowp, int l, f32x4 (&v)[16]) {
#pragma unroll
    for (int j = 0; j < 8; ++j) { const f32x4* p = (const f32x4*)rowp + 2 * (l + 16 * j); v[2 * j] = p[0]; v[2 * j + 1] = p[1]; }
}
__device__ __forceinline__ void rowq_load_bf(const bf16_t* rowp, int l, f32x4 (&v)[16]) {
    u32x4 w[8];
#pragma unroll
    for (int j = 0; j < 8; ++j) w[j] = ((const u32x4*)rowp)[l + 16 * j];
#pragma unroll
    for (int j = 0; j < 8; ++j) { v[2 * j] = (f32x4){bf_lo(w[j].x), bf_hi(w[j].x), bf_lo(w[j].y), bf_hi(w[j].y)}; v[2 * j + 1] = (f32x4){bf_lo(w[j].z), bf_hi(w[j].z), bf_lo(w[j].w), bf_hi(w[j].w)}; }
}
__device__ __forceinline__ void build_ab(const Frame& F, LAS float* At, LAS float* Bt, const float* gvec, const float* modl, int sh_off, int sc_off) {
    const int t = F.tid_();
#pragma unroll
    for (int h = 0; h < 2; ++h) {
        f32x4 g[3], sc[3], sh[3];
#pragma unroll
        for (int k = 0; k < 3; ++k) { const int it = 3 * h + k, i4 = t + 512 * it, m = i4 >> 8, col = (i4 & 255) * 4;
            if (it < 5 && i4 < 9 * DM / 4) { g[k] = *(const f32x4*)(gvec + col); sc[k] = *(const f32x4*)(modl + (size_t)m * MODW + sc_off + col); sh[k] = *(const f32x4*)(modl + (size_t)m * MODW + sh_off + col); }
            else { g[k] = (f32x4){0.f, 0.f, 0.f, 0.f}; sc[k] = g[k]; sh[k] = g[k]; } }
#pragma unroll
        for (int k = 0; k < 3; ++k) { const int it = 3 * h + k, i4 = t + 512 * it, m = i4 >> 8, col = (i4 & 255) * 4;
            if (it < 5 && i4 < 9 * DM / 4) { *(LAS f32x4*)(At + m * DM + col) = g[k] * (1.0f + sc[k]); *(LAS f32x4*)(Bt + m * DM + col) = sh[k]; } }
        asm volatile("" ::: "memory");
    }
}
template <bool FP8 = false>
__device__ __forceinline__ void rowq_norm_store(f32x4 (&v)[16], float ss, const LAS float* At, const LAS float* Bt, int midx, int l, bf16_t* orow) {
    const float rstd = 1.0f / sqrtf(red16(ss) * (1.0f / DM) + EPS);
#pragma unroll
    for (int j = 0; j < 8; ++j) { const int cb = l + 16 * j;
#pragma unroll
        for (int h = 0; h < 2; ++h) { const f32x4 A4 = *(const LAS f32x4*)(At + midx * DM + 8 * cb + 4 * h), B4 = *(const LAS f32x4*)(Bt + midx * DM + 8 * cb + 4 * h);
            v[2 * j + h] = v[2 * j + h] * rstd * A4 + B4; }
        if constexpr (FP8) { u32x2 w; w.x = pg8::pk4_fp8(v[2 * j].x, v[2 * j].y, v[2 * j].z, v[2 * j].w); w.y = pg8::pk4_fp8(v[2 * j + 1].x, v[2 * j + 1].y, v[2 * j + 1].z, v[2 * j + 1].w);
            *(u32x2*)((unsigned char*)orow + 8 * cb) = w; }
        else { u32x4 w; w.x = pk2(v[2 * j].x, v[2 * j].y); w.y = pk2(v[2 * j].z, v[2 * j].w); w.z = pk2(v[2 * j + 1].x, v[2 * j + 1].y); w.w = pk2(v[2 * j + 1].z, v[2 * j + 1].w);
            *(u32x4*)(orow + 8 * cb) = w; } }
}
__device__ __forceinline__ void norm1_phase(const Frame& F, const float* srcL, const float* srcC, int nrows, const float* gvec, const float* modl, bf16_t* hl) {
    LAS float* At = (LAS float*)F.lds; LAS float* Bt = At + 9 * DM;
    __syncthreads(); build_ab(F, At, Bt, gvec, modl, 0, DM); __syncthreads();
    const int l = F.lane_() & 15, rg = F.lane_() >> 4;
    for (int qd = F.gw; qd < nrows / 4; qd += F.NGW) {
        const int row = 4 * qd + rg, midx = row < NLAT ? (row >> 12) : 8;
        const float* xr = row < NLAT ? srcL + (size_t)row * DM : srcC + (size_t)(row - NLAT) * DM;
        f32x4 v[16]; rowq_load(xr, l, v);
        float ss = 0.f;
#pragma unroll
        for (int i = 0; i < 16; ++i) ss += (v[i].x * v[i].x + v[i].y * v[i].y) + (v[i].z * v[i].z + v[i].w * v[i].w);
        rowq_norm_store(v, ss, At, Bt, midx, l, hl + (size_t)row * DM);
    }
}

__device__ __forceinline__ void sc_conv_phase(const Frame& F, const bf16_t* U, const float* convw  , bf16_t* Z, int nrows) {
    const int nitems = (nrows / 8) * 2, lane = F.lane_();
    FOR_ITEMS(it, nitems) {
        const int run = it >> 1, chunk = it & 1, r0 = run * 8, col = chunk * 512 + lane * 8;
        int pos0, slen; if (r0 < NLAT) { pos0 = r0 & (SEQ - 1); slen = SEQ; } else { pos0 = (r0 - NLAT) & (CTXL - 1); slen = CTXL; }
        const bool has_prev = pos0 > 0, has_next = pos0 + 8 < slen;
        u32x4 pp[10], gb[8];
        const bf16_t* base = U + (size_t)r0 * 2048 + col;
#pragma unroll
        for (int i = 0; i < 10; ++i) { const bool ok = (i == 0) ? has_prev : ((i == 9) ? has_next : true);
            if (ok) pp[i] = *(const u32x4*)(base + (ptrdiff_t)(i - 1) * 2048 + DM); else pp[i] = (u32x4){0u, 0u, 0u, 0u}; }
#pragma unroll
        for (int i = 0; i < 8; ++i) gb[i] = *(const u32x4*)(base + (size_t)i * 2048);
        float w0[8], w1[8], w2[8];
#pragma unroll
        for (int j = 0; j < 8; ++j) { w0[j] = convw[col + j]; w1[j] = convw[DM + col + j]; w2[j] = convw[2 * DM + col + j]; }
        float pm[8], pc[8], pn[8];
        auto unp = [&](const u32x4& g, float (&p)[8]) { p[0] = bf_lo(g.x); p[1] = bf_hi(g.x); p[2] = bf_lo(g.y); p[3] = bf_hi(g.y); p[4] = bf_lo(g.z); p[5] = bf_hi(g.z); p[6] = bf_lo(g.w); p[7] = bf_hi(g.w); };
        unp(pp[0], pm); unp(pp[1], pc);
#pragma unroll
        for (int i = 0; i < 8; ++i) {
            unp(pp[i + 2], pn);
            float g[8]; unp(gb[i], g);
            float o[8];
#pragma unroll
            for (int j = 0; j < 8; ++j) o[j] = g[j] * (w0[j] * pm[j] + w1[j] * pc[j] + w2[j] * pn[j]);
            u32x4 w; w.x = pk2(o[0], o[1]); w.y = pk2(o[2], o[3]); w.z = pk2(o[4], o[5]); w.w = pk2(o[6], o[7]);
            *(u32x4*)(Z + (size_t)(r0 + i) * DM + col) = w;
#pragma unroll
            for (int j = 0; j < 8; ++j) { pm[j] = pc[j]; pc[j] = pn[j]; }
        }
    }
}

__device__ __forceinline__ void norm2_router_phase(const Frame& F, const bf16_t* lat, int nrows, const float* gvec, const float* modl, bf16_t* hl,
                                                   const float* wrouter, float* affL, float* affC) {
    LAS float* Wp = (LAS float*)F.lds;
    LAS float* At = Wp + 16 * DM; LAS float* Bt = At + 9 * DM;
    const int lane = F.lane_(), r = lane & 15, q = lane >> 4;
    const int tile0 = (int)(((long)(nrows / 16) * (int)blockIdx.x) / F.G) + F.wave, tile_end = (int)(((long)(nrows / 16) * ((int)blockIdx.x + 1)) / F.G);
    u32x4 bufA[8], bufB[8], xw[16];
#define N2_FETCH(tile_) do { const u32x4* _xr = (const u32x4*)(lat + (size_t)(16 * (tile_) + r) * DM); _Pragma("unroll") for (int i = 0; i < 8; ++i) { bufA[i] = _xr[q + 4 * i]; bufB[i] = _xr[q + 4 * (8 + i)]; } \
        _Pragma("unroll") for (int i = 0; i < 16; ++i) xw[i] = _xr[q + 4 * (16 + i)]; } while (0)
    if (tile0 < tile_end) N2_FETCH(tile0);
    { PB(PT_SUB_GATHER)
    __syncthreads();
    { const int t = F.tid_(); f32x4 wv[8];
#pragma unroll
      for (int it = 0; it < 8; ++it) wv[it] = *(const f32x4*)(wrouter + 4 * (t + 512 * it));
#pragma unroll
      for (int it = 0; it < 8; ++it) { const int i4 = t + 512 * it, col = i4 >> 2, e0 = (i4 & 3) * 4, cb = col >> 3, j = col & 7, q = cb & 3, i = cb >> 2; *(LAS f32x4*)(Wp + ((i * 8 + j) * 4 + q) * 16 + e0) = wv[it]; } }
    build_ab(F, At, Bt, gvec, modl, 3 * DM, 4 * DM);
    __syncthreads();
    PE(PT_SUB_GATHER) }
    for (int tile = tile0; tile < tile_end; tile += 8) {
        const int row = 16 * tile + r, midx = (16 * tile) < NLAT ? ((16 * tile) >> 12) : 8;
        const u32x4* xr = (const u32x4*)(lat + (size_t)row * DM);
        float ss = 0.f;
        if (tile != tile0) N2_FETCH(tile);
        {
#define N2_SQ(v) do { const float a0 = bf_lo((v).x), a1 = bf_hi((v).x), a2 = bf_lo((v).y), a3 = bf_hi((v).y), a4 = bf_lo((v).z), a5 = bf_hi((v).z), a6 = bf_lo((v).w), a7 = bf_hi((v).w); \
              ss += ((a0 * a0 + a1 * a1) + (a2 * a2 + a3 * a3)) + ((a4 * a4 + a5 * a5) + (a6 * a6 + a7 * a7)); } while (0)
#pragma unroll
          for (int i = 0; i < 8; ++i) N2_SQ(bufA[i]);
#pragma unroll
          for (int i = 0; i < 8; ++i) N2_SQ(bufB[i]);
#pragma unroll
          for (int i = 0; i < 16; ++i) N2_SQ(xw[i]);
#undef N2_SQ
        }
        ss += __shfl_xor(ss, 16); ss += __shfl_xor(ss, 32);
        const float rstd = 1.0f / sqrtf(ss * (1.0f / DM) + EPS);
        asm volatile("" ::: "memory");
        f32x4 accA = (f32x4){0.f, 0.f, 0.f, 0.f}, accB = (f32x4){0.f, 0.f, 0.f, 0.f};
        unsigned char* orow = (unsigned char*)hl + (size_t)row * DM;
        const LAS float* atab = At + midx * DM; const LAS float* btab = Bt + midx * DM;
#define N2_BATCH(buf, bt) do { _Pragma("unroll") \
            for (int k = 0; k < 8; ++k) { const int i = 8 * (bt) + k, cb = q + 4 * i; const u32x4 xv = buf[k]; \
                const f32x4 A0 = *(const LAS f32x4*)(atab + 8 * cb), A1 = *(const LAS f32x4*)(atab + 8 * cb + 4), B0 = *(const LAS f32x4*)(btab + 8 * cb), B1 = *(const LAS f32x4*)(btab + 8 * cb + 4); \
                float y[8]; \
                y[0] = bf_lo(xv.x) * rstd * A0.x + B0.x; y[1] = bf_hi(xv.x) * rstd * A0.y + B0.y; y[2] = bf_lo(xv.y) * rstd * A0.z + B0.z; y[3] = bf_hi(xv.y) * rstd * A0.w + B0.w; \
                y[4] = bf_lo(xv.z) * rstd * A1.x + B1.x; y[5] = bf_hi(xv.z) * rstd * A1.y + B1.y; y[6] = bf_lo(xv.w) * rstd * A1.z + B1.z; y[7] = bf_hi(xv.w) * rstd * A1.w + B1.w; \
                u32x2 w8; w8.x = pg8::pk4_fp8(y[0], y[1], y[2], y[3]); w8.y = pg8::pk4_fp8(y[4], y[5], y[6], y[7]); \
                *(u32x2*)(orow + 8 * cb) = w8; \
                const LAS float* wp = Wp + (i * 8) * 64 + lane;            \
                _Pragma("unroll") \
                for (int j = 0; j < 8; j += 2) { accA = __builtin_amdgcn_mfma_f32_16x16x4f32(y[j], wp[j * 64], accA, 0, 0, 0); accB = __builtin_amdgcn_mfma_f32_16x16x4f32(y[j + 1], wp[(j + 1) * 64], accB, 0, 0, 0); } \
                asm volatile("" ::: "memory");            \
            } } while (0)
        N2_BATCH(bufA, 0);
#pragma unroll
        for (int k = 0; k < 8; ++k) bufA[k] = xr[q + 4 * (16 + k)];
        N2_BATCH(bufB, 1);
#pragma unroll
        for (int k = 0; k < 8; ++k) bufB[k] = xr[q + 4 * (24 + k)];
        N2_BATCH(bufA, 2);
        N2_BATCH(bufB, 3);
#undef N2_BATCH
        const f32x4 lg = accA + accB;
        float af[4];
#pragma unroll
        for (int k = 0; k < 4; ++k) { const float mx = max16(lg[k]), ex = __expf(lg[k] - mx); af[k] = ex / red16(ex); }
        const int e = lane & 15, row4 = 16 * tile + 4 * (lane >> 4);
        if (row4 < NLAT) *(f32x4*)(affL + ((size_t)((row4 >> 12) * NE + e) << 12) + (row4 & (SEQ - 1))) = (f32x4){af[0], af[1], af[2], af[3]};
        else { const int rc = row4 - NLAT; *(f32x4*)(affC + ((size_t)((rc >> 8) * NE + e) << 8) + (rc & (CTXL - 1))) = (f32x4){af[0], af[1], af[2], af[3]}; }
    }
}

__device__ __forceinline__ int block_excl_scan(int v, LAS int* tmp, int lane, int wave, int& total) {
    int incl = v;
#pragma unroll
    for (int o = 1; o < 64; o <<= 1) { const int t = __shfl_up(incl, o); if (lane >= o) incl += t; }
    if (lane == 63) tmp[wave] = incl;
    __syncthreads();
    int woff = 0, tot = 0;
#pragma unroll
    for (int w = 0; w < 8; ++w) { const int t = tmp[w]; tot += t; if (w < wave) woff += t; }
    __syncthreads();
    total = tot;
    return woff + incl - v;
}
__device__ __forceinline__ void topk_unit(const Frame& F, const float* aff, int N, int K, int e, int rbase, int tokbase, int* rowlist, float* gl, int* slotmap, const unsigned char* HL8, unsigned char* XG) {
    LAS int* sm = (LAS int*)F.lds;
    const int t = F.tid_(), lane = F.lane_(), wave = F.wave;
    unsigned vb[8];
    if (t * 8 < N) { const u32x4 q0 = *(const u32x4*)(aff + t * 8), q1 = *(const u32x4*)(aff + t * 8 + 4);
        vb[0] = q0.x; vb[1] = q0.y; vb[2] = q0.z; vb[3] = q0.w; vb[4] = q1.x; vb[5] = q1.y; vb[6] = q1.z; vb[7] = q1.w; }
    else {
#pragma unroll
        for (int j = 0; j < 8; ++j) vb[j] = 0u; }
    unsigned T = 0u;
#pragma unroll 1
    for (int g = 0; g < 11; ++g) {
        const int shift = g < 10 ? 28 - 3 * g : 0, nm = g < 10 ? 7 : 1;
        LAS int* cb = sm + (g & 1) * 64;
#pragma unroll 1
        for (int m = 0; m < nm; ++m) { const unsigned cand = T | ((unsigned)(m + 1) << shift); int c = 0;
#pragma unroll
            for (int j = 0; j < 8; ++j) c += (int)__popcll(__ballot(vb[j] >= cand));
            if (lane == 0) cb[wave * 8 + m] = c; }
        __syncthreads();
        pg8::i32x4 t0 = *(const LAS pg8::i32x4*)cb, t1 = *(const LAS pg8::i32x4*)(cb + 4);
#pragma unroll
        for (int w = 1; w < 8; ++w) { const pg8::i32x4 q0 = *(const LAS pg8::i32x4*)(cb + w * 8), q1 = *(const LAS pg8::i32x4*)(cb + w * 8 + 4);
            t0.x += q0.x; t0.y += q0.y; t0.z += q0.z; t0.w += q0.w; t1.x += q1.x; t1.y += q1.y; t1.z += q1.z; }
        int ms = (t0.x >= K) ? 1 : 0;
        if (nm > 1) ms += ((t0.y >= K) ? 1 : 0) + ((t0.z >= K) ? 1 : 0) + ((t0.w >= K) ? 1 : 0) + ((t1.x >= K) ? 1 : 0) + ((t1.y >= K) ? 1 : 0) + ((t1.z >= K) ? 1 : 0);
        T = (unsigned)__builtin_amdgcn_readfirstlane((int)(T | ((unsigned)ms << shift)));
    }
    __syncthreads();
    int ngt = 0, neq = 0;
#pragma unroll
    for (int j = 0; j < 8; ++j) { ngt += (vb[j] > T) ? 1 : 0; neq += (vb[j] == T) ? 1 : 0; }
    int tot_pk;
    const int pre_pk = block_excl_scan((ngt << 16) | neq, sm + 16, lane, wave, tot_pk);
    const int tot_gt = tot_pk >> 16, gt_pre = pre_pk >> 16, eq_pre = pre_pk & 0xffff;
    const int need_eq = K - tot_gt;
    int sel[8], nsel = 0, eqr = eq_pre;
#pragma unroll
    for (int j = 0; j < 8; ++j) { int s = 0; if (vb[j] > T) s = 1; else if (vb[j] == T) { s = (eqr < need_eq) ? 1 : 0; ++eqr; } sel[j] = s; nsel += s; }
    int slot = gt_pre + (eq_pre < need_eq ? eq_pre : need_eq);
    (void)nsel;
    if (t * 8 < N) {
#pragma unroll
        for (int j = 0; j < 8; ++j) { const int row = tokbase + t * 8 + j;
            if (sel[j]) { const int pos = rbase + slot; rowlist[pos] = row; gl[pos] = __uint_as_float(vb[j]); slotmap[row * NE + e] = pos; ++slot; }
            else slotmap[row * NE + e] = -1; }
    }
    __syncthreads();
    (void)HL8; (void)XG;
}
constexpr int MOE_QL = 24576;
__device__ __forceinline__ constexpr size_t moe_wup_off(int wb) { return wb == 2 ? WS_END : WS_WMOE + (size_t)wb * 32 * MiB; }
__device__ __forceinline__ constexpr size_t moe_wdn_off(int wb) { return wb == 2 ? WS_END + 32 * MiB : WS_WMOE_DN + (size_t)wb * 16 * MiB; }
__device__ __forceinline__ void moe_convert_item(const Frame& F, int q) {
    LAS float* scr = (LAS float*)(F.lds + 65536 + F.wave * 8704);
    const int layer = (q >= MOE_QL) + (q >= 2 * MOE_QL) + (q >= 3 * MOE_QL), it = q - layer * MOE_QL, wb = layer == 3 ? 0 : layer;
    unsigned char* wup = KWS + moe_wup_off(wb); unsigned char* wdn = KWS + moe_wdn_off(wb);
    if (it < 16384) { const int e = it >> 10, r = it & 1023, half = r >> 9, q = r & 511, kb = q >> 5, nb = q & 31, n0 = nb * 32;
        const float* W = (half ? KIN(I_WUP) : KIN(I_WGATE)) + ((size_t)(layer * NE + e) << 20);
        transpose_item_fp8(W, DM, DM, wup + ((size_t)e << 21), kb * 64, n0, (n0 >> 7) * 256 + half * 128 + (n0 & 127), scr, F.lane_()); }
    else { const int r = it - 16384, e = r >> 9, q = r & 511, kb = q >> 5, nb = q & 31;
        const float* W = KIN(I_WDOWN) + ((size_t)(layer * NE + e) << 20);
        transpose_item_fp8(W, DM, DM, wdn + ((size_t)e << 20), kb * 64, nb * 32, nb * 32, scr, F.lane_()); }
}
__device__ __forceinline__ void moe_convert_tail(const Frame& F, int first_blk, int it0, int it1) {
    if (F.G != 256 || (int)blockIdx.x < first_blk) return;
    const int nw = (256 - first_blk) * 8, w = ((int)blockIdx.x - first_blk) * 8 + F.wave;
    for (int it = it0 + w; it < it1; it += nw) moe_convert_item(F, it);
}
__device__ __forceinline__ void topk_convert_phase(const Frame& F, const Args& a, int layer, bool with_ctx, const float* affL, const float* affC, int* rowlist, float* gl, int* slotmap, const unsigned char* HL8, unsigned char* XG, int q0, int q1, int q2) {
    const int RE = with_ctx ? (REL + REC) : REL;
    const int nunits = with_ctx ? 256 : 128;
    PB(PT_SUB_TOPKU)
    for (int u = blockIdx.x; u < nunits; u += F.G) {
        if (u < 128) { const int b = u >> 4, e = u & 15; topk_unit(F, affL + ((size_t)(b * NE + e) << 12), SEQ, CAPL, e, e * RE + b * CAPL, b * SEQ, rowlist, gl, slotmap, HL8, XG); }
        else { const int v = u - 128, b = v >> 4, e = v & 15; topk_unit(F, affC + ((size_t)(b * NE + e) << 8), CTXL, CAPC, e, e * RE + REL + b * CAPC, NLAT + b * CTXL, rowlist, gl, slotmap, HL8, XG); }
        __syncthreads();
    }
    __syncthreads();
    PE(PT_SUB_TOPKU)
    const bool deal = F.G == 256;
    const int slow = blockIdx.x < 128, wv = (blockIdx.x & 127) * 8 + F.wave;
    const unsigned it_first = (unsigned)((deal && slow) ? q1 : q0), it_end = (unsigned)((deal && !slow) ? q1 : q2);
    for (unsigned it0 = it_first + (deal ? 0u : (unsigned)F.gw); it0 < it_end; it0 += deal ? (slow ? 1024u : 2048u) : (unsigned)F.NGW) {
        unsigned it = it0;
        if (deal) { if (slow) it = it0 + wv; else { it = it0 + 2 * wv; } }
        for (int rep = 0; rep < ((deal && !slow) ? 2 : 1); ++rep, ++it) if (it < it_end) moe_convert_item(F, (int)it);
    }
}

__device__ __forceinline__ void combine_phase(const Frame& F, bf16_t* lat, int nrows, const bf16_t* YS, const int* slotmap, const float* gl, const float* modl,
                                              bool final_layer, float* out, const float* gnext, const float* modnext, bf16_t* hl) {
    LAS float* At = (LAS float*)F.lds; LAS float* Bt = At + 9 * DM; LAS float* Gt = Bt + 9 * DM;
    __syncthreads();
    if (!final_layer) build_ab(F, At, Bt, gnext, modnext, 0, DM);
    { const int t = F.tid_(); f32x4 gq[5];
#pragma unroll
      for (int it = 0; it < 5; ++it) { const int i4 = t + 512 * it, m = i4 >> 8, col = (i4 & 255) * 4; gq[it] = (i4 < 9 * DM / 4) ? *(const f32x4*)(modl + (size_t)m * MODW + 5 * DM + col) : (f32x4){0.f, 0.f, 0.f, 0.f}; }
#pragma unroll
      for (int it = 0; it < 5; ++it) { const int i4 = t + 512 * it, m = i4 >> 8, col = (i4 & 255) * 4; if (i4 < 9 * DM / 4) *(LAS f32x4*)(Gt + m * DM + col) = gq[it] * 0.0625f; } }
    __syncthreads();
    const int lane = F.lane_(), l = lane & 15, rg = lane >> 4;
    for (int qd = F.gw; qd < nrows / 4; qd += F.NGW) {
        const int row = 4 * qd + rg, midx = row < NLAT ? (row >> 12) : 8;
        const int mypos = slotmap[row * NE + l];
        const float myg = mypos >= 0 ? gl[mypos] : 0.f;
        f32x4 v[16]; rowq_load_bf(lat + (size_t)row * DM, l, v);
        f32x4 acc[16];
#pragma unroll
        for (int i = 0; i < 16; ++i) acc[i] = (f32x4){0.f, 0.f, 0.f, 0.f};
        unsigned m16 = (unsigned)((__ballot(mypos >= 0) >> (16 * rg)) & 0xffffull);
        while (__any(m16 != 0u)) {
            const int e = m16 ? (__builtin_ctz(m16)) : 0; const bool act = m16 != 0u; m16 &= m16 - 1u;
            const int pos = __shfl(mypos, rg * 16 + e); const float ge = __shfl(myg, rg * 16 + e);
            if (act) { const u32x2* yr = (const u32x2*)((const unsigned char*)YS + (size_t)pos * DM);
                u32x2 w[8];
#pragma unroll
                for (int j = 0; j < 8; ++j) w[j] = yr[l + 16 * j];
#pragma unroll
                for (int j = 0; j < 8; ++j) { const f32x2 a0 = __builtin_amdgcn_cvt_pk_f32_fp8((int)w[j].x, false), a1 = __builtin_amdgcn_cvt_pk_f32_fp8((int)w[j].x, true),
                                                          a2 = __builtin_amdgcn_cvt_pk_f32_fp8((int)w[j].y, false), a3 = __builtin_amdgcn_cvt_pk_f32_fp8((int)w[j].y, true);
                    acc[2 * j] += (f32x4){a0.x, a0.y, a1.x, a1.y} * ge; acc[2 * j + 1] += (f32x4){a2.x, a2.y, a3.x, a3.y} * ge; } }
        }
        float ss = 0.f;
#pragma unroll
        for (int j = 0; j < 8; ++j)
#pragma unroll
            for (int h = 0; h < 2; ++h) { const f32x4 g2 = *(const LAS f32x4*)(Gt + midx * DM + 8 * (l + 16 * j) + 4 * h);
                const f32x4 x = v[2 * j + h] + g2 * acc[2 * j + h]; v[2 * j + h] = x; ss += (x.x * x.x + x.y * x.y) + (x.z * x.z + x.w * x.w); }
        if (final_layer) { float* orow = out + (size_t)row * DM;
#pragma unroll
            for (int j = 0; j < 8; ++j) { f32x4* p = (f32x4*)orow + 2 * (l + 16 * j); p[0] = v[2 * j]; p[1] = v[2 * j + 1]; }
        } else { u32x4* orow = (u32x4*)(lat + (size_t)row * DM);
#pragma unroll
            for (int j = 0; j < 8; ++j) { u32x4 w; w.x = pk2(v[2 * j].x, v[2 * j].y); w.y = pk2(v[2 * j].z, v[2 * j].w); w.z = pk2(v[2 * j + 1].x, v[2 * j + 1].y); w.w = pk2(v[2 * j + 1].z, v[2 * j + 1].w); orow[l + 16 * j] = w; }
        }
        if (!final_layer) rowq_norm_store(v, ss, At, Bt, midx, l, hl + (size_t)row * DM);
    }
}

__device__ __forceinline__ void attn_prep_phase(const Frame& F, bf16_t* U, const float* qg, const float* kg, bf16_t* Kb, bf16_t* Vb) {
    LAS f32x2* T = (LAS f32x2*)F.lds;
    __syncthreads();
    for (int idx = F.tid_(); idx < 2048; idx += 512) { const int pos = idx >> 5, f = idx & 31; float s, c; sincosf((float)pos * exp2f(-(float)f * (13.287712379549449f / 32.0f)), &s, &c); T[idx] = (f32x2){c, s}; }
    __syncthreads();
    const int lane = F.lane_(), l = lane & 15, rg = lane >> 4, blk = l >> 3, sub = l & 7, e0 = blk * 64 + sub * 4;
    float gq[8], gk[8];
#pragma unroll
    for (int j = 0; j < 4; ++j) { gq[j] = qg[e0 + j]; gq[4 + j] = qg[e0 + 32 + j]; gk[j] = kg[e0 + j]; gk[4 + j] = kg[e0 + 32 + j]; }
    FOR_ITEMS(qd, MALL / 4) {
        const int row = 4 * qd + rg; const bool lat = (4 * qd) < NLAT;
        bf16_t* ur = U + (size_t)row * 1536;
        int b, t; if (lat) { b = row >> 12; t = row & (SEQ - 1); } else { b = (row - NLAT) >> 8; t = (row - NLAT) & (CTXL - 1); }
        const size_t krow = (size_t)(b * (CTXL + SEQ) + (lat ? CTXL + t : t)) * 256;
        u32x2 xlo[12], xhi[12];
#pragma unroll
        for (int h = 0; h < 12; ++h) { if (lat || h >= 8) { xlo[h] = *(const u32x2*)(ur + h * 128 + e0); xhi[h] = *(const u32x2*)(ur + h * 128 + e0 + 32); } }
        f32x2 cs[4];
        if (lat) { const int pos = blk ? (t & 63) : (t >> 6);
#pragma unroll
            for (int j = 0; j < 4; ++j) cs[j] = T[pos * 32 + sub * 4 + j]; }
#pragma unroll
        for (int h = 0; h < 10; ++h) {
            if (!lat && h < 8) continue;
            float x[8] = {bf_lo(xlo[h].x), bf_hi(xlo[h].x), bf_lo(xlo[h].y), bf_hi(xlo[h].y), bf_lo(xhi[h].x), bf_hi(xhi[h].x), bf_lo(xhi[h].y), bf_hi(xhi[h].y)};
            float ss = 0.f;
#pragma unroll
            for (int j = 0; j < 8; ++j) ss += x[j] * x[j];
            const float rstd = 1.0f / sqrtf(red16(ss) * (1.0f / 128.0f) + EPS);
#pragma unroll
            for (int j = 0; j < 8; ++j) x[j] = x[j] * rstd * (h < 8 ? gq[j] : gk[j]);
            if (lat) {
#pragma unroll
                for (int j = 0; j < 4; ++j) { const float lo = x[j], hi = x[4 + j]; x[j] = lo * cs[j].x - hi * cs[j].y; x[4 + j] = hi * cs[j].x + lo * cs[j].y; } }
            u32x2 olo, ohi; olo.x = pk2(x[0], x[1]); olo.y = pk2(x[2], x[3]); ohi.x = pk2(x[4], x[5]); ohi.y = pk2(x[6], x[7]);
            if (h < 8) { *(u32x2*)(ur + h * 128 + e0) = olo; *(u32x2*)(ur + h * 128 + e0 + 32) = ohi; }
            else { *(u32x2*)(Kb + krow + (h - 8) * 128 + e0) = olo; *(u32x2*)(Kb + krow + (h - 8) * 128 + e0 + 32) = ohi; }
        }
#pragma unroll
        for (int h = 0; h < 2; ++h) { *(u32x2*)(Vb + krow + h * 128 + e0) = xlo[10 + h]; *(u32x2*)(Vb + krow + h * 128 + e0 + 32) = xhi[10 + h]; }
    }
}
__device__ __forceinline__ void attn_phase(const Frame& F, const bf16_t* U, const bf16_t* Kb, const bf16_t* Vb, bf16_t* Z) {
    for (int i = 0; i < 1024; ++i) {
        int u;
        if (F.G == 256) { if (i >= 4) break; u = (blockIdx.x & 7) * 128 + i * 32 + (blockIdx.x >> 3); }
        else { u = blockIdx.x + i * F.G; if (u >= 1024) break; }
        const int pair = u >> 6, within = u & 63, g = within >> 4, qb = within & 15, b = pair >> 1, kvh = pair & 1, h = kvh * 4 + g;
        att::attn_dense_body(U + (size_t)(b * SEQ + qb * 256) * 1536 + h * 128, Kb + (size_t)b * (CTXL + SEQ) * 256 + kvh * 128, Vb + (size_t)b * (CTXL + SEQ) * 256 + kvh * 128,
                             Z + (size_t)(b * SEQ + qb * 256) * DM + h * 128, CTXL + SEQ, (char*)((unsigned char*)F.lds));
        __syncthreads();
    }
}


constexpr float HY_DLO = -3.0701134573253944f, HY_DHI = -15.350567286626972f;
__device__ __forceinline__ void p0_hyena_tables(const Frame& F, const Args& a) {
    float* a2L = (float*)(KWS + WS_A2); float* a2C = (float*)(KWS + WS_A2C); f32x2* tw = (f32x2*)(KWS + WS_TW);
    const float* w1 = KIN(I_HYFW1); const float* b1 = KIN(I_HYFB1); const float* w2 = KIN(I_HYFW2); const float* b2 = KIN(I_HYFB2); const float* fr = KIN(I_HYFREQ);
    const int j = F.lane_(); const float fj = fr[j];
    for (int item = F.gw; item < SEQ + CTXL; item += F.NGW) {
        const int L = item < SEQ ? SEQ : CTXL, lag = item < SEQ ? item : item - SEQ;
        const float t = (float)lag / (float)(L - 1);
        float acc = b1[j] + t * w1[j];
        const float base = (6.283185307179586f / (float)L) * (float)lag;
#pragma unroll 4
        for (int k = 0; k < 16; ++k) { const float band = 1e-4f + (float)k * ((15.0f - 1e-4f) / 15.0f); float s, c; sincosf(base * band, &s, &c);
            acc += c * w1[(1 + k) * 64 + j] - s * w1[(17 + k) * 64 + j]; }
        const float a1 = sinf(fj * acc);
        float acc2 = b2[j];
#pragma unroll 8
        for (int i = 0; i < 64; ++i) acc2 += __shfl(a1, i) * w2[i * 64 + j];
        const float a2 = sinf(fj * acc2);
        (item < SEQ ? a2L : a2C)[(size_t)lag * 64 + j] = a2;
    }
    for (int k = blockIdx.x * 512 + F.tid_(); k < 2048; k += F.G * 512) { float s, c; sincospif((float)k * (1.0f / 4096.0f), &s, &c); tw[k] = (f32x2){c, -s}; }
}


__device__ __forceinline__ void hy_filter_table_phase(const Frame& F, const Args& a, int tile_first, int tile_step) {
    LAS float* a2t = (LAS float*)F.lds;
    LAS float* w3t = (LAS float*)(F.lds + 16640);
    const float* w3 = KIN(I_HYFW3);
    float* HT = (float*)(KWS + WS_HT); float* HTC = (float*)(KWS + WS_HTC);
    const int tid = F.tid_(), lane = F.lane_(), wave = F.wave;
    for (int tile = tile_first; tile < 68 * 16; tile += tile_step) {
        const int lt = tile >> 4, ct = tile & 15, col0 = ct * 256;
        const bool isL = lt < 64; const int L = isL ? SEQ : CTXL, lag0 = isL ? lt * 64 : (lt - 64) * 64;
        const float* a2 = isL ? (const float*)(KWS + WS_A2) : (const float*)(KWS + WS_A2C);
        __syncthreads();
        { f32x4 av4[2], wv4[8];
#pragma unroll
          for (int it = 0; it < 2; ++it) av4[it] = *(const f32x4*)(a2 + (size_t)lag0 * 64 + 4 * (tid + 512 * it));
#pragma unroll
          for (int it = 0; it < 8; ++it) { const int i4 = tid + 512 * it, k = i4 >> 6, j4 = (i4 & 63) * 4; wv4[it] = *(const f32x4*)(w3 + (size_t)k * 4096 + col0 + j4); }
#pragma unroll
          for (int it = 0; it < 2; ++it) { const int i4 = tid + 512 * it, lg = i4 >> 4, k = (i4 & 15) * 4; a2t[k * 65 + lg] = av4[it].x; a2t[(k + 1) * 65 + lg] = av4[it].y; a2t[(k + 2) * 65 + lg] = av4[it].z; a2t[(k + 3) * 65 + lg] = av4[it].w; }
#pragma unroll
          for (int it = 0; it < 8; ++it) *(LAS f32x4*)(w3t + 4 * (tid + 512 * it)) = wv4[it]; }
        __syncthreads();
        const int mi = lane & 15, mq = lane >> 4, ls = wave & 3, cs0 = (wave >> 2) * 8;
        float av[16];
#pragma unroll
        for (int s = 0; s < 16; ++s) av[s] = a2t[(16 * mq + s) * 65 + 16 * ls + mi];
        const int dir = col0 >> 11, o = (col0 >> 10) & 1;
        const int lagb = lag0 + 16 * ls + 4 * mq;
#pragma unroll 2
        for (int cs = 0; cs < 8; ++cs) {
            f32x4 accA = (f32x4){0.f, 0.f, 0.f, 0.f}, accB = (f32x4){0.f, 0.f, 0.f, 0.f};
            const LAS float* wp = w3t + (16 * mq) * 256 + (cs0 + cs) * 16 + mi;
#pragma unroll
            for (int s = 0; s < 16; s += 2) { accA = __builtin_amdgcn_mfma_f32_16x16x4f32(av[s], wp[s * 256], accA, 0, 0, 0); accB = __builtin_amdgcn_mfma_f32_16x16x4f32(av[s + 1], wp[(s + 1) * 256], accB, 0, 0, 0); }
            const f32x4 acc = accA + accB;
            const int c = (col0 & 1023) + (cs0 + cs) * 16 + mi; const float delta = fabsf(HY_DLO + (float)c * ((HY_DHI - HY_DLO) / 1023.0f));
            float* hb = isL ? HT + ((size_t)(o * DM + c) << 13) : HTC + ((size_t)(o * DM + c) << 9);
#pragma unroll
            for (int r = 0; r < 4; ++r) { const int lag = lagb + r; const float v = acc[r] * __expf(-((float)lag / (float)(L - 1)) * delta);
                if (dir == 0) hb[lag] = v; else if (lag > 0) hb[2 * L - lag] = v; }
        }
    }
}

__device__ __forceinline__ void hy_dwconv_phase(const Frame& F, const bf16_t* U, const float* convw, bf16_t* XTL, bf16_t* XTC) {
    LAS unsigned* tile2 = (LAS unsigned*)(F.lds + F.wave * 16896);
    const int lane = F.lane_(), rr = lane >> 3, cq = lane & 7;
    constexpr int NITEMS = (MALL / 64) * 24;
    FOR_ITEMS(it, NITEMS) {
        const int rb = it / 24, cb = it - rb * 24, r0 = rb * 64, ch0 = cb * 128;
        int b, pos0, slen; if (r0 < NLAT) { b = r0 >> 12; pos0 = r0 & (SEQ - 1); slen = SEQ; } else { const int rc = r0 - NLAT; b = rc >> 8; pos0 = rc & (CTXL - 1); slen = CTXL; }
        const bf16_t* up = U + (size_t)r0 * 3072 + ch0 + 2 * lane;
        unsigned x[66];
#pragma unroll
        for (int i = 0; i < 66; ++i) { const bool ok = (i == 0) ? (pos0 > 0) : ((i == 65) ? (pos0 + 64 < slen) : true); x[i] = ok ? *(const unsigned*)(up + (ptrdiff_t)(i - 1) * 3072) : 0u; }
        const float* wp = convw + ch0 + 2 * lane;
        const float w0a = wp[0], w0b = wp[1], w1a = wp[3072], w1b = wp[3073], w2a = wp[6144], w2b = wp[6145];
#pragma unroll
        for (int t = 0; t < 64; t += 2) {
            const float a0 = w0a * bf_lo(x[t]) + w1a * bf_lo(x[t + 1]) + w2a * bf_lo(x[t + 2]), a1 = w0a * bf_lo(x[t + 1]) + w1a * bf_lo(x[t + 2]) + w2a * bf_lo(x[t + 3]);
            const float b0 = w0b * bf_hi(x[t]) + w1b * bf_hi(x[t + 1]) + w2b * bf_hi(x[t + 2]), b1 = w0b * bf_hi(x[t + 1]) + w1b * bf_hi(x[t + 2]) + w2b * bf_hi(x[t + 3]);
            tile2[(2 * lane) * 33 + (t >> 1)] = pk2(a0, a1); tile2[(2 * lane + 1) * 33 + (t >> 1)] = pk2(b0, b1); }
        LDS_WAIT(); asm volatile("" ::: "memory");
        const int part = ch0 >> 10, c0 = ch0 & 1023;
        bf16_t* ob = (r0 < NLAT) ? XTL + ((size_t)((part * NB + b) * DM + c0) << 12) + pos0 : XTC + ((size_t)((part * NB + b) * DM + c0) << 8) + pos0;
#pragma unroll
        for (int g = 0; g < 16; ++g) { const int c = g * 8 + rr; u32x4 o; const LAS unsigned* sp = tile2 + c * 33 + cq * 4; o.x = sp[0]; o.y = sp[1]; o.z = sp[2]; o.w = sp[3];
            *(u32x4*)(ob + (size_t)c * slen + cq * 8) = o; }
        LDS_WAIT(); asm volatile("" ::: "memory");
    }
}

__device__ __forceinline__ void hy_untranspose_phase(const Frame& F, const bf16_t* zTL, const bf16_t* zTC, bf16_t* Z) {
    LAS unsigned* tile = (LAS unsigned*)(F.lds + F.wave * 8448);
    const int lane = F.lane_(), hi8 = lane >> 3, lo8 = lane & 7;
    constexpr int NITL = NB * 16 * 64, NITC = NB * 16 * 4;
    FOR_ITEMS(it, NITL + NITC) {
        int b, cb, tb, slen; const bf16_t* src; int rowbase;
        if (it < NITL) { b = it >> 10; cb = (it >> 6) & 15; tb = it & 63; slen = SEQ; src = zTL; rowbase = b * SEQ; }
        else { const int i2 = it - NITL; b = i2 >> 6; cb = (i2 >> 2) & 15; tb = i2 & 3; slen = CTXL; src = zTC; rowbase = NLAT + b * CTXL; }
        const int c0 = cb * 64, t0 = tb * 64;
#pragma unroll
        for (int g = 0; g < 8; ++g) { const int c = g * 8 + hi8;
            const u32x4 v = *(const u32x4*)(src + (size_t)(b * DM + c0 + c) * slen + t0 + lo8 * 8);
            LAS unsigned* tp = tile + c * 33 + lo8 * 4; tp[0] = v.x; tp[1] = v.y; tp[2] = v.z; tp[3] = v.w; }
        LDS_WAIT(); asm volatile("" ::: "memory");
#pragma unroll
        for (int g = 0; g < 8; ++g) { const int t = g * 8 + hi8; unsigned e[8];
#pragma unroll
            for (int i = 0; i < 8; ++i) { const unsigned w = tile[(lo8 * 8 + i) * 33 + (t >> 1)]; e[i] = (t & 1) ? (w >> 16) : (w & 0xffffu); }
            u32x4 o; o.x = e[0] | (e[1] << 16); o.y = e[2] | (e[3] << 16); o.z = e[4] | (e[5] << 16); o.w = e[6] | (e[7] << 16);
            *(u32x4*)(Z + (size_t)(rowbase + t0 + t) * DM + c0 + lo8 * 8) = o; }
        LDS_WAIT(); asm volatile("" ::: "memory");
    }
}

constexpr int FFT_N = 8192;
__device__ __forceinline__ int PX(int i) { return i + (i >> 5); }
__device__ __forceinline__ f32x2 cmul(f32x2 a, f32x2 b) { return (f32x2){a.x * b.x - a.y * b.y, a.x * b.y + a.y * b.x}; }
__device__ __forceinline__ f32x2 cmulc(f32x2 a, f32x2 w) { return (f32x2){a.x * w.x + a.y * w.y, a.y * w.x - a.x * w.y}; }
__device__ __forceinline__ f32x2 twv(const LAS f32x2* TW, int k) { const f32x2 t = TW[k & 2047]; return (k & 2048) ? (f32x2){t.y, -t.x} : t; }
template <int J, bool CONJ> __device__ __forceinline__ f32x2 mulc16(f32x2 a) {
    constexpr float CR[8] = {1.0f, 0.92387953251128674f, 0.70710678118654752f, 0.38268343236508977f, 0.0f, -0.38268343236508977f, -0.70710678118654752f, -0.92387953251128674f};
    constexpr float CI[8] = {0.0f, -0.38268343236508977f, -0.70710678118654752f, -0.92387953251128674f, -1.0f, -0.92387953251128674f, -0.70710678118654752f, -0.38268343236508977f};
    if constexpr (J == 0) return a;
    else if constexpr (J == 4) return CONJ ? (f32x2){-a.y, a.x} : (f32x2){a.y, -a.x};
    else { constexpr float cr = CR[J], ci = CONJ ? -CI[J] : CI[J]; return (f32x2){a.x * cr - a.y * ci, a.x * ci + a.y * cr}; }
}
template <int H, int M, int E, bool INV> __device__ __forceinline__ void bfly(f32x2 (&v)[16]) {
    if constexpr (!(E & H)) { constexpr int J = (E & (H - 1)) << M;
        if constexpr (!INV) { const f32x2 x = v[E], y = v[E + H]; v[E] = x + y; v[E + H] = mulc16<J, false>(x - y); }
        else { const f32x2 x = v[E], y = mulc16<J, true>(v[E + H]); v[E] = x + y; v[E + H] = x - y; } }
}
template <int H, int M, bool INV> __device__ __forceinline__ void stage16(f32x2 (&v)[16]) {
    bfly<H, M, 0, INV>(v); bfly<H, M, 1, INV>(v); bfly<H, M, 2, INV>(v); bfly<H, M, 3, INV>(v); bfly<H, M, 4, INV>(v); bfly<H, M, 5, INV>(v); bfly<H, M, 6, INV>(v); bfly<H, M, 7, INV>(v);
    bfly<H, M, 8, INV>(v); bfly<H, M, 9, INV>(v); bfly<H, M, 10, INV>(v); bfly<H, M, 11, INV>(v); bfly<H, M, 12, INV>(v); bfly<H, M, 13, INV>(v); bfly<H, M, 14, INV>(v); bfly<H, M, 15, INV>(v);
}
template <bool INV> __device__ __forceinline__ void r16(f32x2 (&v)[16], f32x2 b) {
    f32x2 p[16];
    p[1] = b; p[2] = cmul(b, b); p[3] = cmul(p[2], b); p[4] = cmul(p[2], p[2]); p[5] = cmul(p[4], b); p[6] = cmul(p[3], p[3]); p[7] = cmul(p[6], b);
    p[8] = cmul(p[4], p[4]); p[9] = cmul(p[8], b); p[10] = cmul(p[5], p[5]); p[11] = cmul(p[10], b); p[12] = cmul(p[6], p[6]); p[13] = cmul(p[12], b); p[14] = cmul(p[7], p[7]); p[15] = cmul(p[14], b);
    constexpr int REV[16] = {0, 8, 4, 12, 2, 10, 6, 14, 1, 9, 5, 13, 3, 11, 7, 15};
    if constexpr (!INV) {
        stage16<8, 0, false>(v); stage16<4, 1, false>(v); stage16<2, 2, false>(v); stage16<1, 3, false>(v);
#pragma unroll
        for (int e = 1; e < 16; ++e) v[e] = cmul(v[e], p[REV[e]]);
    } else {
#pragma unroll
        for (int e = 1; e < 16; ++e) v[e] = cmulc(v[e], p[REV[e]]);
        stage16<1, 3, true>(v); stage16<2, 2, true>(v); stage16<4, 1, true>(v); stage16<8, 0, true>(v);
    }
}
template <bool INV> __device__ __forceinline__ void fft_pass16(LAS f32x2* X, const LAS f32x2* TW, int ls, int tid) {
    const int lst = ls - 3, pos = tid & ((1 << lst) - 1), g = tid >> lst, ibase = (g << (ls + 1)) + pos;
    f32x2 v[16];
#pragma unroll
    for (int e = 0; e < 16; ++e) v[e] = X[PX(ibase + (e << lst))];
    r16<INV>(v, twv(TW, pos << (12 - ls)));
#pragma unroll
    for (int e = 0; e < 16; ++e) X[PX(ibase + (e << lst))] = v[e];
    __syncthreads();
}

template <int J, bool CONJ> __device__ __forceinline__ f32x2 mulc32(f32x2 a) {
    constexpr float CR[16] = {1.000000000e+00f, 9.807852804e-01f, 9.238795325e-01f, 8.314696123e-01f, 7.071067812e-01f, 5.555702330e-01f, 3.826834324e-01f, 1.950903220e-01f, 6.123233996e-17f, -1.950903220e-01f, -3.826834324e-01f, -5.555702330e-01f, -7.071067812e-01f, -8.314696123e-01f, -9.238795325e-01f, -9.807852804e-01f};
    constexpr float CI[16] = {-0.000000000e+00f, -1.950903220e-01f, -3.826834324e-01f, -5.555702330e-01f, -7.071067812e-01f, -8.314696123e-01f, -9.238795325e-01f, -9.807852804e-01f, -1.000000000e+00f, -9.807852804e-01f, -9.238795325e-01f, -8.314696123e-01f, -7.071067812e-01f, -5.555702330e-01f, -3.826834324e-01f, -1.950903220e-01f};
    if constexpr (J == 0) return a;
    else if constexpr (J == 8) return CONJ ? (f32x2){-a.y, a.x} : (f32x2){a.y, -a.x};
    else { constexpr float cr = CR[J], ci = CONJ ? -CI[J] : CI[J]; return (f32x2){a.x * cr - a.y * ci, a.x * ci + a.y * cr}; }
}
template <int H, int E, bool INV> __device__ __forceinline__ void bfly32(f32x2 (&v)[32]) {
    if constexpr (!(E & H)) { constexpr int J = (E & (H - 1)) * (16 / H);
        if constexpr (!INV) { const f32x2 x = v[E], y = v[E + H]; v[E] = x + y; v[E + H] = mulc32<J, false>(x - y); }
        else { const f32x2 x = v[E], y = mulc32<J, true>(v[E + H]); v[E] = x + y; v[E + H] = x - y; } }
}
template <int H, bool INV> __device__ __forceinline__ void stage32(f32x2 (&v)[32]) {
#define B4(e) bfly32<H, e, INV>(v); bfly32<H, e + 1, INV>(v); bfly32<H, e + 2, INV>(v); bfly32<H, e + 3, INV>(v);
    B4(0) B4(4) B4(8) B4(12) B4(16) B4(20) B4(24) B4(28)
#undef B4
}
__device__ __forceinline__ void fft32_fwd(f32x2 (&v)[32]) { stage32<16, false>(v); stage32<8, false>(v); stage32<4, false>(v); stage32<2, false>(v); stage32<1, false>(v); }
__device__ __forceinline__ void fft32_inv(f32x2 (&v)[32]) { stage32<1, true>(v); stage32<2, true>(v); stage32<4, true>(v); stage32<8, true>(v); stage32<16, true>(v); }
__device__ __forceinline__ float block_sum(float v, LAS float* scr, int lane, int wave) {
    v = wave_sum(v); __syncthreads(); if (lane == 0) scr[wave] = v; __syncthreads();
    float t = 0.f;
#pragma unroll
    for (int w = 0; w < 8; ++w) t += scr[w];
    return t;
}
__device__ __forceinline__ void hy_longconv_phase(const Frame& F, const Args& a, const bf16_t* XTL, bf16_t* z1T, bf16_t* z2T, const bf16_t* XTC, bf16_t* z2Tc) {
    LAS f32x2* W = (LAS f32x2*)F.lds;
    LAS f32x2* HF = (LAS f32x2*)(F.lds + 67584);
    LAS f32x2* TW = (LAS f32x2*)(F.lds + 135168);
    LAS float* wfb = (LAS float*)(F.lds + 151552);
    LAS float* scr = wfb + 128;
    const int tid = F.tid_(), lane = F.lane_(), wave = F.wave;
    const f32x2* twg = (const f32x2*)(KWS + WS_TW);
    for (int k = tid; k < 2048; k += 512) TW[k] = twg[k];
    const float* a2L = (const float*)(KWS + WS_A2); const float* a2C = (const float*)(KWS + WS_A2C);
    const float* w3 = KIN(I_HYFW3); const float* skip = KIN(I_HYSKIP);
    __syncthreads();
    const float* HT = (const float*)(KWS + WS_HT); const float* HTC = (const float*)(KWS + WS_HTC);
    for (int c = blockIdx.x; c < DM; c += F.G) {
        for (int o = 0; o < 2; ++o) {
            __syncthreads();
            PB(PT_SUB_FILT)
            const bf16_t* usrc = o == 0 ? XTL : z1T; const bf16_t* gsrc = XTL + ((size_t)(1 + o) * NB * DM << 12); bf16_t* dst = o == 0 ? z1T : z2T;
            bf16_t pu0[8], pu1[8];
#pragma unroll
            for (int e = 0; e < 8; ++e) { const int t = tid + 512 * e; pu0[e] = usrc[((size_t)c << 12) + t]; pu1[e] = usrc[((size_t)(DM + c) << 12) + t]; }
            f32x2 v[16]; float lsum = 0.f;
            { const float* hp = HT + ((size_t)(o * DM + c) << 13) + tid;
#pragma unroll
                for (int e = 0; e < 16; ++e) { float h = hp[512 * e]; if (e == 8 && tid == 0) h = 0.f; v[e] = (f32x2){h, 0.f}; lsum += fabsf(h); } }
            r16<false>(v, twv(TW, tid));
#pragma unroll
            for (int e = 0; e < 16; ++e) W[PX(tid + 512 * e)] = v[e];
            const float ssum = block_sum(lsum, scr, lane, wave);
            fft_pass16<false>(W, TW, 8, tid);
            const float scale = 1.0f / (ssum * (float)FFT_N);
            if (tid < 256) { f32x2 q[32];
#pragma unroll
                for (int e = 0; e < 32; ++e) q[e] = W[33 * tid + e];
                fft32_fwd(q);
#pragma unroll
                for (int e = 0; e < 32; ++e) HF[33 * tid + e] = q[e] * scale; }
            __syncthreads();
            PE(PT_SUB_FILT)
            const float sk = skip[o * DM + c];
            for (int bp = 0; bp < 4; ++bp) {
                const size_t o0 = (size_t)((2 * bp) * DM + c) << 12, o1 = (size_t)((2 * bp + 1) * DM + c) << 12;
                float ur[8], ui[8];
#pragma unroll
                for (int e = 0; e < 8; ++e) { ur[e] = bf1(pu0[e]); ui[e] = bf1(pu1[e]); v[e] = (f32x2){ur[e], ui[e]}; v[e + 8] = (f32x2){0.f, 0.f}; }
                bf16_t pg0[8], pg1[8];
#pragma unroll
                for (int e = 0; e < 8; ++e) { const int t = tid + 512 * e; pg0[e] = gsrc[o0 + t]; pg1[e] = gsrc[o1 + t]; }
                if (bp < 3) {
#pragma unroll
                    for (int e = 0; e < 8; ++e) { const int t = tid + 512 * e; pu0[e] = usrc[o0 + ((size_t)(2 * DM) << 12) + t]; pu1[e] = usrc[o1 + ((size_t)(2 * DM) << 12) + t]; } }
                r16<false>(v, twv(TW, tid));
#pragma unroll
                for (int e = 0; e < 16; ++e) W[PX(tid + 512 * e)] = v[e];
                __syncthreads();
                fft_pass16<false>(W, TW, 8, tid);
                if (tid < 256) { f32x2 q[32];
#pragma unroll
                    for (int e = 0; e < 32; ++e) q[e] = W[33 * tid + e];
                    fft32_fwd(q);
#pragma unroll
                    for (int e = 0; e < 32; ++e) q[e] = cmul(q[e], HF[33 * tid + e]);
                    fft32_inv(q);
#pragma unroll
                    for (int e = 0; e < 32; ++e) W[33 * tid + e] = q[e]; }
                __syncthreads();
                fft_pass16<true>(W, TW, 8, tid);
#pragma unroll
                for (int e = 0; e < 16; ++e) v[e] = W[PX(tid + 512 * e)];
                r16<true>(v, twv(TW, tid));
#pragma unroll
                for (int e = 0; e < 8; ++e) { const int t = tid + 512 * e;
                    const float r0 = bf1(pg0[e]) * (v[e].x + ur[e] * sk), r1 = bf1(pg1[e]) * (v[e].y + ui[e] * sk);
                    dst[o0 + t] = (bf16_t)f2bf(r0); dst[o1 + t] = (bf16_t)f2bf(r1); }
            }
        }
    }
    PB(PT_SUB_CTX)
    LAS float* ucA = (LAS float*)F.lds;
    LAS float* hf0 = ucA + 2048;
    LAS float* hf1 = hf0 + 512;
    LAS float* ucB = hf1 + 512;
    LAS float* scr2 = scr + 8;
    const int mi = lane & 15, mk = lane >> 4, tA = (2 * wave) * 16, tB = tA + 16;
    for (int c = blockIdx.x; c < DM; c += F.G) {
        __syncthreads();
        for (int idx = tid; idx < 2048; idx += 512) ucA[idx] = bf1(XTC[(size_t)((idx >> 8) * DM + c) * CTXL + (idx & 255)]);
        float l0 = 0.f, l1 = 0.f;
        if (tid < 511) { const int d = tid - 255, si = (d >= 0 ? d : 512 + d); const float h0 = HTC[((size_t)c << 9) + si], h1 = HTC[((size_t)(DM + c) << 9) + si]; hf0[tid] = h0; hf1[tid] = h1; l0 = fabsf(h0); l1 = fabsf(h1); }
        u32x2 gq[2][2];
#pragma unroll
        for (int o = 0; o < 2; ++o)
#pragma unroll
            for (int tt = 0; tt < 2; ++tt) gq[o][tt] = *(const u32x2*)(XTC + (size_t)(((1 + o) * NB + (mi & 7)) * DM + c) * CTXL + (tt ? tB : tA) + 4 * mk);
        l0 = wave_sum(l0); l1 = wave_sum(l1);
        if (lane == 0) { scr[wave] = l0; scr2[wave] = l1; }
        __syncthreads();
        float s0sum = 0.f, s1sum = 0.f;
#pragma unroll
        for (int w = 0; w < 8; ++w) { s0sum += scr[w]; s1sum += scr2[w]; }
        for (int o = 0; o < 2; ++o) {
            const LAS float* us = o ? ucB : ucA; const LAS float* hfull = o ? hf1 : hf0;
            const float rs = 1.0f / (o ? s1sum : s0sum), sk = skip[o * DM + c];
            f32x4 acc0 = (f32x4){0.f, 0.f, 0.f, 0.f}, acc1 = (f32x4){0.f, 0.f, 0.f, 0.f};
            const LAS float* hA = hfull + 255 + tA + mi - mk; const LAS float* hB = hA + 16; const LAS float* ub = us + (mi & 7) * 256 + mk;
#pragma unroll 8
            for (int s0 = 0; s0 < 256; s0 += 4) { const float bv = ub[s0];
                acc0 = __builtin_amdgcn_mfma_f32_16x16x4f32(hA[-s0], bv, acc0, 0, 0, 0); acc1 = __builtin_amdgcn_mfma_f32_16x16x4f32(hB[-s0], bv, acc1, 0, 0, 0); }
            if (mi < 8) {
#pragma unroll
                for (int tt = 0; tt < 2; ++tt) { const int t0 = (tt ? tB : tA) + 4 * mk; const f32x4 y = tt ? acc1 : acc0;
                    const u32x2 gw = o ? gq[1][tt] : gq[0][tt];
                    const float g[4] = {bf_lo(gw.x), bf_hi(gw.x), bf_lo(gw.y), bf_hi(gw.y)};
                    float r[4];
#pragma unroll
                    for (int k = 0; k < 4; ++k) r[k] = g[k] * (y[k] * rs + us[mi * 256 + t0 + k] * sk);
                    if (o == 0) {
#pragma unroll
                        for (int k = 0; k < 4; ++k) ucB[mi * 256 + t0 + k] = bf1((bf16_t)f2bf(r[k]));
                    } else { u32x2 w; w.x = pk2(r[0], r[1]); w.y = pk2(r[2], r[3]); *(u32x2*)(z2Tc + (size_t)(mi * DM + c) * CTXL + t0) = w; } }
            }
            __syncthreads();
        }
    }
    __syncthreads();
    PE(PT_SUB_CTX)
}

__device__ __forceinline__ void copy_rows(const Frame& F, const float* src, float* dst, size_t n4) {
    for (size_t i = (size_t)blockIdx.x * 512 + F.tid_(); i < n4; i += (size_t)F.G * 512) ((f32x4*)dst)[i] = ((const f32x4*)src)[i];
}


constexpr int PH_P0 = 0, PH_N0 = 1, PH_L0 = 2, PH_PER = 12, PH_END = PH_L0 + DEPTH * PH_PER;
#ifndef DBG_LAST
#define DBG_LAST 100
#endif

constexpr int CQ_P0 = 8192;
constexpr int CQ_A0 = CQ_P0 + 5120, CQ_B0 = CQ_A0, CQ_T0F = CQ_B0 + 12288, CQ_T0 = CQ_T0F + 2048;
constexpr int CQ_A1 = CQ_T0 + 5120, CQ_B1 = CQ_A1 + 8960, CQ_T1 = CQ_B1 + 10496;
constexpr int CQ_A2 = CQ_T1 + 11648, CQ_T2F = CQ_A2 + 12288, CQ_T2 = CQ_T2F + 3968;
constexpr int CQ_T3F = CQ_T2 + 12288, CQ_T3 = 4 * MOE_QL;
static_assert(CQ_T0 >= MOE_QL && CQ_T1 >= 2 * MOE_QL && CQ_T2 >= 3 * MOE_QL && CQ_T3F <= CQ_T3, "conversion schedule");
constexpr int CQ_IN[4][3]  = {{96, CQ_P0, CQ_A0}, {96, CQ_T0, CQ_A1}, {48, CQ_T1, CQ_A2}, {256, 0, 0}};
constexpr int CQ_OUT[4][3] = {{256, 0, 0}, {32, CQ_A1, CQ_B1}, {256, 0, 0}, {256, 0, 0}};
constexpr int CQ_UP[4][3]  = {{256, 0, 0}, {256, 0, 0}, {256, 0, 0}, {256, 0, 0}};
constexpr int CQ_DN[4][3]  = {{256, 0, 0}, {256, 0, 0}, {256, 0, 0}, {256, 0, 0}};
constexpr int CQ_TOPK[4][3] = {{CQ_B0, CQ_T0F, CQ_T0}, {CQ_B1, CQ_T1, CQ_T1}, {CQ_A2, CQ_T2F, CQ_T2}, {CQ_T2, CQ_T3F, CQ_T3}};
template <int layer>
__device__ __forceinline__ void run_layer(const Frame& F, const Args& a, const XcdBarrier& bar, const int lo, const int hi) {
    float* modv = (float*)(KWS + WS_MODV);
    bf16_t* LAT = (bf16_t*)(KWS + WS_LAT);
    bf16_t* HL = (bf16_t*)(KWS + WS_HL);
    bf16_t* U = (bf16_t*)(KWS + WS_U);
    bf16_t* Z = (bf16_t*)(KWS + WS_Z);
    bf16_t* wm = (bf16_t*)(KWS + WS_WMIX);
    bf16_t* HB = (bf16_t*)(KWS + WS_H);
    bf16_t* YS = (bf16_t*)(KWS + WS_YS);
    bf16_t* XTL = (bf16_t*)(KWS + WS_H); bf16_t* XTC = (bf16_t*)(KWS + WS_H + 192 * MiB);
    bf16_t* Z1T = (bf16_t*)(KWS + WS_U); bf16_t* Z2T = (bf16_t*)(KWS + WS_U + 68 * MiB); bf16_t* Z2TC = (bf16_t*)(KWS + WS_U + 136 * MiB);
    bf16_t* KB = (bf16_t*)(KWS + WS_H); bf16_t* VB = (bf16_t*)(KWS + WS_H + 17 * MiB);
    float* affL = (float*)(KWS + WS_AFF); float* affC = (float*)(KWS + WS_AFFC);
    int* rowlist = (int*)(KWS + WS_ROWL); float* gl = (float*)(KWS + WS_GL); int* slotmap = (int*)(KWS + WS_SLOT);
#define IN(k) (lo <= (k) && (k) < hi)
#define SEAM(k) do { if ((k) + 1 < hi) { unsigned long long _st0 = 0; const bool _sp = ((PROBE_MASK >> 20) & 1u) || ((PROBE_SEAMMASK >> _ptype) & 1u); if ((PROBE_MASK >> 21) & 1u) xcd_barrier(bar); if (_sp) _st0 = wall_clock64(); xcd_barrier(bar); if (_sp) { if (threadIdx.x == 0) { volatile LAS unsigned long long* _pa = (volatile LAS unsigned long long*)(F.lds + LDS_MISC + 128); *_pa = *_pa + (wall_clock64() - _st0); } } } } while (0)
        constexpr int pb = PH_L0 + layer * PH_PER;
        if (pb >= hi) return;
        constexpr int kind = layer % 3, jj = layer / 3;
        constexpr bool need_ctx = layer <= 2, upd_ctx = layer < 2;
        constexpr int m_in = need_ctx ? MALL : NLAT, m_out = upd_ctx ? MALL : NLAT;
        const float* modl = modv + (size_t)layer * 9 * MODW;
        const void* baseL = layer == 0 ? (const void*)KIN(I_X) : (const void*)LAT;
        const void* baseC = layer == 0 ? (const void*)KIN(I_CTX) : (const void*)(LAT + (size_t)NLAT * DM);
        const bf16_t* w_in = kind == 0 ? wm + WM_SC_IN + (size_t)jj * 3072 * 1024 : (kind == 1 ? wm + WM_HY_IN : wm + WM_AT_QKV);
        const bf16_t* w_out = kind == 0 ? wm + WM_SC_OUT + (size_t)jj * 1024 * 1024 : (kind == 1 ? wm + WM_HY_OUT : wm + WM_AT_O);
        constexpr int n_in = kind == 2 ? 1536 : 3072;
        if (IN(pb + 0)) { PB(PT_INGEMM)
            if constexpr (CQ_IN[layer][0] < 256) { moe_convert_tail(F, CQ_IN[layer][0], CQ_IN[layer][1], CQ_IN[layer][2]); __syncthreads(); }
            pg8::Gemm g{HL, w_in, m_in, n_in, DM, 1 << 20, nullptr}; pg8::StaticOrder S; S.init(m_in, n_in, F.G, (int)blockIdx.x);
            if constexpr (kind == 0) { pg8::EpiScIn E{U}; pg8::gemm_phase<pg8::EpiScIn, pg8::StaticOrder, false>(F.lds, g, S, E); }
            else { pg8::EpiBf16 E{U, n_in};
            pg8::gemm_phase<pg8::EpiBf16, pg8::StaticOrder, false>(F.lds, g, S, E); }
            SEAM(pb + 0); PE(PT_INGEMM)
        }
        if (IN(pb + 1)) { PB(kind == 0 ? PT_SCCONV : (kind == 1 ? PT_HYDW : PT_ATPREP))
            if constexpr (kind == 0) sc_conv_phase(F, U, KIN(I_SCCONV) + (size_t)jj * 3 * DM, Z, m_out);
            if constexpr (kind == 2) attn_prep_phase(F, U, KIN(I_ATQG), KIN(I_ATKG), KB, VB);
            if constexpr (kind == 1) hy_dwconv_phase(F, U, KIN(I_HYCONV), XTL, XTC);
            SEAM(pb + 1); PE(kind == 0 ? PT_SCCONV : (kind == 1 ? PT_HYDW : PT_ATPREP))
        }
        if constexpr (kind != 0) if (IN(pb + 2)) { PB(kind == 1 ? PT_HYLC : PT_ATTN)
            if constexpr (kind == 2) attn_phase(F, U, KB, VB, Z);
            if constexpr (kind == 1) hy_longconv_phase(F, a, XTL, Z1T, Z2T, XTC, Z2TC);
            SEAM(pb + 2); PE(kind == 1 ? PT_HYLC : PT_ATTN)
        }
        if constexpr (kind == 1) if (IN(pb + 3)) { PB(PT_HYUT) hy_untranspose_phase(F, Z2T, Z2TC, Z); SEAM(pb + 3); PE(PT_HYUT) }
        if (IN(pb + 4)) { PB(PT_OUTGEMM)
            if constexpr (CQ_OUT[layer][0] < 256) { moe_convert_tail(F, CQ_OUT[layer][0], CQ_OUT[layer][1], CQ_OUT[layer][2]); __syncthreads(); }
            if constexpr (layer == 0) { if (F.G == 256 && blockIdx.x >= 32) hy_filter_table_phase(F, a, (int)blockIdx.x - 32, 224); __syncthreads(); }
            pg8::Gemm g{Z, w_out, m_out, DM, DM, 1 << 20, nullptr}; pg8::StaticOrder S; S.init(m_out, DM, F.G, (int)blockIdx.x);
            pg8::EpiRes<layer == 0> E{baseL, baseC, LAT, modl + 2 * DM};
            pg8::gemm_phase<pg8::EpiRes<layer == 0>, pg8::StaticOrder, false>(F.lds, g, S, E);
            SEAM(pb + 4); PE(PT_OUTGEMM)
        }
        if (IN(pb + 5)) { PB(PT_NORM2)
            norm2_router_phase(F, LAT, m_out, KIN(I_NORMG) + (size_t)(layer * 2 + 1) * DM, modl, HL, KIN(I_ROUTER) + (size_t)layer * DM * NE, affL, affC);
            SEAM(pb + 5); PE(PT_NORM2)
        }
        if (IN(pb + 6)) { PB(PT_TOPK) topk_convert_phase(F, a, layer, upd_ctx, affL, affC, rowlist, gl, slotmap, (const unsigned char*)HL, (unsigned char*)Z, F.G == 256 ? CQ_TOPK[layer][0] : layer * MOE_QL, F.G == 256 ? CQ_TOPK[layer][1] : (layer + 1) * MOE_QL, F.G == 256 ? CQ_TOPK[layer][2] : (layer + 1) * MOE_QL); SEAM(pb + 6); PE(PT_TOPK) }
        constexpr int RE = upd_ctx ? (REL + REC) : REL;
        if (IN(pb + 7)) { PB(PT_MOEUP)
            if constexpr (CQ_UP[layer][0] < 256) { moe_convert_tail(F, CQ_UP[layer][0], CQ_UP[layer][1], CQ_UP[layer][2]); __syncthreads(); }
            pg8::Gemm g{HL, KWS + moe_wup_off(layer == 3 ? 0 : layer), NE * RE, 2048, DM, RE / 256, rowlist}; pg8::StaticOrder S; S.init(NE * RE, 2048, F.G, (int)blockIdx.x);
            pg8::EpiMoeUp E{(unsigned char*)HB};
            pg8::gemm_phase<pg8::EpiMoeUp, pg8::StaticOrder, true, 1>(F.lds, g, S, E);
            SEAM(pb + 7); PE(PT_MOEUP)
        }
        if (IN(pb + 8)) { PB(PT_MOEDN)
            if constexpr (CQ_DN[layer][0] < 256) { moe_convert_tail(F, CQ_DN[layer][0], CQ_DN[layer][1], CQ_DN[layer][2]); __syncthreads(); }
            pg8::Gemm g{HB, KWS + moe_wdn_off(layer == 3 ? 0 : layer), NE * RE, DM, DM, RE / 256, nullptr}; pg8::StaticOrder S; S.init(NE * RE, DM, F.G, (int)blockIdx.x);
            pg8::EpiMoeDown E{(unsigned char*)YS, gl};
            pg8::gemm_phase<pg8::EpiMoeDown, pg8::StaticOrder, false, 1>(F.lds, g, S, E);
            SEAM(pb + 8); PE(PT_MOEDN)
        }
        if (IN(pb + 9)) { PB(PT_COMB)
            const bool fin = layer == DEPTH - 1;
            combine_phase(F, LAT, m_out, YS, slotmap, gl, modl, fin, KOUT, KIN(I_NORMG) + (size_t)((layer + 1) * 2) * DM, modv + (size_t)(layer + 1) * 9 * MODW, HL);
            SEAM(pb + 9); PE(PT_COMB)
        }
    #undef IN
#undef SEAM
}

__global__ void __launch_bounds__(512, 2) fwd_kernel(Args a) {
    extern __shared__ __attribute__((aligned(16))) unsigned char lds_raw[];
    Frame F;
    F.lds = (LAS unsigned char*)lds_raw;
    F.wave = __builtin_amdgcn_readfirstlane((int)threadIdx.x >> 6);
    F.G = gridDim.x; F.gw = blockIdx.x * 8 + F.wave; F.NGW = F.G * 8;
    volatile LAS unsigned* MISC = (volatile LAS unsigned*)(F.lds + LDS_MISC);
    for (int u = F.tid_(); u < (LDS_BYTES - LDS_MISC) / 4; u += 512) MISC[u] = 0u;
    __syncthreads();
    unsigned* ctl = (unsigned*)(KWS + WS_CTL);
    const int lo = a.ph_lo, hi = a.ph_hi;
    const bool multi = (hi - lo) > 1;
    XcdBarrier bar; bar.bar = ctl + CW_BAR; bar.x = 0; bar.st = nullptr;
    if (multi) bar = xcd_barrier_post(ctl + CW_BAR, MISC + 8);
#define IN(k) (lo <= (k) && (k) < hi)
#define SEAM(k) do { if ((k) + 1 < hi) { unsigned long long _st0 = 0; const bool _sp = ((PROBE_MASK >> 20) & 1u) || ((PROBE_SEAMMASK >> _ptype) & 1u); if ((PROBE_MASK >> 21) & 1u) xcd_barrier(bar); if (_sp) _st0 = wall_clock64(); xcd_barrier(bar); if (_sp) { if (threadIdx.x == 0) { volatile LAS unsigned long long* _pa = (volatile LAS unsigned long long*)(F.lds + LDS_MISC + 128); *_pa = *_pa + (wall_clock64() - _st0); } } } } while (0)

    float* modv = (float*)(KWS + WS_MODV);
    bf16_t* LAT = (bf16_t*)(KWS + WS_LAT);
    bf16_t* HL = (bf16_t*)(KWS + WS_HL);
    bf16_t* U = (bf16_t*)(KWS + WS_U);
    bf16_t* Z = (bf16_t*)(KWS + WS_Z);
    bf16_t* wm = (bf16_t*)(KWS + WS_WMIX);
    bf16_t* HB = (bf16_t*)(KWS + WS_H);
    bf16_t* YS = (bf16_t*)(KWS + WS_YS);
    bf16_t* XTL = (bf16_t*)(KWS + WS_H); bf16_t* XTC = (bf16_t*)(KWS + WS_H + 192 * MiB);
    bf16_t* Z1T = (bf16_t*)(KWS + WS_U); bf16_t* Z2T = (bf16_t*)(KWS + WS_U + 68 * MiB); bf16_t* Z2TC = (bf16_t*)(KWS + WS_U + 136 * MiB);
    bf16_t* KB = (bf16_t*)(KWS + WS_H); bf16_t* VB = (bf16_t*)(KWS + WS_H + 17 * MiB);
    float* affL = (float*)(KWS + WS_AFF); float* affC = (float*)(KWS + WS_AFFC);
    int* rowlist = (int*)(KWS + WS_ROWL); float* gl = (float*)(KWS + WS_GL); int* slotmap = (int*)(KWS + WS_SLOT);

    if (IN(PH_P0)) { PB(PT_P0) p0_mod(F, a); __syncthreads(); p0_convert_mixers(F, a); p0_hyena_tables(F, a); __syncthreads(); moe_convert_tail(F, 128, 0, CQ_P0); SEAM(PH_P0); PE(PT_P0) }
    if (IN(PH_N0)) { PB(PT_N1) norm1_phase(F, KIN(I_X), KIN(I_CTX), MALL, KIN(I_NORMG), modv, HL); if (F.G != 256) hy_filter_table_phase(F, a, (int)blockIdx.x, F.G); SEAM(PH_N0); PE(PT_N1) }

    if (DBG_LAST >= PH_L0 + 0 * PH_PER) run_layer<0>(F, a, bar, lo, hi);
    if (DBG_LAST >= PH_L0 + 1 * PH_PER) run_layer<1>(F, a, bar, lo, hi);
    if (DBG_LAST >= PH_L0 + 2 * PH_PER) run_layer<2>(F, a, bar, lo, hi);
    if (DBG_LAST >= PH_L0 + 3 * PH_PER) run_layer<3>(F, a, bar, lo, hi);
    if ((PROBE_MASK >> 26) & 1u) { if (xb_xcc_id() != (blockIdx.x & 7u)) { const unsigned long long t0 = wall_clock64(); while (wall_clock64() - t0 < 50000ull) __builtin_amdgcn_s_sleep(8); } }
    if (PROBE_MASK != 0u) { __syncthreads(); const unsigned long long tot = *(volatile LAS unsigned long long*)(F.lds + LDS_MISC + 128) * (unsigned long long)PROBE_K;
        const unsigned long long t0 = wall_clock64(); while (wall_clock64() - t0 < tot) __builtin_amdgcn_s_sleep(8); }
#undef IN
#undef SEAM
}

#ifndef ONE_LAUNCH
#define ONE_LAUNCH 1
#endif
extern "C" void kernel_launch(void* const* d_in, const int* in_sizes, int n_in, void* d_out, int out_size, void* d_ws, size_t ws_size, hipStream_t stream) {
    static int grid = 0;
    if (grid == 0) {
        if (n_in != 28 || out_size != NLAT * DM || ws_size < WS_END + 48 * MiB) { fprintf(stderr, "kernel_launch: unexpected shapes n_in %d out %d ws %zu (need %zu)\n", n_in, out_size, ws_size, (size_t)(WS_END + 48 * MiB)); grid = -1; return; }
        int dev = 0, cus = 0, per_cu = 0;
        if (hipGetDevice(&dev) != hipSuccess || hipDeviceGetAttribute(&cus, hipDeviceAttributeMultiprocessorCount, dev) != hipSuccess) { grid = -1; return; }
        if (hipFuncSetAttribute((const void*)fwd_kernel, hipFuncAttributeMaxDynamicSharedMemorySize, LDS_BYTES) != hipSuccess) { fprintf(stderr, "kernel_launch: hipFuncSetAttribute failed\n"); grid = -1; return; }
        if (hipOccupancyMaxActiveBlocksPerMultiprocessor(&per_cu, (const void*)fwd_kernel, 512, LDS_BYTES) != hipSuccess || per_cu < 1) fprintf(stderr, "kernel_launch: occupancy query says %d\n", per_cu);
        (void)hipGetLastError();
        grid = cus;
    }
    if (grid < 0) return;
    hipMemsetAsync((char*)d_ws + WS_CTL, 0, CTL_ZERO_BYTES, stream);
    Args a{};
    for (int i = 0; i < 28; ++i) a.in[i] = (const float*)d_in[i];
    a.out = (float*)d_out; a.ws = (unsigned char*)d_ws;
    if (ONE_LAUNCH) { a.ph_lo = 0; a.ph_hi = PH_L0 + (DEPTH - 1) * PH_PER + 10;   hipLaunchKernelGGL(fwd_kernel, dim3(grid), dim3(512), LDS_BYTES, stream, a); }
    else {
        for (int ph = 0; ph <= PH_END; ++ph) {
            bool exists = (ph == PH_P0 || ph == PH_N0 || ph == PH_END);
            if (ph >= PH_L0 && ph < PH_END) { const int layer = (ph - PH_L0) / PH_PER, k = (ph - PH_L0) % PH_PER, kind = layer % 3;
                exists = (k == 0 || k == 1 || k == 4 || (k >= 5 && k <= 9) || (k == 2 && kind != 0) || (k == 3 && kind == 1));
                if (ph > DBG_LAST) exists = false; }
            if (!exists) continue;
            a.ph_lo = ph; a.ph_hi = ph + 1;
            hipLaunchKernelGGL(fwd_kernel, dim3(grid), dim3(512), LDS_BYTES, stream, a);
        }
    }
}
```
